# Optimizing an MI355X kernel written in HIP

```python
import math
import jax, jax.numpy as jnp
from jax import lax
import numpy as np

D_MODEL = 2048
BATCH = 2
SEQ = 16384
DEPTH = 2

F32 = jnp.float32
CHUNK = 64
N_META = 16
CONV_WIDTH = 3
D_CONV = 1536
S5_CH = 16
S5_STATE = 64
D_SSM = 512
S5_GROUPS = D_SSM // S5_CH
MLSTM_HEADS = 4
MLSTM_DH = 256
D_MLSTM = MLSTM_HEADS * MLSTM_DH
DSA_HEADS = 8
DSA_DH = 128
D_DSA = DSA_HEADS * DSA_DH
IDX_HEADS = 8
IDX_DH = 64
TOPK_MAX = 256
Q_BLOCK = 128
NUM_BUCKETS = 32
MAX_DISTANCE = 128
D_FF = 5632
N_EXPERTS = 8
TOP_K = 2
D_EXPERT = 5632
MOE_BLOCK = 512
ALPHA = (2 * DEPTH) ** 0.25
BETA = (8 * DEPTH) ** -0.25
LN_EPS = 1e-5
N_EVEN = (DEPTH + 1) // 2
N_ODD = DEPTH // 2
D_IN_EVEN = 3 * D_CONV + D_SSM
D_IN_ODD = 4 * D_MLSTM + 2 * MLSTM_HEADS + 3 * D_DSA + IDX_HEADS * IDX_DH + IDX_DH + IDX_HEADS

kernel_name = "hybrid_conv_s5_mlstm_dsa_moe_trunk"


def layer_norm(x, g, b):
    xf = x.astype(F32)
    mu = xf.mean(-1, keepdims=True)
    var = jnp.square(xf - mu).mean(-1, keepdims=True)
    return ((xf - mu) * lax.rsqrt(var + LN_EPS) * g.astype(F32) + b.astype(F32)).astype(x.dtype)


def chunk_id(pos):
    return jnp.where(pos < N_META, 0, 1 + (pos - N_META) // CHUNK)


def t5_bucket(rel):
    half = NUM_BUCKETS // 2
    max_exact = half // 2
    ret = jnp.where(rel > 0, half, 0)
    n = jnp.abs(rel)
    nf = jnp.maximum(n, 1).astype(F32)
    large = max_exact + (jnp.log(nf / max_exact) / math.log(MAX_DISTANCE / max_exact) * (half - max_exact)).astype(jnp.int32)
    large = jnp.minimum(large, half - 1)
    return ret + jnp.where(n < max_exact, n, large)


def short_conv_mixer(b_gate, c_gate, xv, conv_w):
    z = c_gate * xv
    L = z.shape[1]
    zp = jnp.pad(z, ((0, 0), (CONV_WIDTH - 1, 0), (0, 0)))
    conv = sum(conv_w[j] * zp[:, j:j + L] for j in range(CONV_WIDTH))
    return b_gate * conv


def s5_mixer(u, a_re, a_im, log_dt, b_re, b_im, c_re, c_im, d_skip, w_glu):
    Bsz, L, _ = u.shape
    ug = u.reshape(Bsz, L, S5_GROUPS, S5_CH).astype(F32)
    a = lax.complex(a_re.astype(F32), a_im.astype(F32))
    dt = jnp.exp(log_dt.astype(F32))[:, None]
    a_bar = jnp.exp(dt * a)
    b_bar = ((a_bar - 1.0) / a)[:, :, None] * lax.complex(b_re.astype(F32), b_im.astype(F32))
    bu = jnp.einsum('gpc,blgc->blgp', b_bar, ug)
    a_seq = jnp.broadcast_to(a_bar, (L,) + a_bar.shape)

    def combine(e1, e2):
        a1, b1 = e1
        a2, b2 = e2
        return a1 * a2, a2 * b1 + b2

    state = jax.vmap(lambda bu_b: lax.associative_scan(combine, (a_seq, bu_b), axis=0)[1])(bu)
    c = lax.complex(c_re.astype(F32), c_im.astype(F32))
    y = jnp.real(jnp.einsum('gcp,blgp->blgc', c, state)) + d_skip.astype(F32) * ug
    y = jax.nn.gelu(y)
    y = y * jax.nn.sigmoid(jnp.einsum('gcd,blgd->blgc', w_glu.astype(F32), y))
    return y.reshape(Bsz, L, D_SSM).astype(u.dtype)


def conv_ssm_mixer(h, w_in, conv_w, a_re, a_im, log_dt, b_re, b_im, c_re, c_im, d_skip, w_glu, w_out):
    p = h @ w_in
    b_gate, c_gate, xv, u = jnp.split(p, [D_CONV, 2 * D_CONV, 3 * D_CONV], axis=-1)
    y = jnp.concatenate([short_conv_mixer(b_gate, c_gate, xv, conv_w),
                         s5_mixer(u, a_re, a_im, log_dt, b_re, b_im, c_re, c_im, d_skip, w_glu)], axis=-1)
    return y @ w_out


def mlstm(q, k, v, o_pre, i_pre, f_pre, b_i, b_f):
    Bsz, L, _ = q.shape
    nc = L // CHUNK

    def to_chunks(t):
        return t.reshape(Bsz, nc, CHUNK, MLSTM_HEADS, MLSTM_DH).transpose(1, 0, 3, 2, 4).astype(F32)

    def gate_chunks(t):
        return t.reshape(Bsz, nc, CHUNK, MLSTM_HEADS).transpose(1, 0, 3, 2)

    qc, kc, vc = to_chunks(q), to_chunks(k) * MLSTM_DH ** -0.5, to_chunks(v)
    li = gate_chunks(i_pre.astype(F32) + b_i.astype(F32))
    lf = gate_chunks(jax.nn.log_sigmoid(f_pre.astype(F32) + b_f.astype(F32)))
    tril = jnp.tril(jnp.ones((CHUNK, CHUNK), bool))

    def step(carry, xs):
        c_st, n_st, m_prev = carry
        qx, kx, vx, lix, lfx = xs
        bcum = jnp.cumsum(lfx, axis=-1)
        dmat = jnp.where(tril, bcum[..., :, None] - bcum[..., None, :] + lix[..., None, :], -jnp.inf)
        m_inter = bcum + m_prev[..., None]
        m_t = jnp.maximum(m_inter, dmat.max(-1))
        s = jnp.einsum('bhtd,bhsd->bhts', qx, kx) * jnp.exp(dmat - m_t[..., None])
        w_inter = jnp.exp(m_inter - m_t)
        num = jnp.einsum('bhts,bhsd->bhtd', s, vx) + w_inter[..., None] * jnp.einsum('bhvk,bhtk->bhtv', c_st, qx)
        den = s.sum(-1) + w_inter * jnp.einsum('bhtk,bhk->bht', qx, n_st)
        h_out = num / jnp.maximum(jnp.abs(den), jnp.exp(-m_t))[..., None]
        b_last = bcum[..., -1]
        w_s = b_last[..., None] - bcum + lix
        m_new = jnp.maximum(b_last + m_prev, w_s.max(-1))
        decay = jnp.exp(b_last + m_prev - m_new)
        ws = jnp.exp(w_s - m_new[..., None])
        c_new = decay[..., None, None] * c_st + jnp.einsum('bhs,bhsv,bhsk->bhvk', ws, vx, kx)
        n_new = decay[..., None] * n_st + jnp.einsum('bhs,bhsk->bhk', ws, kx)
        return (c_new, n_new, m_new), h_out

    init = (jnp.zeros((Bsz, MLSTM_HEADS, MLSTM_DH, MLSTM_DH), F32),
            jnp.zeros((Bsz, MLSTM_HEADS, MLSTM_DH), F32),
            jnp.zeros((Bsz, MLSTM_HEADS), F32))
    _, hc = lax.scan(step, init, (qc, kc, vc, li, lf))
    h_all = hc.transpose(1, 0, 3, 2, 4).reshape(Bsz, L, D_MLSTM)
    return (jax.nn.sigmoid(o_pre.astype(F32)) * h_all).astype(q.dtype)


def dsa_attention(q, k, v, q_idx, k_idx, w_idx, rel_bias_table, topk):
    Bsz, L, _ = q.shape
    nb = L // Q_BLOCK
    pos = jnp.arange(L, dtype=jnp.int32)
    key_chunk = chunk_id(pos)
    qh = q.reshape(Bsz, L, DSA_HEADS, DSA_DH)
    kh = k.reshape(Bsz, L, DSA_HEADS, DSA_DH)
    vh = v.reshape(Bsz, L, DSA_HEADS, DSA_DH)
    qi = q_idx.reshape(Bsz, L, IDX_HEADS, IDX_DH)
    wi = w_idx * IDX_HEADS ** -0.5
    gather = jax.vmap(lambda t, i: t[i])

    def blocks(t):
        return jnp.moveaxis(t.reshape((Bsz, nb, Q_BLOCK) + t.shape[2:]), 1, 0)

    def attend(args):
        q_b, qi_b, w_b, pos_b = args
        s = jnp.einsum('bqhd,bkd->bqhk', qi_b, k_idx).astype(F32) * IDX_DH ** -0.5
        score = jnp.einsum('bqh,bqhk->bqk', w_b.astype(F32), jax.nn.relu(s))
        q_chunk = chunk_id(pos_b)
        admissible = key_chunk[None, :] <= q_chunk[:, None]
        score = jnp.where(admissible[None], score, -jnp.inf)
        _, idx = lax.top_k(score, topk)
        k_sel = gather(kh, idx)
        v_sel = gather(vh, idx)
        logits = jnp.einsum('bqhd,bqkhd->bhqk', q_b, k_sel).astype(F32) * DSA_DH ** -0.5
        bias = rel_bias_table[t5_bucket(idx - pos_b[None, :, None])]
        valid = key_chunk[idx] <= q_chunk[None, :, None]
        logits = jnp.where(valid[:, None], logits + jnp.moveaxis(bias, -1, 1).astype(F32), -jnp.inf)
        p = jax.nn.softmax(logits, axis=-1)
        return jnp.einsum('bhqk,bqkhd->bqhd', p.astype(v.dtype), v_sel)

    out = lax.map(attend, (blocks(qh), blocks(qi), blocks(wi), pos.reshape(nb, Q_BLOCK)))
    return jnp.moveaxis(out, 0, 1).reshape(Bsz, L, D_DSA)


def mlstm_dsa_mixer(h, w_in, b_i, b_f, rel_bias_table, w_out, topk):
    Bsz, L, _ = h.shape
    lq = L + (-L) % Q_BLOCK
    hp = jnp.pad(h, ((0, 0), (0, lq - L), (0, 0)))
    p = hp @ w_in
    sizes = [D_MLSTM] * 4 + [MLSTM_HEADS] * 2 + [D_DSA] * 3 + [IDX_HEADS * IDX_DH, IDX_DH, IDX_HEADS]
    q_m, k_m, v_m, o_m, i_m, f_m, q_d, k_d, v_d, q_i, k_i, w_i = jnp.split(p, np.cumsum(sizes)[:-1].tolist(), axis=-1)
    y_m = mlstm(q_m, k_m, v_m, o_m, i_m, f_m, b_i, b_f)
    y_d = dsa_attention(q_d, k_d, v_d, q_i, k_i, w_i, rel_bias_table, topk)
    y = jnp.concatenate([y_m, y_d], axis=-1)[:, :L]
    return y @ w_out


def swiglu(h, w1, w3, w2):
    return (jax.nn.silu(h @ w1) * (h @ w3)) @ w2


def moe_swiglu(h, w_router, b_router, w1, w3, w2):
    Bsz, L, D = h.shape
    x2 = h.reshape(-1, D)
    n = x2.shape[0]
    logits = (x2 @ w_router).astype(F32) + b_router.astype(F32)
    top_val, top_idx = lax.top_k(logits, TOP_K)
    gates = jax.nn.softmax(top_val, axis=-1)
    na = n * TOP_K
    flat_e = top_idx.reshape(-1)
    order = jnp.argsort(flat_e)
    e_s = flat_e[order]
    tok_s = (order // TOP_K).astype(jnp.int32)
    g_s = gates.reshape(-1)[order]
    counts = jnp.bincount(flat_e, length=N_EXPERTS)
    padded = (counts + MOE_BLOCK - 1) // MOE_BLOCK * MOE_BLOCK
    pad_end = jnp.cumsum(padded)
    pad_start = pad_end - padded
    start = jnp.cumsum(counts) - counts
    dest = pad_start[e_s] + jnp.arange(na) - start[e_s]
    nblk = -(-na // MOE_BLOCK) + N_EXPERTS
    cap = nblk * MOE_BLOCK
    slot_tok = jnp.zeros((cap,), jnp.int32).at[dest].set(tok_s)
    slot_gate = jnp.zeros((cap,), F32).at[dest].set(g_s)
    blk_expert = jnp.minimum(jnp.searchsorted(pad_end, jnp.arange(nblk) * MOE_BLOCK, side='right'), N_EXPERTS - 1)
    xb = x2[slot_tok].reshape(nblk, MOE_BLOCK, D)

    def expert_block(args):
        xe, e = args
        return (jax.nn.silu(xe @ w1[e]) * (xe @ w3[e])) @ w2[e]

    yb = lax.map(expert_block, (xb, blk_expert)).reshape(cap, D)
    y = jax.ops.segment_sum(yb.astype(F32) * slot_gate[:, None], slot_tok, num_segments=n)
    return y.astype(h.dtype).reshape(Bsz, L, D)


def setup_inputs(seed: int = 0) -> dict:
    key = jax.random.key(seed)
    ks = iter(jax.random.split(key, 48))

    def nrm(shape, scale):
        return jax.random.normal(next(ks), shape, F32) * scale

    def gain(shape):
        return 1.0 + nrm(shape, 0.02)

    d = D_MODEL
    return {
        "x": nrm((BATCH, SEQ, d), 1.0),
        "meta_tokens": nrm((N_META, d), 1.0),
        "w_in_even": nrm((N_EVEN, d, D_IN_EVEN), d ** -0.5),
        "conv_w": nrm((N_EVEN, CONV_WIDTH, D_CONV), CONV_WIDTH ** -0.5),
        "s5_a_re": -0.5 + nrm((N_EVEN, S5_GROUPS, S5_STATE), 0.01),
        "s5_a_im": math.pi * jnp.arange(S5_STATE, dtype=F32) + nrm((N_EVEN, S5_GROUPS, S5_STATE), 0.01),
        "s5_log_dt": jax.random.uniform(next(ks), (N_EVEN, S5_GROUPS), F32, math.log(1e-3), math.log(1e-1)),
        "s5_b_re": nrm((N_EVEN, S5_GROUPS, S5_STATE, S5_CH), (2 * S5_CH) ** -0.5),
        "s5_b_im": nrm((N_EVEN, S5_GROUPS, S5_STATE, S5_CH), (2 * S5_CH) ** -0.5),
        "s5_c_re": nrm((N_EVEN, S5_GROUPS, S5_CH, S5_STATE), S5_STATE ** -0.5),
        "s5_c_im": nrm((N_EVEN, S5_GROUPS, S5_CH, S5_STATE), S5_STATE ** -0.5),
        "s5_d": nrm((N_EVEN, S5_GROUPS, S5_CH), 1.0),
        "s5_w_glu": nrm((N_EVEN, S5_GROUPS, S5_CH, S5_CH), S5_CH ** -0.5),
        "w_out_even": nrm((N_EVEN, D_CONV + D_SSM, d), BETA * (D_CONV + D_SSM) ** -0.5),
        "ln_mix_even_g": gain((N_EVEN, d)),
        "ln_mix_even_b": nrm((N_EVEN, d), 0.02),
        "ffn_w1": nrm((N_EVEN, d, D_FF), d ** -0.5),
        "ffn_w3": nrm((N_EVEN, d, D_FF), d ** -0.5),
        "ffn_w2": nrm((N_EVEN, D_FF, d), BETA * D_FF ** -0.5),
        "ln_ffn_even_g": gain((N_EVEN, d)),
        "ln_ffn_even_b": nrm((N_EVEN, d), 0.02),
        "w_in_odd": nrm((N_ODD, d, D_IN_ODD), d ** -0.5),
        "mlstm_b_i": nrm((N_ODD, MLSTM_HEADS), 0.1),
        "mlstm_b_f": jnp.linspace(3.0, 6.0, MLSTM_HEADS, dtype=F32) + nrm((N_ODD, MLSTM_HEADS), 0.1),
        "rel_bias_table": nrm((NUM_BUCKETS, DSA_HEADS), 0.2),
        "w_out_odd": nrm((N_ODD, D_MLSTM + D_DSA, d), BETA * (D_MLSTM + D_DSA) ** -0.5),
        "ln_mix_odd_g": gain((N_ODD, d)),
        "ln_mix_odd_b": nrm((N_ODD, d), 0.02),
        "router_w": nrm((N_ODD, d, N_EXPERTS), d ** -0.5),
        "router_b": nrm((N_ODD, N_EXPERTS), 0.01),
        "expert_w1": nrm((N_ODD, N_EXPERTS, d, D_EXPERT), d ** -0.5),
        "expert_w3": nrm((N_ODD, N_EXPERTS, d, D_EXPERT), d ** -0.5),
        "expert_w2": nrm((N_ODD, N_EXPERTS, D_EXPERT, d), BETA * D_EXPERT ** -0.5),
        "ln_ffn_odd_g": gain((N_ODD, d)),
        "ln_ffn_odd_b": nrm((N_ODD, d), 0.02),
    }


def reference(x, meta_tokens, w_in_even, conv_w, s5_a_re, s5_a_im, s5_log_dt, s5_b_re, s5_b_im, s5_c_re, s5_c_im,
              s5_d, s5_w_glu, w_out_even, ln_mix_even_g, ln_mix_even_b, ffn_w1, ffn_w3, ffn_w2, ln_ffn_even_g,
              ln_ffn_even_b, w_in_odd, mlstm_b_i, mlstm_b_f, rel_bias_table, w_out_odd, ln_mix_odd_g, ln_mix_odd_b,
              router_w, router_b, expert_w1, expert_w3, expert_w2, ln_ffn_odd_g, ln_ffn_odd_b):
    Bsz, S, D = x.shape
    topk = min(TOPK_MAX, S // 4)
    h = jnp.concatenate([jnp.broadcast_to(meta_tokens.astype(x.dtype)[None], (Bsz, N_META, D)), x], axis=1)
    for layer in range(DEPTH):
        i = layer // 2
        if layer % 2 == 0:
            mix = conv_ssm_mixer(h, w_in_even[i], conv_w[i], s5_a_re[i], s5_a_im[i], s5_log_dt[i], s5_b_re[i],
                                 s5_b_im[i], s5_c_re[i], s5_c_im[i], s5_d[i], s5_w_glu[i], w_out_even[i])
            h = layer_norm(ALPHA * h + mix, ln_mix_even_g[i], ln_mix_even_b[i])
            h = layer_norm(ALPHA * h + swiglu(h, ffn_w1[i], ffn_w3[i], ffn_w2[i]), ln_ffn_even_g[i], ln_ffn_even_b[i])
        else:
            mix = mlstm_dsa_mixer(h, w_in_odd[i], mlstm_b_i[i], mlstm_b_f[i], rel_bias_table, w_out_odd[i], topk)
            h = layer_norm(ALPHA * h + mix, ln_mix_odd_g[i], ln_mix_odd_b[i])
            moe = moe_swiglu(h, router_w[i], router_b[i], expert_w1[i], expert_w3[i], expert_w2[i])
            h = layer_norm(ALPHA * h + moe, ln_ffn_odd_g[i], ln_ffn_odd_b[i])
    return h[:, N_META:]
```

```cpp
#include <hip/hip_runtime.h>
#include <cstdio>
#include <cstdint>
#include <cstring>

#define LAS __attribute__((address_space(3)))
#define GAS __attribute__((address_space(1)))
typedef unsigned short bf16_t;
typedef short bf16x8 __attribute__((ext_vector_type(8)));
typedef float f32x4 __attribute__((ext_vector_type(4)));
typedef float f32x16 __attribute__((ext_vector_type(16)));
typedef float f32x2 __attribute__((ext_vector_type(2)));
typedef unsigned u32x4 __attribute__((ext_vector_type(4)));
typedef unsigned u32x2 __attribute__((ext_vector_type(2)));

#ifndef MK_N_LAUNCHES
#define MK_N_LAUNCHES 1
#endif

constexpr int D = 2048, NB = 2, SEQ = 16384, NMETA = 16, LR = 16400, LP = 16512, M = NB * LP;
constexpr int DCONV = 1536, DSSM = 512, NIN_E = 5120, DFF = 5632, N13 = 2 * DFF;
constexpr int NIN_OA = 4864, NIN_OB = 3072;
constexpr int CA_QM = 0, CA_OM = 1024, CA_QD = 2048, CA_KD = 3072, CA_QI = 4096, CA_KI = 4608, CA_IM = 4672, CA_FM = 4676, CA_WI = 4680;
constexpr int RB_KM = 0, RB_VM = 1024, RB_VD = 2048;
constexpr float ALPHA = 1.41421356237309515f;
constexpr float LN_EPS = 1e-5f;
constexpr int S5CH = 128, S5NCH = LP / S5CH;
constexpr int NEXP = 8, MOE_CAP_TILES = 265, MOE_CAP = MOE_CAP_TILES * 256;
constexpr int BMP_PITCH = 544;
constexpr int NWAVES = 8, NTHREADS = 512;

constexpr size_t MiB = 1u << 20;
constexpr size_t WS_CTL = 0, CTL_BYTES = 1 * MiB;
constexpr size_t WS_WINE = 1 * MiB, WS_WOUTE = 21 * MiB, WS_W13 = 29 * MiB, WS_W2 = 73 * MiB, WS_WINOA = 95 * MiB, WS_WINOB = 118 * MiB;
constexpr size_t WS_HA = 138 * MiB, WS_HB = 267 * MiB, WS_PRE = 396 * MiB;
constexpr size_t WS_EW13 = 1 * MiB, WS_EW2 = 353 * MiB, WS_YB = 1 * MiB;
constexpr size_t WS_P = 529 * MiB, WS_KVT = 900 * MiB, WS_BMP = 1094 * MiB, WS_Y = 1163 * MiB, WS_PRE1 = 529 * MiB, WS_GH = 529 * MiB;
constexpr size_t WS_H2 = 1292 * MiB, WS_H3 = 1421 * MiB;
constexpr size_t WS_HBF8 = WS_HA;
constexpr size_t WS_H3F8 = 270 * MiB;
constexpr size_t WS_XE = 1550 * MiB;
constexpr size_t WS_S5T = WS_XE + 3584 * 1024;
constexpr size_t WS_MOE = 1555 * MiB;
constexpr size_t WS_KIC = 1558 * MiB;
constexpr size_t WS_WOUTO = 1563 * MiB;
constexpr size_t WS_END = 1571 * MiB;
constexpr size_t MO_TOKE = 0, MO_TOKG = 512 * 1024, MO_TOKPOS = 1024 * 1024, MO_TOKSLOT = 1536 * 1024, MO_SLOTTOK = 2048 * 1024, MO_TILEE = 2560 * 1024;
constexpr int CW_BAR = 0;
constexpr int CW_CNT = 4096;
constexpr int CW_Q2 = 8192;
constexpr int CW_Q1 = 8448;

constexpr int LDS_BYTES = 163840;
constexpr int LDS_MISC = 163840 - 256;
constexpr int D1_WAVE_BYTES = 36032;

#define LDS_WAIT() asm volatile("s_waitcnt lgkmcnt(0)" ::: "memory")
#define VM_WAIT() asm volatile("s_waitcnt vmcnt(0)" ::: "memory")
#define RAW_BAR() do { asm volatile("s_waitcnt lgkmcnt(0)" ::: "memory"); __builtin_amdgcn_s_barrier(); asm volatile("" ::: "memory"); } while (0)
__device__ __forceinline__ float bf2f(unsigned v) { return __uint_as_float(v << 16); }
__device__ __forceinline__ float bflo(unsigned w) { return __uint_as_float(w << 16); }
__device__ __forceinline__ float bfhi(unsigned w) { return __uint_as_float(w & 0xffff0000u); }
__device__ __forceinline__ unsigned f2bf(float f) { unsigned u = __float_as_uint(f); return (u + 0x7fffu + ((u >> 16) & 1u)) >> 16; }
typedef __bf16 bf16x2_t __attribute__((ext_vector_type(2)));
__device__ __forceinline__ unsigned pk4_f8(float a, float b, float c, float d) {
    a = __builtin_amdgcn_fmed3f(a, -448.f, 448.f); b = __builtin_amdgcn_fmed3f(b, -448.f, 448.f); c = __builtin_amdgcn_fmed3f(c, -448.f, 448.f); d = __builtin_amdgcn_fmed3f(d, -448.f, 448.f);
    int w = __builtin_amdgcn_cvt_pk_fp8_f32(a, b, 0, false); w = __builtin_amdgcn_cvt_pk_fp8_f32(c, d, w, true); return (unsigned)w; }
__device__ __forceinline__ unsigned pk4_i8(float a, float b, float c, float d) {
    const int ia = (int)__builtin_rintf(__builtin_amdgcn_fmed3f(a, -127.f, 127.f)), ib = (int)__builtin_rintf(__builtin_amdgcn_fmed3f(b, -127.f, 127.f));
    const int ic = (int)__builtin_rintf(__builtin_amdgcn_fmed3f(c, -127.f, 127.f)), id = (int)__builtin_rintf(__builtin_amdgcn_fmed3f(d, -127.f, 127.f));
    return (unsigned)(ia & 255) | ((unsigned)(ib & 255) << 8) | ((unsigned)(ic & 255) << 16) | ((unsigned)id << 24); }
constexpr float I8S_H = 28.f, I8S_W13 = 1280.f;
#ifndef FFN_DOWN_F8
#define FFN_DOWN_F8 0
#endif
constexpr float F8S_H3 = 8.f, F8S_W13 = 512.f, F8S_GH = 4.f, F8S_W2 = 2048.f;
__device__ __forceinline__ unsigned pk2(float lo, float hi) { bf16x2_t v; v[0] = (__bf16)lo; v[1] = (__bf16)hi; return __builtin_bit_cast(unsigned, v); }
template <int CTRL, int ROWMASK> __device__ __forceinline__ float dpp_add_f(float v) { return v + __int_as_float(__builtin_amdgcn_update_dpp(0, __float_as_int(v), CTRL, ROWMASK, 0xf, false)); }
__device__ __forceinline__ float wave_sum(float v) {
    v = dpp_add_f<0x111, 0xf>(v); v = dpp_add_f<0x112, 0xf>(v); v = dpp_add_f<0x114, 0xf>(v); v = dpp_add_f<0x118, 0xf>(v);
    v = dpp_add_f<0x142, 0xa>(v); v = dpp_add_f<0x143, 0xc>(v);
    return __int_as_float(__builtin_amdgcn_readlane(__float_as_int(v), 63));
}
__device__ __forceinline__ float fast_sigmoid(float x) { return __builtin_amdgcn_rcpf(1.0f + __expf(-x)); }

#define XB_TMO      128
#define XB_XCNT(j)  (256  + 64 * (j))
#define XB_XSUB(j)  (1280 + 64 * (j))
#define XB_XGEN(j)  (2304 + 64 * (j))
#define XB_TOP      3328
#define XB_TOPGEN   3392
#define XCD_BAR_WORDS 3456
#define XB_SPIN_CAP (1u << 22)

__device__ __forceinline__ unsigned xb_ld(unsigned* p)              { return __hip_atomic_load(p, __ATOMIC_RELAXED, __HIP_MEMORY_SCOPE_AGENT); }
__device__ __forceinline__ unsigned xb_add(unsigned* p, unsigned v) { return __hip_atomic_fetch_add(p, v, __ATOMIC_RELAXED, __HIP_MEMORY_SCOPE_AGENT); }
__device__ __forceinline__ unsigned xb_xcc_id() { return (unsigned)__builtin_amdgcn_s_getreg((3 << 11) | 20) & 0xFu; }
#define XB_SPIN(cond, bar) do { unsigned _sp = 0; while (cond) { __builtin_amdgcn_s_sleep(1); \
    if ((++_sp & 255u) == 0u) { if (xb_ld(&(bar)[XB_TMO])) break; if (_sp > XB_SPIN_CAP) { atomicAdd(&(bar)[XB_TMO], 1u); break; } } } } while (0)

struct XcdBarrier { unsigned* bar; unsigned x; volatile LAS unsigned* st; };

__device__ __forceinline__ XcdBarrier xcd_barrier_post(unsigned* bar, volatile LAS unsigned* st) {
    XcdBarrier b; b.bar = bar; b.x = xb_xcc_id(); b.st = st;
    if (threadIdx.x == 0) (void)xb_add(&bar[XB_XCNT(b.x)], 1u);
    return b;
}
__device__ __forceinline__ void xcd_barrier_complete(unsigned* bar, unsigned x, unsigned& nloc, unsigned& nx) {
    const unsigned G = gridDim.x * gridDim.y * gridDim.z;
    unsigned sum, cnt, mine, sp = 0u;
    for (;;) {
        sum = 0u; cnt = 0u; mine = 0u;
#pragma unroll
        for (unsigned j = 0; j < 16; ++j) { const unsigned c = xb_ld(&bar[XB_XCNT(j)]); sum += c; cnt += (c > 0u) ? 1u : 0u; mine = (j == x) ? c : mine; }
        if (sum == G) break;
        __builtin_amdgcn_s_sleep(1);
        if ((++sp & 255u) == 0u) { if (xb_ld(&bar[XB_TMO])) break; if (sp > XB_SPIN_CAP) { atomicAdd(&bar[XB_TMO], 1u); break; } }
    }
    nloc = mine > 0u ? mine : 1u; nx = cnt > 0u ? cnt : 1u;
}
__device__ __forceinline__ void xcd_barrier(const XcdBarrier& b) {
    asm volatile("s_waitcnt vmcnt(0)" ::: "memory");
    __syncthreads();
    if (threadIdx.x == 0) {
        unsigned* bar = b.bar;
        __builtin_amdgcn_s_waitcnt(0);
        unsigned nloc = b.st[0], nx = b.st[1];
        if (nloc == 0u) { xcd_barrier_complete(bar, b.x, nloc, nx); b.st[0] = nloc; b.st[1] = nx; }
        const unsigned old = xb_add(&bar[XB_XSUB(b.x)], 1u);
        const unsigned gen = old / nloc;
        if (old + 1u == (gen + 1u) * nloc) {
            __builtin_amdgcn_fence(__ATOMIC_RELEASE, "agent");
            asm volatile("s_waitcnt vmcnt(0)" ::: "memory");
            const unsigned og = xb_add(&bar[XB_TOP], 1u);
            const unsigned tg = og / nx;
            if (og + 1u == (tg + 1u) * nx) xb_add(&bar[XB_TOPGEN], 1u);
            else XB_SPIN(xb_ld(&bar[XB_TOPGEN]) == tg, bar);
            __builtin_amdgcn_fence(__ATOMIC_ACQUIRE, "agent");
            xb_add(&bar[XB_XGEN(b.x)], 1u);
            asm volatile("s_waitcnt vmcnt(0)" ::: "memory");
        } else {
            XB_SPIN(xb_ld(&bar[XB_XGEN(b.x)]) == gen, bar);
            __builtin_amdgcn_fence(__ATOMIC_ACQUIRE, "agent");
            asm volatile("s_waitcnt vmcnt(0)" ::: "memory");
        }
    }
    __syncthreads();
}
#define PROBE_REP 0
#define PROBE_ML 0
#define PROBE_D1 0
#define PROBE_D2 0
#define PROBE_G3 1
namespace pg8 {
constexpr int BM = 256, BK = 64, HALF = 128, HTB = HALF * BK * 2, STAGE_BYTES = 8 * HTB, NXCD = 8, WGM = 8;
__host__ __device__ __forceinline__ int lds_byte(int r, int c) { const int st = (r >> 4) * 2 + (c >> 5), rr = r & 15, cc = c & 31, ob = rr * 64 + cc * 2; return st * 1024 + (ob ^ (((ob >> 9) & 1) << 5)); }
__host__ __device__ __forceinline__ void stage_rc(int b, int& R, int& C) { const int st = b / 1024, sb = b % 1024, swz = sb ^ (((sb >> 9) & 1) << 5); R = (st >> 1) * 16 + swz / 64; C = (st & 1) * 32 + (swz % 64) / 2; }
__host__ __device__ __forceinline__ int perm32(int rho) { const int n = rho >> 4, i = rho & 15; return 8 * (i >> 2) + 4 * n + (i & 3); }

struct Unit { int pm, pn; };
struct StaticOrder {
    int nM, nN, nwg, G, c;
    __device__ void init(int nM_, int nN_, int G_, int c_) { nM = nM_; nN = nN_; nwg = nM * nN; G = G_; c = c_; }
    __device__ bool next(int i, Unit& u) const {
        const long L = (long)i * G + c; if (L >= nwg) return false;
        int wgid = (int)L; { const int q = nwg / NXCD, r = nwg % NXCD, xcd = wgid % NXCD, off = wgid / NXCD; wgid = (xcd < r ? xcd * (q + 1) : r * (q + 1) + (xcd - r) * q) + off; }
        const int nig = WGM * nN, gid = wgid / nig, fm = gid * WGM, gsz = (nM - fm) < WGM ? (nM - fm) : WGM;
        u.pm = fm + ((wgid % nig) % gsz); u.pn = (wgid % nig) / gsz; return true;
    }
};
struct LinProv {
    StaticOrder so; const char* Bt; int K; int probe_same = 0;
    __device__ __forceinline__ bool next(int i, Unit& u) const { const bool r = so.next(i, u); if (probe_same) { u.pm &= 3; u.pn &= 3; } return r; }
    __device__ __forceinline__ void aoffs(const Unit& u, const int (&RA)[2], const int (&CA)[2], unsigned (&v)[2][2]) const {
#pragma unroll
        for (int h = 0; h < 2; ++h)
#pragma unroll
            for (int i = 0; i < 2; ++i) v[h][i] = (unsigned)((u.pm * BM + h * HALF + RA[i]) * K + CA[i]) * 2u;
    }
    __device__ __forceinline__ const char* bbase(const Unit& u) const { return Bt + (size_t)u.pn * BM * K * 2; }
};
struct GatherProv {
    StaticOrder so; const char* Bt; int K; const int* rowidx; const int* tile_e; int t_lo; size_t estride;
    __device__ __forceinline__ bool next(int i, Unit& u) const { return so.next(i, u); }
    __device__ __forceinline__ void aoffs(const Unit& u, const int (&RA)[2], const int (&CA)[2], unsigned (&v)[2][2]) const {
#pragma unroll
        for (int h = 0; h < 2; ++h)
#pragma unroll
            for (int i = 0; i < 2; ++i) { const int row = rowidx ? rowidx[(t_lo + u.pm) * BM + h * HALF + RA[i]] : (u.pm * BM + h * HALF + RA[i]); v[h][i] = (unsigned)(row * K + CA[i]) * 2u; }
    }
    __device__ __forceinline__ const char* bbase(const Unit& u) const { const int e = __builtin_amdgcn_readfirstlane(tile_e[t_lo + u.pm]); return Bt + (size_t)e * estride + (size_t)u.pn * BM * K * 2; }
};

struct EpiBf16 {
    static constexpr bool PERM = true;
    bf16_t* O; int ldc; bf16_t* X = nullptr; int xpn = -1;
    __device__ __forceinline__ void operator()(const f32x4 (&acc)[2][2][4][2], const Unit& u, int wr, int wc, int fr, int fq) const {
        const int row0 = u.pm * BM + wr * 64 + fr, col0 = u.pn * BM + wc * 32 + 8 * fq;
        const bool xc = (u.pn == xpn) && (wc < 2);
#pragma unroll
        for (int ai = 0; ai < 2; ++ai)
#pragma unroll
            for (int m = 0; m < 4; ++m) { bf16_t* rowp = O + (size_t)(row0 + ai * HALF + m * 16) * ldc + col0;
#pragma unroll
                for (int bj = 0; bj < 2; ++bj) { const f32x4 v0 = acc[ai][bj][m][0], v1 = acc[ai][bj][m][1];
                    u32x4 w; w.x = pk2(v0[0], v0[1]); w.y = pk2(v0[2], v0[3]); w.z = pk2(v1[0], v1[1]); w.w = pk2(v1[2], v1[3]);
                    *(u32x4*)(rowp + bj * HALF) = w;
                    if (bj == 0 && xc) *(u32x4*)(X + (size_t)(row0 + ai * HALF + m * 16) * 64 + wc * 32 + 8 * fq) = w; } }
    }
};
struct EpiGated {
    static constexpr bool PERM = true;
    bf16_t* O; int ldc; int nostore;
    __device__ __forceinline__ void operator()(const f32x4 (&acc)[2][2][4][2], const Unit& u, int wr, int wc, int fr, int fq) const {
        if (nostore == 1) return;
        if (nostore == 2) {
            const int wv = wr * 4 + wc; char* slab = (char*)O + ((size_t)(u.pm * 44 + u.pn) * 8 + wv) * 8192 + (fq * 16 + fr) * 16;
#pragma unroll
            for (int ai = 0; ai < 2; ++ai)
#pragma unroll
                for (int m = 0; m < 4; ++m) { float r[8];
#pragma unroll
                    for (int n = 0; n < 2; ++n)
#pragma unroll
                        for (int j = 0; j < 4; ++j) { const float a = acc[ai][0][m][n][j], b = acc[ai][1][m][n][j]; r[n * 4 + j] = a * b * __builtin_amdgcn_rcpf(1.0f + __expf(-a)); }
                    u32x4 w; w.x = pk2(r[0], r[1]); w.y = pk2(r[2], r[3]); w.z = pk2(r[4], r[5]); w.w = pk2(r[6], r[7]);
                    *(u32x4*)(slab + (ai * 4 + m) * 1024) = w; }
            return; }
        const int row0 = u.pm * BM + wr * 64 + fr, col0 = u.pn * HALF + wc * 32 + 8 * fq;
#pragma unroll
        for (int ai = 0; ai < 2; ++ai)
#pragma unroll
            for (int m = 0; m < 4; ++m) { bf16_t* rowp = O + (size_t)(row0 + ai * HALF + m * 16) * ldc + col0;
                float r[8];
#pragma unroll
                for (int n = 0; n < 2; ++n)
#pragma unroll
                    for (int j = 0; j < 4; ++j) { const float a = acc[ai][0][m][n][j], b = acc[ai][1][m][n][j]; r[n * 4 + j] = a * b * __builtin_amdgcn_rcpf(1.0f + __expf(-a)); }
                u32x4 w; w.x = pk2(r[0], r[1]); w.y = pk2(r[2], r[3]); w.z = pk2(r[4], r[5]); w.w = pk2(r[6], r[7]);
                *(u32x4*)rowp = w; }
    }
};
struct EpiResBf16S {
    static constexpr bool PERM = true;
    bf16_t* C; const bf16_t* H; int ldc; float alpha, scale;
    __device__ __forceinline__ void operator()(const f32x4 (&acc)[2][2][4][2], const Unit& u, int wr, int wc, int fr, int fq) const {
        const int row0 = u.pm * BM + wr * 64 + fr, col0 = u.pn * BM + wc * 32 + 8 * fq;
#pragma unroll
        for (int ai = 0; ai < 2; ++ai)
#pragma unroll
            for (int m = 0; m < 4; ++m) { const size_t off = (size_t)(row0 + ai * HALF + m * 16) * ldc + col0;
#pragma unroll
                for (int bj = 0; bj < 2; ++bj) { const u32x4 hv = *(const u32x4*)(H + off + bj * HALF); const f32x4 v0 = acc[ai][bj][m][0] * scale, v1 = acc[ai][bj][m][1] * scale;
                    u32x4 w; w.x = pk2(alpha * bflo(hv.x) + v0[0], alpha * bfhi(hv.x) + v0[1]); w.y = pk2(alpha * bflo(hv.y) + v0[2], alpha * bfhi(hv.y) + v0[3]);
                    w.z = pk2(alpha * bflo(hv.z) + v1[0], alpha * bfhi(hv.z) + v1[1]); w.w = pk2(alpha * bflo(hv.w) + v1[2], alpha * bfhi(hv.w) + v1[3]);
                    *(u32x4*)(C + off + bj * HALF) = w; } }
    }
};
struct EpiBf16S {
    static constexpr bool PERM = true;
    bf16_t* O; int ldc; float scale;
    __device__ __forceinline__ void operator()(const f32x4 (&acc)[2][2][4][2], const Unit& u, int wr, int wc, int fr, int fq) const {
        const int row0 = u.pm * BM + wr * 64 + fr, col0 = u.pn * BM + wc * 32 + 8 * fq;
#pragma unroll
        for (int ai = 0; ai < 2; ++ai)
#pragma unroll
            for (int m = 0; m < 4; ++m) { bf16_t* rowp = O + (size_t)(row0 + ai * HALF + m * 16) * ldc + col0;
#pragma unroll
                for (int bj = 0; bj < 2; ++bj) { const f32x4 v0 = acc[ai][bj][m][0] * scale, v1 = acc[ai][bj][m][1] * scale;
                    u32x4 w; w.x = pk2(v0[0], v0[1]); w.y = pk2(v0[2], v0[3]); w.z = pk2(v1[0], v1[1]); w.w = pk2(v1[2], v1[3]);
                    *(u32x4*)(rowp + bj * HALF) = w; } }
    }
};
struct EpiGatedS {
    static constexpr bool PERM = true;
    bf16_t* O; int ldc; float sin;
    __device__ __forceinline__ void operator()(const f32x4 (&acc)[2][2][4][2], const Unit& u, int wr, int wc, int fr, int fq) const {
        const int row0 = u.pm * BM + wr * 64 + fr, col0 = u.pn * HALF + wc * 32 + 8 * fq;
#pragma unroll
        for (int ai = 0; ai < 2; ++ai)
#pragma unroll
            for (int m = 0; m < 4; ++m) { bf16_t* rowp = O + (size_t)(row0 + ai * HALF + m * 16) * ldc + col0;
                float r[8];
#pragma unroll
                for (int n = 0; n < 2; ++n)
#pragma unroll
                    for (int j = 0; j < 4; ++j) { const float a = acc[ai][0][m][n][j] * sin, b = acc[ai][1][m][n][j] * sin; r[n * 4 + j] = a * b * __builtin_amdgcn_rcpf(1.0f + __expf(-a)); }
                u32x4 w; w.x = pk2(r[0], r[1]); w.y = pk2(r[2], r[3]); w.z = pk2(r[4], r[5]); w.w = pk2(r[6], r[7]);
                *(u32x4*)rowp = w; }
    }
};
struct EpiGatedF8 {
    static constexpr bool PERM = true;
    unsigned char* O; int ldc; float sin, sout;
    __device__ __forceinline__ void operator()(const f32x4 (&acc)[2][2][4][2], const Unit& u, int wr, int wc, int fr, int fq) const {
        const int row0 = u.pm * BM + wr * 64 + fr, col0 = u.pn * HALF + wc * 32 + 8 * fq;
        const float sb = sin * sout;
#pragma unroll
        for (int ai = 0; ai < 2; ++ai)
#pragma unroll
            for (int m = 0; m < 4; ++m) { unsigned char* rowp = O + (size_t)(row0 + ai * HALF + m * 16) * ldc + col0;
                float r[8];
#pragma unroll
                for (int n = 0; n < 2; ++n)
#pragma unroll
                    for (int j = 0; j < 4; ++j) { const float a = acc[ai][0][m][n][j] * sin, b = acc[ai][1][m][n][j] * sb; r[n * 4 + j] = a * b * __builtin_amdgcn_rcpf(1.0f + __expf(-a)); }
                u32x2 w; w.x = pk4_f8(r[0], r[1], r[2], r[3]); w.y = pk4_f8(r[4], r[5], r[6], r[7]);
                *(u32x2*)rowp = w; }
    }
};
struct EpiResBf16 {
    static constexpr bool PERM = true;
    bf16_t* C; const bf16_t* H; int ldc; float alpha;
    __device__ __forceinline__ void operator()(const f32x4 (&acc)[2][2][4][2], const Unit& u, int wr, int wc, int fr, int fq) const {
        const int row0 = u.pm * BM + wr * 64 + fr, col0 = u.pn * BM + wc * 32 + 8 * fq;
#pragma unroll
        for (int ai = 0; ai < 2; ++ai)
#pragma unroll
            for (int m = 0; m < 4; ++m) { const size_t off = (size_t)(row0 + ai * HALF + m * 16) * ldc + col0;
#pragma unroll
                for (int bj = 0; bj < 2; ++bj) { const u32x4 hv = *(const u32x4*)(H + off + bj * HALF); const f32x4 v0 = acc[ai][bj][m][0], v1 = acc[ai][bj][m][1];
                    u32x4 w; w.x = pk2(alpha * bflo(hv.x) + v0[0], alpha * bfhi(hv.x) + v0[1]); w.y = pk2(alpha * bflo(hv.y) + v0[2], alpha * bfhi(hv.y) + v0[3]);
                    w.z = pk2(alpha * bflo(hv.z) + v1[0], alpha * bfhi(hv.z) + v1[1]); w.w = pk2(alpha * bflo(hv.w) + v1[2], alpha * bfhi(hv.w) + v1[3]);
                    *(u32x4*)(C + off + bj * HALF) = w; } }
    }
};

typedef int i32x4v __attribute__((ext_vector_type(4)));
typedef int i32x8v __attribute__((ext_vector_type(8)));
template <int MODE> struct Frag;
template <> struct Frag<0> { bf16x8 v[2]; };
template <> struct Frag<1> { i32x8v v; };
template <> struct Frag<2> { i32x4v v[2]; };
__device__ __forceinline__ void ldfrag(Frag<0>& f, const LAS unsigned char* p) { f.v[0] = *(const LAS bf16x8*)p; f.v[1] = *(const LAS bf16x8*)(p + 1024); }
__device__ __forceinline__ void ldfrag(Frag<1>& f, const LAS unsigned char* p) { const i32x4v a = *(const LAS i32x4v*)p, b = *(const LAS i32x4v*)(p + 1024); f.v = __builtin_shufflevector(a, b, 0, 1, 2, 3, 4, 5, 6, 7); }
__device__ __forceinline__ void ldfrag(Frag<2>& f, const LAS unsigned char* p) { f.v[0] = *(const LAS i32x4v*)p; f.v[1] = *(const LAS i32x4v*)(p + 1024); }
__device__ __forceinline__ void mmafrag(f32x4& acc, const Frag<0>& b, const Frag<0>& a) { acc = __builtin_amdgcn_mfma_f32_16x16x32_bf16(b.v[0], a.v[0], acc, 0, 0, 0); acc = __builtin_amdgcn_mfma_f32_16x16x32_bf16(b.v[1], a.v[1], acc, 0, 0, 0); }
__device__ __forceinline__ void mmafrag(f32x4& acc, const Frag<1>& b, const Frag<1>& a) { acc = __builtin_amdgcn_mfma_scale_f32_16x16x128_f8f6f4(b.v, a.v, acc, 0, 0, 0, 0, 0, 0); }
__device__ __forceinline__ void mmafrag(f32x4& acc, const Frag<2>& b, const Frag<2>& a) {
    i32x4v c = __builtin_bit_cast(i32x4v, acc); c = __builtin_amdgcn_mfma_i32_16x16x64_i8(b.v[0], a.v[0], c, 0, 0, 0); c = __builtin_amdgcn_mfma_i32_16x16x64_i8(b.v[1], a.v[1], c, 0, 0, 0); acc = __builtin_bit_cast(f32x4, c); }
template <class Epi, class Prov, int MODE = 0>
__device__ __forceinline__ void gemm_phase(LAS unsigned char* lds, const char* Abase, const int K, const Prov& S, const Epi& E) {
    constexpr bool F8 = (MODE == 1);
    const int tid = threadIdx.x, wid = __builtin_amdgcn_readfirstlane(tid >> 6), lane = tid & 63, wr = wid >> 2, wc = wid & 3, fr = lane & 15, fq = lane >> 4;
    const int nt = K / BK;
    int RA[2], CA[2]; unsigned voffB[2];
#pragma unroll
    for (int i = 0; i < 2; ++i) { int R, C; stage_rc(tid * 16 + i * 8192, R, C); const int Rb = Epi::PERM ? ((R & ~31) + perm32(R & 31)) : R;
        RA[i] = R; CA[i] = C; voffB[i] = (unsigned)(Rb * K + C) * 2u; }
    const size_t kstep = (size_t)(BK * 2);
    const size_t hstep = (size_t)HALF * K * 2;
    const unsigned ldsw = (unsigned)wid * 1024u;
    const unsigned ldsb = (unsigned)(size_t)lds + ldsw;
    const int aoff = lds_byte(wr * 64 + fr, fq * 8), boff = lds_byte(wc * 32 + fr, fq * 8);
#define PG8_SA(b, h) (((b) * 2 + (h)) * HTB)
#define PG8_SB(b, h) ((4 + (b) * 2 + (h)) * HTB)
#define PG8_STAGE(bufoff, gbase, voff) do { _Pragma("unroll") for (int _i = 0; _i < 2; ++_i) { \
        if (F8) asm volatile("s_mov_b32 m0, %0\n\ts_nop 0\n\tglobal_load_lds_dwordx4 %1, %2" :: "s"(ldsb + (unsigned)((bufoff) + _i * 8192)), "v"((voff)[_i]), "s"((const char*)(gbase)) : "memory", "m0"); \
        else __builtin_amdgcn_global_load_lds((const unsigned*)((const char*)(gbase) + (voff)[_i]), (LAS unsigned*)(lds + (bufoff) + ldsw + _i * 8192), 16, 0, 0); } } while (0)
#define PG8_LDA(dst, b, h) do { _Pragma("unroll") for (int m = 0; m < 4; ++m) ldfrag(dst[m], lds + PG8_SA(b, h) + aoff + m * 2048); } while (0)
#define PG8_LDB(dst, b, h) do { _Pragma("unroll") for (int n = 0; n < 2; ++n) ldfrag(dst[n], lds + PG8_SB(b, h) + boff + n * 2048); } while (0)
#define PG8_MMA(ai, bj, At, Bt) do { __builtin_amdgcn_s_setprio(1); _Pragma("unroll") for (int m = 0; m < 4; ++m) _Pragma("unroll") for (int n = 0; n < 2; ++n) { \
        if (F8) { f32x4 c_; _Pragma("unroll") for (int j_ = 0; j_ < 4; ++j_) c_[j_] = acc16[ai][bj][m >> 1][8 * (m & 1) + 4 * n + j_]; mmafrag(c_, Bt[n], At[m]); \
                  _Pragma("unroll") for (int j_ = 0; j_ < 4; ++j_) acc16[ai][bj][m >> 1][8 * (m & 1) + 4 * n + j_] = c_[j_]; } \
        else mmafrag(acc[ai][bj][m][n], Bt[n], At[m]); } __builtin_amdgcn_s_setprio(0); } while (0)
#define PG8_WAIT_V(n) asm volatile("s_waitcnt vmcnt(" #n ")" ::: "memory")
#define PG8_WAIT_L(n) asm volatile("s_waitcnt lgkmcnt(" #n ")" ::: "memory")
#define PG8_BAR __builtin_amdgcn_s_barrier()
#define PG8_SCHED __builtin_amdgcn_sched_barrier(0)
    Unit cur, nxt; int ui = 0;
    if (!S.next(0, cur)) return;
    f32x4 acc[2][2][4][2];
    f32x16 acc16[2][2][2];
#pragma unroll
    for (int a = 0; a < 2; ++a)
#pragma unroll
        for (int b = 0; b < 2; ++b)
#pragma unroll
            for (int q = 0; q < 2; ++q)
#pragma unroll
                for (int j = 0; j < 16; ++j) acc16[a][b][q][j] = 0.f;
#pragma unroll
    for (int a = 0; a < 2; ++a)
#pragma unroll
        for (int b = 0; b < 2; ++b)
#pragma unroll
            for (int m = 0; m < 4; ++m)
#pragma unroll
                for (int n = 0; n < 2; ++n) acc[a][b][m][n] = (f32x4){0.f, 0.f, 0.f, 0.f};
    Frag<MODE> At[4], B0[2], B1[2];
    unsigned vAc[2][2], vAn[2][2];
    S.aoffs(cur, RA, CA, vAc);
    const char* cB = S.bbase(cur);
    const char* A0 = Abase;
    PG8_STAGE(PG8_SB(0, 0), cB, voffB); PG8_STAGE(PG8_SA(0, 0), A0, vAc[0]); PG8_STAGE(PG8_SB(0, 1), cB + hstep, voffB); PG8_STAGE(PG8_SA(0, 1), A0, vAc[1]);
    if (wr == 1) PG8_BAR;
    PG8_WAIT_V(4); PG8_BAR;
    PG8_STAGE(PG8_SB(1, 0), cB + kstep, voffB); PG8_STAGE(PG8_SA(1, 0), A0 + kstep, vAc[0]); PG8_STAGE(PG8_SB(1, 1), cB + hstep + kstep, voffB);
    PG8_WAIT_V(6); PG8_BAR;
    for (;;) {
        const bool has_next = S.next(ui + 1, nxt);
        const char* nB = cB;
        if (has_next) { S.aoffs(nxt, RA, CA, vAn); nB = S.bbase(nxt); }
        else {
#pragma unroll
            for (int h = 0; h < 2; ++h)
#pragma unroll
                for (int i = 0; i < 2; ++i) vAn[h][i] = vAc[h][i];
        }
        for (int t = 0; t < nt; t += 2) {
            const bool last = (t == nt - 2);
            const char* a1 = A0 + (size_t)(t + 1) * kstep;
            const char* a2 = last ? A0 : A0 + (size_t)(t + 2) * kstep; const char* b2 = last ? nB : cB + (size_t)(t + 2) * kstep;
            const char* a3 = a2 + kstep; const char* b3 = b2 + kstep;
            unsigned v2[2][2];
#pragma unroll
            for (int h = 0; h < 2; ++h)
#pragma unroll
                for (int i = 0; i < 2; ++i) v2[h][i] = last ? vAn[h][i] : vAc[h][i];
            PG8_LDB(B0, 0, 0); PG8_SCHED; PG8_LDA(At, 0, 0); PG8_STAGE(PG8_SA(1, 1), a1, vAc[1]);
            PG8_WAIT_L(8); PG8_BAR; PG8_WAIT_L(0); PG8_MMA(0, 0, At, B0); PG8_BAR; PG8_SCHED;
            PG8_LDB(B1, 0, 1); PG8_STAGE(PG8_SB(0, 0), b2, voffB);
            PG8_BAR; PG8_WAIT_L(0); PG8_MMA(0, 1, At, B1); PG8_BAR;
            PG8_LDA(At, 0, 1); PG8_STAGE(PG8_SA(0, 0), a2, v2[0]);
            PG8_BAR; PG8_WAIT_L(0); PG8_MMA(1, 0, At, B0); PG8_BAR; PG8_SCHED;
            PG8_STAGE(PG8_SB(0, 1), b2 + hstep, voffB);
            PG8_WAIT_V(6); PG8_BAR; PG8_MMA(1, 1, At, B1); PG8_BAR;
            PG8_LDB(B0, 1, 0); PG8_SCHED; PG8_LDA(At, 1, 0); PG8_STAGE(PG8_SA(0, 1), a2, v2[1]);
            PG8_WAIT_L(8); PG8_BAR; PG8_WAIT_L(0); PG8_MMA(0, 0, At, B0); PG8_BAR; PG8_SCHED;
            PG8_LDB(B1, 1, 1); PG8_STAGE(PG8_SB(1, 0), b3, voffB);
            PG8_BAR; PG8_WAIT_L(0); PG8_MMA(0, 1, At, B1); PG8_BAR;
            PG8_LDA(At, 1, 1); PG8_STAGE(PG8_SA(1, 0), a3, v2[0]);
            PG8_BAR; PG8_WAIT_L(0); PG8_MMA(1, 0, At, B0); PG8_BAR; PG8_SCHED;
            PG8_STAGE(PG8_SB(1, 1), b3 + hstep, voffB);
            PG8_WAIT_V(6); PG8_BAR; PG8_MMA(1, 1, At, B1); PG8_BAR;
        }
        if (F8) {
#pragma unroll
            for (int a = 0; a < 2; ++a)
#pragma unroll
                for (int b = 0; b < 2; ++b)
#pragma unroll
                    for (int m = 0; m < 4; ++m)
#pragma unroll
                        for (int n = 0; n < 2; ++n)
#pragma unroll
                            for (int j = 0; j < 4; ++j) { acc[a][b][m][n][j] = acc16[a][b][m >> 1][8 * (m & 1) + 4 * n + j]; acc16[a][b][m >> 1][8 * (m & 1) + 4 * n + j] = 0.f; }
        }
        if (MODE == 2) {
#pragma unroll
            for (int a = 0; a < 2; ++a)
#pragma unroll
                for (int b = 0; b < 2; ++b)
#pragma unroll
                    for (int m = 0; m < 4; ++m)
#pragma unroll
                        for (int n = 0; n < 2; ++n)
#pragma unroll
                            for (int j = 0; j < 4; ++j) acc[a][b][m][n][j] = (float)__float_as_int(acc[a][b][m][n][j]);
        }
        E(acc, cur, wr, wc, fr, fq);
        if (!has_next) break;
#pragma unroll
        for (int a = 0; a < 2; ++a)
#pragma unroll
            for (int b = 0; b < 2; ++b)
#pragma unroll
                for (int m = 0; m < 4; ++m)
#pragma unroll
                    for (int n = 0; n < 2; ++n) acc[a][b][m][n] = (f32x4){0.f, 0.f, 0.f, 0.f};
        cur = nxt; cB = nB; ++ui;
#pragma unroll
        for (int h = 0; h < 2; ++h)
#pragma unroll
            for (int i = 0; i < 2; ++i) vAc[h][i] = vAn[h][i];
    }
    PG8_WAIT_V(0);
    if (wr == 0) PG8_BAR;
    PG8_BAR;
#undef PG8_SA
#undef PG8_SB
#undef PG8_STAGE
#undef PG8_LDA
#undef PG8_LDB
#undef PG8_MMA
#undef PG8_WAIT_V
#undef PG8_WAIT_L
#undef PG8_BAR
#undef PG8_SCHED
}
}
struct Frame {
    LAS unsigned char* lds;
    unsigned* ctl;
    unsigned char* ws;
    const float* in[35];
    float* out;
    int tid, lane, wave, G, bid;
};
enum { I_X = 0, I_META, I_WINE, I_CONVW, I_ARE, I_AIM, I_LOGDT, I_BRE, I_BIM, I_CRE, I_CIM, I_S5D, I_WGLU, I_WOUTE, I_LN1G, I_LN1B, I_W1, I_W3, I_W2, I_LN2G, I_LN2B,
       I_WINO, I_MBI, I_MBF, I_RELB, I_WOUTO, I_LN3G, I_LN3B, I_RW, I_RB, I_EW1, I_EW3, I_EW2, I_LN4G, I_LN4B };

struct SrcRef { const float* p; int col; float sc; };
template <class F> __device__ __forceinline__ void transpose_item(const F& f, int ldw, bf16_t* dst, int Kd, int k0, int n0, LAS float* scr, int lane) {
    const SrcRef s = f(n0 + (lane & 31));
#pragma unroll 8
    for (int i = 0; i < 32; ++i) { const int kk = 2 * i + (lane >> 5); scr[kk * 33 + (lane & 31)] = s.p[(size_t)(k0 + kk) * ldw + s.col] * s.sc; }
    LDS_WAIT();
    const int c = lane & 7;
#pragma unroll
    for (int j = 0; j < 4; ++j) { const int n = (lane >> 3) + 8 * j; const LAS float* sp = scr + (8 * c) * 33 + n;
        u32x4 o; o.x = pk2(sp[0 * 33], sp[1 * 33]); o.y = pk2(sp[2 * 33], sp[3 * 33]); o.z = pk2(sp[4 * 33], sp[5 * 33]); o.w = pk2(sp[6 * 33], sp[7 * 33]);
        *(u32x4*)(dst + (size_t)(n0 + n) * Kd + k0 + 8 * c) = o; }
    LDS_WAIT();
}
#define PK4(a, b, c, d) (I8 ? pk4_i8(a, b, c, d) : pk4_f8(a, b, c, d))
template <bool I8, class F> __device__ __forceinline__ void transpose_item_f8(const F& f, int ldw, unsigned char* dst, int Kd, int k0, int n0, float scale, LAS float* scr, int lane) {
    const SrcRef s = f(n0 + (lane & 31));
#pragma unroll 8
    for (int i = 0; i < 32; ++i) { const int kk = 2 * i + (lane >> 5); scr[kk * 33 + (lane & 31)] = s.p[(size_t)(k0 + kk) * ldw + s.col] * (s.sc * scale); }
    LDS_WAIT();
    const int c = lane & 3;
#pragma unroll
    for (int j = 0; j < 2; ++j) { const int n = (lane >> 2) + 16 * j; const LAS float* sp = scr + (16 * c) * 33 + n;
        u32x4 o; o.x = PK4(sp[0 * 33], sp[1 * 33], sp[2 * 33], sp[3 * 33]); o.y = PK4(sp[4 * 33], sp[5 * 33], sp[6 * 33], sp[7 * 33]);
        o.z = PK4(sp[8 * 33], sp[9 * 33], sp[10 * 33], sp[11 * 33]); o.w = PK4(sp[12 * 33], sp[13 * 33], sp[14 * 33], sp[15 * 33]);
        *(u32x4*)(dst + (size_t)(n0 + n) * Kd + k0 + 16 * c) = o; }
    LDS_WAIT();
}
#undef PK4
struct MapIdent { const float* w; __device__ __forceinline__ SrcRef operator()(int n) const { return SrcRef{w, n, 1.f}; } };
struct MapGated { const float* w1; const float* w3; __device__ __forceinline__ SrcRef operator()(int n) const { const int t = n >> 8, r = n & 255; return r < 128 ? SrcRef{w1, t * 128 + r, 1.f} : SrcRef{w3, t * 128 + r - 128, 1.f}; } };
struct MapOddA { const float* w; __device__ __forceinline__ SrcRef operator()(int n) const {
    int c;
    if (n < 1024) c = n;
    else if (n < 2048) c = 3072 + (n - 1024);
    else if (n < 3072) c = 4104 + (n - 2048);
    else if (n < 4096) c = 5128 + (n - 3072);
    else if (n < 4608) c = 7176 + (n - 4096);
    else if (n < 4672) c = 7688 + (n - 4608);
    else if (n < 4676) c = 4096 + (n - 4672);
    else if (n < 4680) c = 4100 + (n - 4676);
    else if (n < 4688) c = 7752 + (n - 4680);
    else return SrcRef{w, 0, 0.f};
    return SrcRef{w, c, 1.f}; } };
struct MapOddB { const float* w; __device__ __forceinline__ SrcRef operator()(int n) const {
    int c;
    if (n < 1024) c = 1024 + n;
    else if (n < 2048) c = 2048 + (n - 1024);
    else c = 6152 + (n - 2048);
    return SrcRef{w, c, 1.f}; } };

__device__ __forceinline__ void p0_prologue(Frame& F) {
    LAS float* scr = (LAS float*)(F.lds + F.wave * 16384);
    const int gw = F.bid * NWAVES + F.wave, NGW = F.G * NWAVES;
    bf16_t* WINE = (bf16_t*)(F.ws + WS_WINE); bf16_t* WOUTE = (bf16_t*)(F.ws + WS_WOUTE);
    bf16_t* WINOA = (bf16_t*)(F.ws + WS_WINOA); bf16_t* WINOB = (bf16_t*)(F.ws + WS_WINOB); bf16_t* WOUTO = (bf16_t*)(F.ws + WS_WOUTO);
    constexpr int I1 = (NIN_E / 32) * (D / 64), I2 = (D / 32) * (D / 64), I3 = (N13 / 32) * (D / 64), I4 = (D / 32) * (DFF / 64), I5 = (NIN_OA / 32) * (D / 64), I6 = (NIN_OB / 32) * (D / 64), I7 = I2;
    constexpr int NITEMS = I1 + I2 + I3 + I4 + I5 + I6 + I7;
    for (int it = gw; it < NITEMS; it += NGW) {
        int r = it;
        if (r < I1) { const int nb = NIN_E / 32; transpose_item(MapIdent{F.in[I_WINE]}, NIN_E, WINE, D, (r / nb) * 64, (r % nb) * 32, scr, F.lane); continue; } r -= I1;
        if (r < I2) { const int nb = D / 32; transpose_item(MapIdent{F.in[I_WOUTE]}, D, WOUTE, D, (r / nb) * 64, (r % nb) * 32, scr, F.lane); continue; } r -= I2;
        if (r < I3) { const int nb = N13 / 32; transpose_item_f8<true>(MapGated{F.in[I_W1], F.in[I_W3]}, DFF, F.ws + WS_W13, D, (r / nb) * 64, (r % nb) * 32, I8S_W13, scr, F.lane); continue; } r -= I3;
        if (r < I4) { const int nb = D / 32;
#if FFN_DOWN_F8
            transpose_item_f8<false>(MapIdent{F.in[I_W2]}, D, F.ws + WS_W2, DFF, (r / nb) * 64, (r % nb) * 32, F8S_W2, scr, F.lane);
#else
            transpose_item(MapIdent{F.in[I_W2]}, D, (bf16_t*)(F.ws + WS_W2), DFF, (r / nb) * 64, (r % nb) * 32, scr, F.lane);
#endif
            continue; } r -= I4;
        if (r < I5) { const int nb = NIN_OA / 32; transpose_item(MapOddA{F.in[I_WINO]}, 7760, WINOA, D, (r / nb) * 64, (r % nb) * 32, scr, F.lane); continue; } r -= I5;
        if (r < I6) { const int nb = NIN_OB / 32; transpose_item(MapOddB{F.in[I_WINO]}, 7760, WINOB, D, (r / nb) * 64, (r % nb) * 32, scr, F.lane); continue; } r -= I6;
        { const int nb = D / 32; transpose_item(MapIdent{F.in[I_WOUTO]}, D, WOUTO, D, (r / nb) * 64, (r % nb) * 32, scr, F.lane); }
    }
    bf16_t* HA = (bf16_t*)(F.ws + WS_HA);
    const size_t gt = (size_t)F.bid * NTHREADS + F.tid, NGT = (size_t)F.G * NTHREADS;
    for (size_t e = gt; e < (size_t)M * (D / 8); e += NGT) {
        const int r = (int)(e / (D / 8)), c = (int)(e % (D / 8)) * 8, b = r / LP, pos = r % LP;
        u32x4 o = (u32x4){0u, 0u, 0u, 0u};
        if (pos < LR) { const float* src = pos < NMETA ? F.in[I_META] + (size_t)pos * D + c : F.in[I_X] + ((size_t)b * SEQ + (pos - NMETA)) * D + c;
            const f32x4 v0 = *(const f32x4*)src, v1 = *(const f32x4*)(src + 4);
            o.x = pk2(v0[0], v0[1]); o.y = pk2(v0[2], v0[3]); o.z = pk2(v1[0], v1[1]); o.w = pk2(v1[2], v1[3]); }
        *(u32x4*)(HA + (size_t)r * D + c) = o;
    }
    if (gt < 2048) {
        const int gp = (int)gt, g = gp >> 6;
        const double are = F.in[I_ARE][gp], aim = F.in[I_AIM][gp], dt = exp((double)F.in[I_LOGDT][g]);
        const double er = exp(dt * are), abr = er * cos(dt * aim), abi = er * sin(dt * aim);
        const double erp = exp(S5CH * dt * are), apr = erp * cos(S5CH * dt * aim), api = erp * sin(S5CH * dt * aim);
        const double nr = abr - 1.0, ni = abi, den = are * are + aim * aim;
        const double qr = (nr * are + ni * aim) / den, qi = (ni * are - nr * aim) / den;
        float* T = (float*)(F.ws + WS_S5T);
        T[gp * 2 + 0] = (float)abr; T[gp * 2 + 1] = (float)abi;
        T[4096 + gp * 2 + 0] = (float)apr; T[4096 + gp * 2 + 1] = (float)api;
        float* BB = T + 8192 + gp * 32;
        for (int c = 0; c < 16; ++c) { const double br = F.in[I_BRE][gp * 16 + c], bi = F.in[I_BIM][gp * 16 + c];
            BB[2 * c + 0] = (float)(qr * br - qi * bi); BB[2 * c + 1] = (float)(qr * bi + qi * br); }
        float* PW = T + 73728 + gp * 18;
        double pr = 1.0, pi = 0.0;
        for (int tau = 0; tau <= 8; ++tau) { PW[2 * tau] = (float)pr; PW[2 * tau + 1] = (float)pi; const double nr2 = pr * abr - pi * abi, ni2 = pr * abi + pi * abr; pr = nr2; pi = ni2; }
    }
}

template <class F> __device__ __forceinline__ void transpose_item32(const F& f, int ldw, bf16_t* dst, int Kd, int k0, int n0, LAS float* scr, int lane) {
    const SrcRef s = f(n0 + (lane & 31));
#pragma unroll 8
    for (int i = 0; i < 16; ++i) { const int kk = 2 * i + (lane >> 5); scr[kk * 33 + (lane & 31)] = s.p[(size_t)(k0 + kk) * ldw + s.col] * s.sc; }
    LDS_WAIT();
    const int c = lane & 3;
#pragma unroll
    for (int j = 0; j < 2; ++j) { const int n = (lane >> 2) + 16 * j; const LAS float* sp = scr + (8 * c) * 33 + n;
        u32x4 o; o.x = pk2(sp[0 * 33], sp[1 * 33]); o.y = pk2(sp[2 * 33], sp[3 * 33]); o.z = pk2(sp[4 * 33], sp[5 * 33]); o.w = pk2(sp[6 * 33], sp[7 * 33]);
        *(u32x4*)(dst + (size_t)(n0 + n) * Kd + k0 + 8 * c) = o; }
    LDS_WAIT();
}
template <class F> __device__ __forceinline__ void transpose_item32_f8(const F& f, int ldw, unsigned char* dst, int Kd, int k0, int n0, float scale, LAS float* scr, int lane) {
    const SrcRef s = f(n0 + (lane & 31));
#pragma unroll 8
    for (int i = 0; i < 16; ++i) { const int kk = 2 * i + (lane >> 5); scr[kk * 33 + (lane & 31)] = s.p[(size_t)(k0 + kk) * ldw + s.col] * (s.sc * scale); }
    LDS_WAIT();
    const int c = lane & 1, n = lane >> 1; const LAS float* sp = scr + (16 * c) * 33 + n;
    u32x4 o; o.x = pk4_f8(sp[0 * 33], sp[1 * 33], sp[2 * 33], sp[3 * 33]); o.y = pk4_f8(sp[4 * 33], sp[5 * 33], sp[6 * 33], sp[7 * 33]);
    o.z = pk4_f8(sp[8 * 33], sp[9 * 33], sp[10 * 33], sp[11 * 33]); o.w = pk4_f8(sp[12 * 33], sp[13 * 33], sp[14 * 33], sp[15 * 33]);
    *(u32x4*)(dst + (size_t)(n0 + n) * Kd + k0 + 16 * c) = o;
    LDS_WAIT();
}
__device__ __forceinline__ void convert_experts(Frame& F) {
    LAS float* scr = (LAS float*)(F.lds + 4 * D1_WAVE_BYTES + (F.wave - 4) * 4352);
    const int gw = F.bid * 4 + (F.wave - 4), NGW = F.G * 4;
    constexpr int J1 = (N13 / 32) * (D / 32), J2 = (D / 32) * (DFF / 32);
    for (int it = gw; it < NEXP * (J1 + J2); it += NGW) {
        const int e = it / (J1 + J2); int r = it % (J1 + J2);
        if (r < J1) { const int nb = N13 / 32; transpose_item32_f8(MapGated{F.in[I_EW1] + (size_t)e * D * DFF, F.in[I_EW3] + (size_t)e * D * DFF}, DFF, F.ws + WS_EW13 + (size_t)e * N13 * D, D, (r / nb) * 32, (r % nb) * 32, F8S_W13, scr, F.lane); }
        else { r -= J1; const int nb = D / 32; transpose_item32_f8(MapIdent{F.in[I_EW2] + (size_t)e * DFF * D}, D, F.ws + WS_EW2 + (size_t)e * D * DFF, DFF, (r / nb) * 32, (r % nb) * 32, F8S_W2, scr, F.lane); }
    }
}

__device__ __forceinline__ void cvt8(const u32x4 w, float (&f)[8]) { f[0] = bflo(w.x); f[1] = bfhi(w.x); f[2] = bflo(w.y); f[3] = bfhi(w.y); f[4] = bflo(w.z); f[5] = bfhi(w.z); f[6] = bflo(w.w); f[7] = bfhi(w.w); }
__device__ __forceinline__ void conv_phase(Frame& F, int wg0, int nwg) {
    const bf16_t* P = (const bf16_t*)(F.ws + WS_P); bf16_t* Y = (bf16_t*)(F.ws + WS_Y);
    const float* cw = F.in[I_CONVW];
    constexpr int STRIP = 16, NSTRIP = LP / STRIP, NCG = DCONV / 8;
    const int gt = (F.bid - wg0) * NTHREADS + F.tid, NGT = nwg * NTHREADS;
    for (int it = gt; it < NB * NSTRIP * NCG; it += NGT) {
        const int cg = it % NCG, sp = (it / NCG) % NSTRIP, b = it / (NCG * NSTRIP), c = cg * 8, p0 = sp * STRIP;
        float w0[8], w1[8], w2[8];
#pragma unroll
        for (int j = 0; j < 8; ++j) { w0[j] = cw[c + j]; w1[j] = cw[DCONV + c + j]; w2[j] = cw[2 * DCONV + c + j]; }
        float z1[8], z2[8];
#pragma unroll
        for (int j = 0; j < 8; ++j) { z1[j] = 0.f; z2[j] = 0.f; }
        for (int d = 2; d >= 1; --d) { const int pos = p0 - d; if (pos >= 0) { const bf16_t* row = P + (size_t)(b * LP + pos) * NIN_E;
                float cgv[8], xv[8]; cvt8(*(const u32x4*)(row + DCONV + c), cgv); cvt8(*(const u32x4*)(row + 2 * DCONV + c), xv);
#pragma unroll
                for (int j = 0; j < 8; ++j) { if (d == 2) z2[j] = cgv[j] * xv[j]; else z1[j] = cgv[j] * xv[j]; } } }
        for (int s4 = 0; s4 < STRIP; s4 += 4) {
            u32x4 rb[4], rc[4], rx[4];
#pragma unroll
            for (int q = 0; q < 4; ++q) { const bf16_t* row = P + (size_t)(b * LP + p0 + s4 + q) * NIN_E; rb[q] = *(const u32x4*)(row + c); rc[q] = *(const u32x4*)(row + DCONV + c); rx[q] = *(const u32x4*)(row + 2 * DCONV + c); }
#pragma unroll
            for (int q = 0; q < 4; ++q) { const int pos = p0 + s4 + q;
                float bg[8], cgv[8], xv[8]; cvt8(rb[q], bg); cvt8(rc[q], cgv); cvt8(rx[q], xv);
                float o[8];
#pragma unroll
                for (int j = 0; j < 8; ++j) { const float z0 = cgv[j] * xv[j]; o[j] = bg[j] * (w0[j] * z2[j] + w1[j] * z1[j] + w2[j] * z0); z2[j] = z1[j]; z1[j] = z0; }
                u32x4 w; w.x = pk2(o[0], o[1]); w.y = pk2(o[2], o[3]); w.z = pk2(o[4], o[5]); w.w = pk2(o[6], o[7]);
                *(u32x4*)(Y + (size_t)(b * LP + pos) * D + c) = w; } }
    }
}
constexpr size_t WS_MS5 = WS_XE;
__device__ __forceinline__ void s5_build_matrices(Frame& F) {
    const float* T = (const float*)(F.ws + WS_S5T); bf16_t* MS = (bf16_t*)(F.ws + WS_MS5);
    const int gt = F.bid * NTHREADS + F.tid, NGT = F.G * NTHREADS;
    for (int e = gt; e < 32 * 3 * 16384; e += NGT) {
        const int k = e & 127, r = (e >> 7) & 127, m = (e >> 14) % 3, g = e / (3 * 16384);
        const float* PW = T + 73728 + (size_t)g * 64 * 18; const float* BB = T + 8192 + (size_t)g * 64 * 32;
        float v = 0.f;
        if (m == 0) { const int t = r >> 4, c = r & 15, s = k >> 4, c2 = k & 15;
            if (s <= t) { const int tau = t - s; const float* cre = F.in[I_CRE] + ((size_t)g * 16 + c) * 64; const float* cim = F.in[I_CIM] + ((size_t)g * 16 + c) * 64;
                for (int p = 0; p < 64; ++p) { const float ar = PW[p * 18 + 2 * tau], ai = PW[p * 18 + 2 * tau + 1], br = BB[p * 32 + 2 * c2], bi = BB[p * 32 + 2 * c2 + 1];
                    const float abr_ = ar * br - ai * bi, abi_ = ar * bi + ai * br; v += cre[p] * abr_ - cim[p] * abi_; }
                if (tau == 0 && c == c2) v += F.in[I_S5D][g * 16 + c]; } }
        else if (m == 1) { const int p = r >> 1, ri = r & 1, s = k >> 4, c2 = k & 15; const int tau = 7 - s;
            const float ar = PW[p * 18 + 2 * tau], ai = PW[p * 18 + 2 * tau + 1], br = BB[p * 32 + 2 * c2], bi = BB[p * 32 + 2 * c2 + 1];
            v = ri ? (ar * bi + ai * br) : (ar * br - ai * bi); }
        else { const int t = r >> 4, c = r & 15, p = k >> 1, ri = k & 1; const int tau = t + 1;
            const float ar = PW[p * 18 + 2 * tau], ai = PW[p * 18 + 2 * tau + 1], cr = F.in[I_CRE][((size_t)g * 16 + c) * 64 + p], ci = F.in[I_CIM][((size_t)g * 16 + c) * 64 + p];
            v = ri ? -(cr * ai + ci * ar) : (cr * ar - ci * ai); }
        MS[e] = (bf16_t)f2bf(v);
    }
}
template <int CTRL> __device__ __forceinline__ float dpp_row_f(float old, float src) { return __int_as_float(__builtin_amdgcn_update_dpp(__float_as_int(old), __float_as_int(src), CTRL, 0xf, 0xf, false)); }
constexpr int S5X_ROW = 272, S5X_BUF = 16 * S5X_ROW;
template <bool SPLIT>
__device__ __forceinline__ void s5_ssd_unit(Frame& F, int b, int g, int half) {
    const bf16_t* P = (const bf16_t*)(F.ws + WS_P); bf16_t* Y = (bf16_t*)(F.ws + WS_Y);
    const float* T = (const float*)(F.ws + WS_S5T); const bf16_t* MS = (const bf16_t*)(F.ws + WS_MS5) + (size_t)g * 3 * 16384;
    const int lane = F.lane, w = F.wave, ql = lane & 15, gq = lane >> 4;
    bf16x8 A1[4], A2[4], A3[4];
#pragma unroll
    for (int ks = 0; ks < 4; ++ks) { const int off = (16 * w + ql) * 128 + 32 * ks + 8 * gq;
        A1[ks] = *(const bf16x8*)(MS + off); A2[ks] = *(const bf16x8*)(MS + 16384 + off); A3[ks] = *(const bf16x8*)(MS + 32768 + off); }
    float m1r[2], m1i[2], m2r[2], m2i[2], m4r[2], m4i[2], m8r[2], m8i[2];
#pragma unroll
    for (int j = 0; j < 2; ++j) { const float* PW = T + 73728 + ((size_t)g * 64 + 8 * w + 2 * gq + j) * 18 + 16;
        m1r[j] = PW[0]; m1i[j] = PW[1]; m2r[j] = m1r[j] * m1r[j] - m1i[j] * m1i[j]; m2i[j] = 2.f * m1r[j] * m1i[j];
        m4r[j] = m2r[j] * m2r[j] - m2i[j] * m2i[j]; m4i[j] = 2.f * m2r[j] * m2i[j]; m8r[j] = m4r[j] * m4r[j] - m4i[j] * m4i[j]; m8i[j] = 2.f * m4r[j] * m4i[j]; }
    bf16x8 Awg; { const float* wg = F.in[I_WGLU] + (size_t)g * 256 + ql * 16 + 4 * gq; u32x4 t_; t_.x = pk2(wg[0], wg[1]); t_.y = pk2(wg[2], wg[3]); t_.z = 0u; t_.w = 0u; Awg = __builtin_bit_cast(bf16x8, t_); }
    float cr[2] = {0.f, 0.f}, ci[2] = {0.f, 0.f};
    const size_t rowb = (size_t)b * LP;
    const bf16_t* ubase = P + (rowb + 8 * ql + (gq >> 1)) * NIN_E + 3 * DCONV + g * 16 + 8 * (gq & 1);
    bf16x8 Bu[4], Bn[4];
    constexpr int NCH = LP / 128, CSPLIT = 65;
    if (half) {
#pragma unroll
        for (int ks = 0; ks < 4; ++ks) Bu[ks] = *(const bf16x8*)(ubase + (size_t)(2 * ks) * NIN_E);
        for (int ch = 0; ch < CSPLIT; ++ch) {
            if (ch + 1 < CSPLIT) {
#pragma unroll
                for (int ks = 0; ks < 4; ++ks) Bn[ks] = *(const bf16x8*)(ubase + ((size_t)(ch + 1) * 128 + 2 * ks) * NIN_E); }
            f32x4 IN = (f32x4){0.f, 0.f, 0.f, 0.f};
#pragma unroll
            for (int ks = 0; ks < 4; ++ks) IN = __builtin_amdgcn_mfma_f32_16x16x32_bf16(A2[ks], Bu[ks], IN, 0, 0, 0);
            float er[2] = {IN[0], IN[2]}, ei[2] = {IN[1], IN[3]};
#pragma unroll
            for (int j = 0; j < 2; ++j) {
                if (ql == 0) { er[j] += m1r[j] * cr[j] - m1i[j] * ci[j]; ei[j] += m1r[j] * ci[j] + m1i[j] * cr[j]; }
                { const float tr = dpp_row_f<0x111>(0.f, er[j]), ti = dpp_row_f<0x111>(0.f, ei[j]); er[j] += m1r[j] * tr - m1i[j] * ti; ei[j] += m1r[j] * ti + m1i[j] * tr; }
                { const float tr = dpp_row_f<0x112>(0.f, er[j]), ti = dpp_row_f<0x112>(0.f, ei[j]); er[j] += m2r[j] * tr - m2i[j] * ti; ei[j] += m2r[j] * ti + m2i[j] * tr; }
                { const float tr = dpp_row_f<0x114>(0.f, er[j]), ti = dpp_row_f<0x114>(0.f, ei[j]); er[j] += m4r[j] * tr - m4i[j] * ti; ei[j] += m4r[j] * ti + m4i[j] * tr; }
                { const float tr = dpp_row_f<0x118>(0.f, er[j]), ti = dpp_row_f<0x118>(0.f, ei[j]); er[j] += m8r[j] * tr - m8i[j] * ti; ei[j] += m8r[j] * ti + m8i[j] * tr; }
                cr[j] = __shfl(er[j], (lane & 48) | 15); ci[j] = __shfl(ei[j], (lane & 48) | 15);
            }
#pragma unroll
            for (int ks = 0; ks < 4; ++ks) Bu[ks] = Bn[ks];
        }
    }
    const int ch0 = half ? CSPLIT : 0, ch1 = (half || !SPLIT) ? NCH : CSPLIT;
#pragma unroll
    for (int ks = 0; ks < 4; ++ks) Bu[ks] = *(const bf16x8*)(ubase + ((size_t)ch0 * 128 + 2 * ks) * NIN_E);
    for (int ch = ch0; ch < ch1; ++ch) {
        if (ch + 1 < ch1) {
#pragma unroll
            for (int ks = 0; ks < 4; ++ks) Bn[ks] = *(const bf16x8*)(ubase + ((size_t)(ch + 1) * 128 + 2 * ks) * NIN_E); }
        f32x4 IN = (f32x4){0.f, 0.f, 0.f, 0.f};
#pragma unroll
        for (int ks = 0; ks < 4; ++ks) IN = __builtin_amdgcn_mfma_f32_16x16x32_bf16(A2[ks], Bu[ks], IN, 0, 0, 0);
        float er[2] = {IN[0], IN[2]}, ei[2] = {IN[1], IN[3]}, xr[2], xi[2];
#pragma unroll
        for (int j = 0; j < 2; ++j) {
            if (ql == 0) { er[j] += m1r[j] * cr[j] - m1i[j] * ci[j]; ei[j] += m1r[j] * ci[j] + m1i[j] * cr[j]; }
            { const float tr = dpp_row_f<0x111>(0.f, er[j]), ti = dpp_row_f<0x111>(0.f, ei[j]); er[j] += m1r[j] * tr - m1i[j] * ti; ei[j] += m1r[j] * ti + m1i[j] * tr; }
            { const float tr = dpp_row_f<0x112>(0.f, er[j]), ti = dpp_row_f<0x112>(0.f, ei[j]); er[j] += m2r[j] * tr - m2i[j] * ti; ei[j] += m2r[j] * ti + m2i[j] * tr; }
            { const float tr = dpp_row_f<0x114>(0.f, er[j]), ti = dpp_row_f<0x114>(0.f, ei[j]); er[j] += m4r[j] * tr - m4i[j] * ti; ei[j] += m4r[j] * ti + m4i[j] * tr; }
            { const float tr = dpp_row_f<0x118>(0.f, er[j]), ti = dpp_row_f<0x118>(0.f, ei[j]); er[j] += m8r[j] * tr - m8i[j] * ti; ei[j] += m8r[j] * ti + m8i[j] * tr; }
            xr[j] = dpp_row_f<0x111>(cr[j], er[j]); xi[j] = dpp_row_f<0x111>(ci[j], ei[j]);
            cr[j] = __shfl(er[j], (lane & 48) | 15); ci[j] = __shfl(ei[j], (lane & 48) | 15);
        }
        LAS unsigned char* xb = F.lds + (ch & 1) * S5X_BUF;
        *(LAS u32x2*)(xb + ql * S5X_ROW + (16 * w + 4 * gq) * 2) = (u32x2){pk2(xr[0], xi[0]), pk2(xr[1], xi[1])};
        RAW_BAR();
        f32x4 Yt = (f32x4){0.f, 0.f, 0.f, 0.f};
#pragma unroll
        for (int ks = 0; ks < 4; ++ks) Yt = __builtin_amdgcn_mfma_f32_16x16x32_bf16(A1[ks], Bu[ks], Yt, 0, 0, 0);
#pragma unroll
        for (int ks = 0; ks < 4; ++ks) { const bf16x8 Bx = *(const LAS bf16x8*)(xb + ql * S5X_ROW + (32 * ks + 8 * gq) * 2); Yt = __builtin_amdgcn_mfma_f32_16x16x32_bf16(A3[ks], Bx, Yt, 0, 0, 0); }
        float y[4];
#pragma unroll
        for (int i = 0; i < 4; ++i) { const float v = Yt[i]; y[i] = v * fast_sigmoid(1.5957691216f * (v + 0.044715f * v * v * v)); }
        u32x4 by; by.x = pk2(y[0], y[1]); by.y = pk2(y[2], y[3]); by.z = 0u; by.w = 0u;
        const f32x4 Z = __builtin_amdgcn_mfma_f32_16x16x32_bf16(Awg, __builtin_bit_cast(bf16x8, by), (f32x4){0.f, 0.f, 0.f, 0.f}, 0, 0, 0);
        u32x2 o; o.x = pk2(y[0] * fast_sigmoid(Z[0]), y[1] * fast_sigmoid(Z[1])); o.y = pk2(y[2] * fast_sigmoid(Z[2]), y[3] * fast_sigmoid(Z[3]));
        *(u32x2*)(Y + (rowb + (size_t)ch * 128 + 8 * ql + w) * D + DCONV + g * 16 + 4 * gq) = o;
#pragma unroll
        for (int ks = 0; ks < 4; ++ks) Bu[ks] = Bn[ks];
    }
}

template <bool ROUTER, int QOUT = (ROUTER ? 1 : 0)>
__device__ __forceinline__ void ln_phase(Frame& F, const bf16_t* PRE, bf16_t* H, const float* gam, const float* bet, unsigned char* H8 = nullptr) {
    const int gw = F.bid * NWAVES + F.wave, NGW = F.G * NWAVES;
    LAS unsigned* lcnt = (LAS unsigned*)(F.lds + LDS_MISC + 64);
    if (ROUTER) { if (F.tid < 16) lcnt[F.tid] = 0u; __syncthreads(); }
    f32x4 gv[8], bv[8];
#pragma unroll
    for (int j = 0; j < 8; ++j) { gv[j] = *(const f32x4*)(gam + 4 * F.lane + 256 * j); bv[j] = *(const f32x4*)(bet + 4 * F.lane + 256 * j); }
    for (int r = gw; r < M; r += NGW) {
        const u32x2* xr = (const u32x2*)(PRE + (size_t)r * D) + F.lane;
        f32x4 v[8]; float s = 0.f;
#pragma unroll
        for (int j = 0; j < 8; ++j) { const u32x2 x = xr[64 * j]; v[j] = (f32x4){bflo(x.x), bfhi(x.x), bflo(x.y), bfhi(x.y)}; s += (v[j][0] + v[j][1]) + (v[j][2] + v[j][3]); }
        const float mean = wave_sum(s) * (1.f / D); float s2 = 0.f;
#pragma unroll
        for (int j = 0; j < 8; ++j) { v[j] = v[j] - mean; s2 += (v[j][0] * v[j][0] + v[j][1] * v[j][1]) + (v[j][2] * v[j][2] + v[j][3] * v[j][3]); }
        const float rstd = 1.f / sqrtf(wave_sum(s2) * (1.f / D) + LN_EPS);
        u32x2* o8 = (u32x2*)(H + (size_t)r * D) + F.lane;
#pragma unroll
        for (int j = 0; j < 8; ++j) { v[j] = v[j] * rstd * gv[j] + bv[j]; u32x2 w; w.x = pk2(v[j][0], v[j][1]); w.y = pk2(v[j][2], v[j][3]); o8[64 * j] = w; }
        if (QOUT) { unsigned* o4 = (unsigned*)(H8 + (size_t)r * D) + F.lane;
#pragma unroll
            for (int j = 0; j < 8; ++j) o4[64 * j] = (QOUT == 2) ? pk4_i8(v[j][0] * I8S_H, v[j][1] * I8S_H, v[j][2] * I8S_H, v[j][3] * I8S_H) : pk4_f8(v[j][0] * F8S_H3, v[j][1] * F8S_H3, v[j][2] * F8S_H3, v[j][3] * F8S_H3); }
        if (ROUTER) {
            const int pos = r % LP;
            if (pos < LR) {
                const float* rw = F.in[I_RW];
                float lg[8];
#pragma unroll
                for (int e = 0; e < 8; ++e) lg[e] = 0.f;
#pragma unroll
                for (int j = 0; j < 8; ++j)
#pragma unroll
                    for (int q = 0; q < 4; ++q) { const int c = 4 * F.lane + 256 * j + q; const f32x4 w0 = *(const f32x4*)(rw + (size_t)c * 8), w1 = *(const f32x4*)(rw + (size_t)c * 8 + 4); const float x = v[j][q];
                        lg[0] += x * w0[0]; lg[1] += x * w0[1]; lg[2] += x * w0[2]; lg[3] += x * w0[3]; lg[4] += x * w1[0]; lg[5] += x * w1[1]; lg[6] += x * w1[2]; lg[7] += x * w1[3]; }
#pragma unroll
                for (int e = 0; e < 8; ++e) lg[e] = wave_sum(lg[e]) + F.in[I_RB][e];
                int e0 = 0; float v0 = lg[0];
#pragma unroll
                for (int e = 1; e < 8; ++e) if (lg[e] > v0) { v0 = lg[e]; e0 = e; }
                int e1 = -1; float v1 = -3.0e38f;
#pragma unroll
                for (int e = 0; e < 8; ++e) if (e != e0 && lg[e] > v1) { v1 = lg[e]; e1 = e; }
                const float p1 = __expf(v1 - v0), g0 = 1.f / (1.f + p1), g1 = p1 * g0;
                if (F.lane == 0) {
                    int* TE = (int*)(F.ws + WS_MOE + MO_TOKE); float* TG = (float*)(F.ws + WS_MOE + MO_TOKG); int* TP = (int*)(F.ws + WS_MOE + MO_TOKPOS);
                    const unsigned q0 = __hip_atomic_fetch_add(lcnt + e0, 1u, __ATOMIC_RELAXED, __HIP_MEMORY_SCOPE_WORKGROUP);
                    const unsigned q1 = __hip_atomic_fetch_add(lcnt + e1, 1u, __ATOMIC_RELAXED, __HIP_MEMORY_SCOPE_WORKGROUP);
                    TE[2 * r] = e0; TE[2 * r + 1] = e1; TG[2 * r] = g0; TG[2 * r + 1] = g1; TP[2 * r] = (int)q0; TP[2 * r + 1] = (int)q1;
                }
            }
        }
    }
    if (ROUTER) {
        __syncthreads();
        if (F.tid < 8) lcnt[8 + F.tid] = __hip_atomic_fetch_add(F.ctl + CW_CNT + 64 * F.tid, lcnt[F.tid], __ATOMIC_RELAXED, __HIP_MEMORY_SCOPE_AGENT);
        __syncthreads();
        const int* TE = (const int*)(F.ws + WS_MOE + MO_TOKE); int* TP = (int*)(F.ws + WS_MOE + MO_TOKPOS);
        for (int r = gw; r < M; r += NGW) if (r % LP < LR && F.lane < 2) TP[2 * r + F.lane] += (int)lcnt[8 + TE[2 * r + F.lane]];
    }
}
__device__ __forceinline__ void route_phase(Frame& F) {
    int cnt[8], ps[8]; int tot = 0;
#pragma unroll
    for (int e = 0; e < 8; ++e) { cnt[e] = (int)__hip_atomic_load(F.ctl + CW_CNT + 64 * e, __ATOMIC_RELAXED, __HIP_MEMORY_SCOPE_AGENT); ps[e] = tot; tot += (cnt[e] + 255) / 256 * 256; }
    const int* TE = (const int*)(F.ws + WS_MOE + MO_TOKE); const int* TP = (const int*)(F.ws + WS_MOE + MO_TOKPOS);
    int* TS = (int*)(F.ws + WS_MOE + MO_TOKSLOT); int* ST = (int*)(F.ws + WS_MOE + MO_SLOTTOK); int* TL = (int*)(F.ws + WS_MOE + MO_TILEE);
    const int gt = F.bid * NTHREADS + F.tid, NGT = F.G * NTHREADS;
    for (int a = gt; a < 2 * M; a += NGT) { const int r = a >> 1; if (r % LP < LR) { const int e = TE[a]; int base = 0;
#pragma unroll
            for (int j = 0; j < 8; ++j) base = (j == e) ? ps[j] : base;
            const int slot = base + TP[a]; TS[a] = slot; ST[slot] = r; } }
    for (int s = gt; s < tot; s += NGT) { int e = 0;
#pragma unroll
        for (int j = 1; j < 8; ++j) e = (s >= ps[j]) ? j : e;
        int pe = 0, ce = 0;
#pragma unroll
        for (int j = 0; j < 8; ++j) { pe = (j == e) ? ps[j] : pe; ce = (j == e) ? cnt[j] : ce; }
        if (s - pe >= ce) ST[s] = 0;
        if ((s & 255) == 0) TL[s >> 8] = e; }
    if (gt == 0) TL[300] = tot >> 8;
}
__device__ __forceinline__ void final_phase(Frame& F) {
    const bf16_t* H = (const bf16_t*)(F.ws + WS_H3); const bf16_t* YB = (const bf16_t*)(F.ws + WS_YB);
    const int* TS = (const int*)(F.ws + WS_MOE + MO_TOKSLOT); const float* TG = (const float*)(F.ws + WS_MOE + MO_TOKG);
    const float* gam = F.in[I_LN4G]; const float* bet = F.in[I_LN4B];
    const int gw = F.bid * NWAVES + F.wave, NGW = F.G * NWAVES;
    f32x4 gv[8], bv[8];
#pragma unroll
    for (int j = 0; j < 8; ++j) { gv[j] = *(const f32x4*)(gam + 4 * F.lane + 256 * j); bv[j] = *(const f32x4*)(bet + 4 * F.lane + 256 * j); }
    for (int o = gw; o < NB * SEQ; o += NGW) {
        const int b = o / SEQ, s = o % SEQ, r = b * LP + NMETA + s;
        const int s0 = TS[2 * r], s1 = TS[2 * r + 1]; const float g0 = TG[2 * r], g1 = TG[2 * r + 1];
        const u32x2* hr = (const u32x2*)(H + (size_t)r * D) + F.lane; const u32x2* y0 = (const u32x2*)(YB + (size_t)s0 * D) + F.lane; const u32x2* y1 = (const u32x2*)(YB + (size_t)s1 * D) + F.lane;
        f32x4 v[8]; float sm = 0.f;
#pragma unroll
        for (int j = 0; j < 8; ++j) { const u32x2 hw = hr[64 * j], a = y0[64 * j], c = y1[64 * j];
            v[j][0] = ALPHA * bflo(hw.x) + g0 * bflo(a.x) + g1 * bflo(c.x); v[j][1] = ALPHA * bfhi(hw.x) + g0 * bfhi(a.x) + g1 * bfhi(c.x);
            v[j][2] = ALPHA * bflo(hw.y) + g0 * bflo(a.y) + g1 * bflo(c.y); v[j][3] = ALPHA * bfhi(hw.y) + g0 * bfhi(a.y) + g1 * bfhi(c.y);
            sm += (v[j][0] + v[j][1]) + (v[j][2] + v[j][3]); }
        const float mean = wave_sum(sm) * (1.f / D); float s2 = 0.f;
#pragma unroll
        for (int j = 0; j < 8; ++j) { v[j] = v[j] - mean; s2 += (v[j][0] * v[j][0] + v[j][1] * v[j][1]) + (v[j][2] * v[j][2] + v[j][3] * v[j][3]); }
        const float rstd = 1.f / sqrtf(wave_sum(s2) * (1.f / D) + LN_EPS);
        f32x4* op = (f32x4*)(F.out + (size_t)o * D) + F.lane;
#pragma unroll
        for (int j = 0; j < 8; ++j) op[64 * j] = v[j] * rstd * gv[j] + bv[j];
    }
}
__device__ __forceinline__ int dsa_kend(int q) { return q < NMETA ? NMETA : NMETA + 64 * (1 + (q - NMETA) / 64); }
constexpr int D1_CAP = 512, D1_BUF = 0, D1_HIST = 16 * D1_CAP * 4, D1_BMP = D1_HIST + 1024, D1_CNT = D1_BMP + BMP_PITCH * 4, D1_WAVE = D1_CNT + 64; static_assert(D1_WAVE == D1_WAVE_BYTES && 4 * D1_WAVE + 4 * 4352 <= LDS_MISC, "top-k LDS map");
__device__ __forceinline__ unsigned d1_mono(float f) { const unsigned u = __float_as_uint(f); return (u & 0x80000000u) ? ~u : (u | 0x80000000u); }
template <int CTRL, int ROWMASK> __device__ __forceinline__ int dpp_int(int old, int src) { return __builtin_amdgcn_update_dpp(old, src, CTRL, ROWMASK, 0xf, false); }
__device__ __forceinline__ int wave_scan_add_i(int v) {
    v += dpp_int<0x111, 0xf>(0, v); v += dpp_int<0x112, 0xf>(0, v); v += dpp_int<0x114, 0xf>(0, v); v += dpp_int<0x118, 0xf>(0, v);
    v += dpp_int<0x142, 0xa>(0, v); v += dpp_int<0x143, 0xc>(0, v); return v;
}
__device__ __forceinline__ unsigned d1_refresh(LAS unsigned* buf, LAS unsigned* hist, LAS unsigned* cnt, int qq, int lane) {
    const int n = (int)cnt[qq];
    LAS unsigned* bq = buf + qq * D1_CAP;
    unsigned e[8];
#pragma unroll
    for (int i = 0; i < 8; ++i) e[i] = (lane + 64 * i < n) ? bq[lane + 64 * i] : 0u;
    unsigned prefix = 0u; int need = 256;
#pragma unroll 1
    for (int r = 3; r >= 0; --r) {
        const int shift = 8 * r;
        bool m[8]; unsigned dg[8]; unsigned any_d = 0u; bool uni = true;
#pragma unroll
        for (int i = 0; i < 8; ++i) { m[i] = (e[i] != 0u) && (r == 3 || (e[i] >> (shift + 8)) == (prefix >> (shift + 8))); dg[i] = (e[i] >> shift) & 255u; }
        { unsigned long long bm = 0ull; unsigned first = 0u;
#pragma unroll
          for (int i = 0; i < 8; ++i) { const unsigned long long b_ = __ballot(m[i]); if (bm == 0ull && b_ != 0ull) first = (unsigned)__builtin_amdgcn_readlane((int)dg[i], (int)__builtin_ctzll(b_)); bm |= b_; }
          any_d = first;
#pragma unroll
          for (int i = 0; i < 8; ++i) uni = uni && !__any(m[i] && dg[i] != first); }
        if (uni) { prefix |= any_d << shift; continue; }
        *(LAS u32x4*)(hist + 4 * lane) = (u32x4){0u, 0u, 0u, 0u};
        LDS_WAIT();
#pragma unroll
        for (int i = 0; i < 8; ++i) if (m[i]) __hip_atomic_fetch_add(hist + (255u - dg[i]), 1u, __ATOMIC_RELAXED, __HIP_MEMORY_SCOPE_WORKGROUP);
        LDS_WAIT();
        const u32x4 h4 = *(const LAS u32x4*)(hist + 4 * lane);
        const int s = (int)(h4.x + h4.y + h4.z + h4.w);
        const int S = wave_scan_add_i(s);
        const int above = S - s;
        const bool found = (above < need) && (need <= S);
        int digit = 0, nneed = 0;
        if (found) { int a = above;
            if (a + (int)h4.x >= need) { digit = 255 - 4 * lane; nneed = need - a; }
            else { a += (int)h4.x;
                if (a + (int)h4.y >= need) { digit = 254 - 4 * lane; nneed = need - a; }
                else { a += (int)h4.y;
                    if (a + (int)h4.z >= need) { digit = 253 - 4 * lane; nneed = need - a; }
                    else { a += (int)h4.z; digit = 252 - 4 * lane; nneed = need - a; } } } }
        const unsigned long long fm = __ballot(found);
        const int src = fm ? (int)__builtin_ctzll(fm) : 0;
        digit = __builtin_amdgcn_readlane(digit, src); nneed = __builtin_amdgcn_readlane(nneed, src);
        prefix |= (unsigned)digit << shift; need = nneed;
    }
    const unsigned T = prefix;
    int base = 0;
#pragma unroll
    for (int i = 0; i < 8; ++i) { const bool keep = e[i] >= T && e[i] != 0u; const unsigned long long mk = __ballot(keep);
        const int pos = base + (int)__builtin_popcountll(mk & ((1ull << lane) - 1ull));
        if (keep) bq[pos] = e[i];
        base += (int)__builtin_popcountll(mk); }
    if (lane == 0) cnt[qq] = (unsigned)base;
    LDS_WAIT();
    return T;
}
__device__ __forceinline__ unsigned wave_min_u(unsigned v) {
    const int ni = -1;
    v = min(v, (unsigned)dpp_int<0x111, 0xf>(ni, (int)v)); v = min(v, (unsigned)dpp_int<0x112, 0xf>(ni, (int)v)); v = min(v, (unsigned)dpp_int<0x114, 0xf>(ni, (int)v)); v = min(v, (unsigned)dpp_int<0x118, 0xf>(ni, (int)v));
    v = min(v, (unsigned)dpp_int<0x142, 0xa>(ni, (int)v)); v = min(v, (unsigned)dpp_int<0x143, 0xc>(ni, (int)v));
    return (unsigned)__builtin_amdgcn_readlane((int)v, 63);
}
__device__ __forceinline__ unsigned wave_max_u(unsigned v) {
    v = max(v, (unsigned)dpp_int<0x111, 0xf>(0, (int)v)); v = max(v, (unsigned)dpp_int<0x112, 0xf>(0, (int)v)); v = max(v, (unsigned)dpp_int<0x114, 0xf>(0, (int)v)); v = max(v, (unsigned)dpp_int<0x118, 0xf>(0, (int)v));
    v = max(v, (unsigned)dpp_int<0x142, 0xa>(0, (int)v)); v = max(v, (unsigned)dpp_int<0x143, 0xc>(0, (int)v));
    return (unsigned)__builtin_amdgcn_readlane((int)v, 63);
}
template <bool EXACT>
__device__ __forceinline__ unsigned d1_select(LAS unsigned* buf, LAS unsigned* hist, LAS unsigned* cnt, int qq, int lane) {
    const int n = (int)cnt[qq];
    LAS unsigned* bq = buf + qq * D1_CAP;
    unsigned e[8];
#pragma unroll
    for (int i = 0; i < 8; ++i) e[i] = (lane + 64 * i < n) ? bq[lane + 64 * i] : 0u;
    unsigned lmin = 0xFFFFFFFFu, lmax = 0u;
#pragma unroll
    for (int i = 0; i < 8; ++i) { const unsigned k = e[i] >> 17; lmin = (e[i] != 0u) ? min(lmin, k) : lmin; lmax = (e[i] != 0u) ? max(lmax, k) : lmax; }
    const unsigned kmin = wave_min_u(lmin), kmax = wave_max_u(lmax);
    const float inv = 256.0f / (float)(kmax - kmin + 1u);
    int bin[8];
#pragma unroll
    for (int i = 0; i < 8; ++i) { const int b_ = (int)((float)((e[i] >> 17) - kmin) * inv); bin[i] = b_ > 255 ? 255 : b_; }
    *(LAS u32x4*)(hist + 4 * lane) = (u32x4){0u, 0u, 0u, 0u};
    LDS_WAIT();
#pragma unroll
    for (int i = 0; i < 8; ++i) if (e[i] != 0u) __hip_atomic_fetch_add(hist + (255 - bin[i]), 1u, __ATOMIC_RELAXED, __HIP_MEMORY_SCOPE_WORKGROUP);
    LDS_WAIT();
    const u32x4 h4 = *(const LAS u32x4*)(hist + 4 * lane);
    const int s_ = (int)(h4.x + h4.y + h4.z + h4.w);
    const int S = wave_scan_add_i(s_);
    const int above_l = S - s_;
    const bool found = (above_l < 256) && (256 <= S);
    int bstar = 0, above = 0, cb = 0;
    if (found) { int a = above_l;
        if (a + (int)h4.x >= 256) { bstar = 255 - 4 * lane; above = a; cb = (int)h4.x; }
        else { a += (int)h4.x;
            if (a + (int)h4.y >= 256) { bstar = 254 - 4 * lane; above = a; cb = (int)h4.y; }
            else { a += (int)h4.y;
                if (a + (int)h4.z >= 256) { bstar = 253 - 4 * lane; above = a; cb = (int)h4.z; }
                else { a += (int)h4.z; bstar = 252 - 4 * lane; above = a; cb = (int)h4.w; } } } }
    const unsigned long long fm = __ballot(found);
    const int src = fm ? (int)__builtin_ctzll(fm) : 0;
    bstar = __builtin_amdgcn_readlane(bstar, src); above = __builtin_amdgcn_readlane(above, src); cb = __builtin_amdgcn_readlane(cb, src);
    unsigned T;
    if (!EXACT) {
        if (above + cb > D1_CAP - 128) return d1_refresh(buf, hist, cnt, qq, lane);
        unsigned lk = 0xFFFFFFFFu;
#pragma unroll
        for (int i = 0; i < 8; ++i) lk = (e[i] != 0u && bin[i] >= bstar) ? min(lk, e[i]) : lk;
        T = wave_min_u(lk);
    } else {
        if (cb > 48) return d1_refresh(buf, hist, cnt, qq, lane);
        unsigned cur = 0xFFFFFFFFu;
        for (int it = above; it < 256; ++it) {
            unsigned lm = 0u;
#pragma unroll
            for (int i = 0; i < 8; ++i) lm = (bin[i] == bstar && e[i] < cur) ? max(lm, e[i]) : lm;
            cur = wave_max_u(lm);
        }
        T = cur;
    }
    int base = 0;
#pragma unroll
    for (int i = 0; i < 8; ++i) { const bool keep = e[i] >= T && e[i] != 0u; const unsigned long long mk = __ballot(keep);
        const int pos = base + (int)__builtin_popcountll(mk & ((1ull << lane) - 1ull));
        if (keep) bq[pos] = e[i];
        base += (int)__builtin_popcountll(mk); }
    if (lane == 0) cnt[qq] = (unsigned)base;
    LDS_WAIT();
    return EXACT ? T : T - 1u;
}
#ifndef PROBE_D1
#define PROBE_D1 0
#endif
__device__ __forceinline__ void d1_append(LAS unsigned* buf, LAS unsigned* hist, LAS unsigned* cnt, const unsigned (&pk)[8], const int c, unsigned& thr, const int ql, const int lane, const int rep) {
    if (__any(c > 0) && !(rep && (PROBE_D1 & 1))) {
        unsigned pos = 0u;
        if (c > 0) pos = __hip_atomic_fetch_add(cnt + ql, (unsigned)c, __ATOMIC_RELAXED, __HIP_MEMORY_SCOPE_WORKGROUP);
        unsigned wp = ql * D1_CAP + pos;
#pragma unroll
        for (int i = 0; i < 8; ++i) if (pk[i] > thr) { buf[wp] = pk[i]; ++wp; }
        const bool full = (c > 0) && (pos + (unsigned)c > (unsigned)(D1_CAP - 32));
        unsigned long long fm = __ballot(full); fm = (fm | (fm >> 16) | (fm >> 32) | (fm >> 48)) & 0xFFFFull;
        if (fm) { LDS_WAIT();
            while (fm) { const int qq = (int)__builtin_ctzll(fm); fm &= fm - 1ull;
                if (rep && (PROBE_D1 & 2)) { if (lane == 0) cnt[qq] = 256u; LDS_WAIT(); continue; }
                const unsigned T = d1_select<false>(buf, hist, cnt, qq, lane);
                if (ql == qq) thr = T; } }
    }
}
__device__ __forceinline__ void d1_unit(Frame& F, LAS unsigned char* wl, int b, int qg, int rep) {
    const bf16_t* PA = (const bf16_t*)(F.ws + WS_P); unsigned* BMP = (unsigned*)(F.ws + WS_BMP);
    LAS unsigned* buf = (LAS unsigned*)(wl + D1_BUF); LAS unsigned* hist = (LAS unsigned*)(wl + D1_HIST); LAS unsigned* bmp = (LAS unsigned*)(wl + D1_BMP); LAS unsigned* cnt = (LAS unsigned*)(wl + D1_CNT);
    const int lane = F.lane, ql = lane & 15, g = lane >> 4, q0 = qg * 16, kend = dsa_kend(q0);
    const size_t rowq = (size_t)b * LP + q0 + ql;
    bf16x8 Bq[8][2]; float wq[8];
#pragma unroll
    for (int h = 0; h < 8; ++h) {
#pragma unroll
        for (int ks = 0; ks < 2; ++ks) Bq[h][ks] = *(const bf16x8*)(PA + rowq * NIN_OA + CA_QI + h * 64 + ks * 32 + 8 * g);
        wq[h] = bf2f(PA[rowq * NIN_OA + CA_WI + h]) * (0.35355339059f * 0.125f);
    }
    if (lane < 16) cnt[lane] = 0u;
    LDS_WAIT();
    unsigned thr = 0u;
    const bf16_t* kp = (const bf16_t*)(F.ws + WS_KIC) + ((size_t)b * LP + ql) * 64 + 8 * g;
    const int ngrp = kend / 16, nit = (ngrp + 1) / 2;
    bf16x8 S0[2][2], S1[2][2], S2[2][2];
#define D1_LOADG(dst, it_) do { _Pragma("unroll") for (int j_ = 0; j_ < 2; ++j_) { int gi_ = 2 * (it_) + j_; gi_ = gi_ < ngrp ? gi_ : ngrp - 1; const bf16_t* kn_ = kp + (size_t)gi_ * 16 * 64; dst[j_][0] = *(const bf16x8*)kn_; dst[j_][1] = *(const bf16x8*)(kn_ + 32); } } while (0)
#define D1_BODY(CUR, LD, itv) do { const int it_b = (itv); \
        D1_LOADG(LD, it_b + 2); \
        unsigned pk[8]; int c = 0; \
        _Pragma("unroll") for (int j = 0; j < 2; ++j) { \
            float sc[4] = {0.f, 0.f, 0.f, 0.f}; \
            _Pragma("unroll") for (int h = 0; h < 8; ++h) { f32x4 acc = (f32x4){0.f, 0.f, 0.f, 0.f}; \
                acc = __builtin_amdgcn_mfma_f32_16x16x32_bf16(CUR[j][0], Bq[h][0], acc, 0, 0, 0); \
                acc = __builtin_amdgcn_mfma_f32_16x16x32_bf16(CUR[j][1], Bq[h][1], acc, 0, 0, 0); \
                _Pragma("unroll") for (int i = 0; i < 4; ++i) sc[i] = __builtin_fmaf(wq[h], __int_as_float(max(__float_as_int(acc[i]), 0)), sc[i]); }   \
            const bool gv = (2 * it_b + j) < ngrp; \
            _Pragma("unroll") for (int i = 0; i < 4; ++i) { const unsigned p = (d1_mono(sc[i]) & 0xFFFF8000u) | (unsigned)((2 * it_b + j) * 16 + 4 * g + i); pk[4 * j + i] = gv ? p : 0u; c += (pk[4 * j + i] > thr) ? 1 : 0; } \
        } \
        d1_append(buf, hist, cnt, pk, c, thr, ql, lane, rep); \
    } while (0)
#pragma unroll
    for (int h = 0; h < 8; ++h) asm volatile("" :: "v"(Bq[h][0]), "v"(Bq[h][1]), "v"(wq[h]));
    D1_LOADG(S0, 0); D1_LOADG(S1, 1);
    for (int it = 0; it < nit; it += 3) {
        D1_BODY(S0, S2, it);
        if (it + 1 < nit) D1_BODY(S1, S0, it + 1);
        if (it + 2 < nit) D1_BODY(S2, S1, it + 2);
    }
#undef D1_BODY
#undef D1_LOADG
    LDS_WAIT();
#pragma unroll 1
    for (int qq = 0; qq < 16; ++qq) {
        if ((int)cnt[qq] > 256) (void)d1_select<true>(buf, hist, cnt, qq, lane);
        const int n = (int)cnt[qq];
#pragma unroll
        for (int j = 0; j < 9; ++j) if (lane + 64 * j < BMP_PITCH) bmp[lane + 64 * j] = 0u;
        LDS_WAIT();
#pragma unroll
        for (int i = 0; i < 4; ++i) if (lane + 64 * i < n) { const unsigned idx = buf[qq * D1_CAP + lane + 64 * i] & 0x7FFFu; __hip_atomic_fetch_or(bmp + (idx >> 5), 1u << (idx & 31u), __ATOMIC_RELAXED, __HIP_MEMORY_SCOPE_WORKGROUP); }
        LDS_WAIT();
        unsigned* orow = BMP + ((size_t)b * LP + q0 + qq) * BMP_PITCH;
#pragma unroll
        for (int j = 0; j < 9; ++j) if (lane + 64 * j < BMP_PITCH) orow[lane + 64 * j] = bmp[lane + 64 * j];
        LDS_WAIT();
    }
}
__device__ __forceinline__ void d1_phase(Frame& F, int rep) {
    if (F.wave >= 4) return;
    LAS unsigned char* wl = F.lds + F.wave * D1_WAVE;
    constexpr int NQG = LR / 16;
    const int b = F.bid & 1;
    for (;;) {
        int u = 0;
        if (F.lane == 0) u = (int)__hip_atomic_fetch_add(F.ctl + CW_Q1 + 64 * (b + 2 * rep), 1u, __ATOMIC_RELAXED, __HIP_MEMORY_SCOPE_AGENT);
        u = __builtin_amdgcn_readfirstlane(u);
        if (u >= NQG) break;
        d1_unit(F, wl, b, NQG - 1 - u, rep);
    }
}

constexpr int D2_KS = 0, D2_KROW = 272, D2_VS = 64 * D2_KROW, D2_VROW = 144, D2_BUF = D2_VS + 128 * D2_VROW, D2_LUT = 2 * D2_BUF, D2_LDS = D2_LUT + 260 * 4;
constexpr float D2_SL2 = 0.08838834764831845f * 1.4426950408889634f, D2_L2E = 1.4426950408889634f, D2_NEG = -3.0e38f, D2_THR = 11.5f;
__device__ __forceinline__ int t5_bucket_dev(int rel) {
    const int n = rel < 0 ? -rel : rel; int v;
    if (n < 8) v = n; else { int l = 8 + (int)(log((double)n / 8.0) / log(16.0) * 8.0); v = l < 15 ? l : 15; }
    return (rel > 0 ? 16 : 0) + v;
}
template <bool FAR>
__device__ __forceinline__ void d2_softmax(const f32x4 (&St)[2][4], unsigned (&bw)[2][2], const unsigned (&bwn)[2][2], float (&mrun)[2], float (&lrun)[2], f32x4 (&O)[2][8], bf16x8 (&Pb)[2][2],
                                           const LAS float* lut, const int g, const int key0, const int (&qpos)[2]) {
    const float bfar = lut[128];
#pragma unroll
    for (int s = 0; s < 2; ++s) {
        const int wsh0 = (int)(bw[s][0] >> (4 * g)), wsh1 = (int)(bw[s][1] >> (4 * g));
        float pv[4][4]; float tmax = D2_NEG;
#pragma unroll
        for (int sub = 0; sub < 4; ++sub)
#pragma unroll
            for (int i = 0; i < 4; ++i) {
                float bias = bfar;
                if (!FAR) { const int rel = key0 + 16 * sub + 4 * g + i - qpos[s]; const int n = rel < 0 ? -rel : rel; const int nn = n < 128 ? n : 128; bias = lut[rel > 0 ? 129 + nn : nn]; }
                const float x = St[s][sub][i] * D2_SL2 + bias;
                const int t = __builtin_amdgcn_sbfe((sub >> 1) ? wsh1 : wsh0, 16 * (sub & 1) + i, 1);
                const float xm = __int_as_float((t & __float_as_int(x)) | (~t & __float_as_int(D2_NEG)));
                pv[sub][i] = xm; tmax = fmaxf(tmax, xm); }
        if (__any(tmax > mrun[s] + D2_THR)) {
            float tm = fmaxf(tmax, __shfl_xor(tmax, 16)); tm = fmaxf(tm, __shfl_xor(tm, 32));
            const float mnew = fmaxf(mrun[s], tm), alpha = __builtin_amdgcn_exp2f(mrun[s] - mnew);
            mrun[s] = mnew; lrun[s] *= alpha;
#pragma unroll
            for (int dt = 0; dt < 8; ++dt) O[s][dt] = O[s][dt] * alpha;
        }
        float ps = 0.f; const float mr = mrun[s];
#pragma unroll
        for (int sub = 0; sub < 4; ++sub)
#pragma unroll
            for (int i = 0; i < 4; ++i) { const float p = __builtin_amdgcn_exp2f(pv[sub][i] - mr); pv[sub][i] = p; ps += p; }
        lrun[s] += ps;
#pragma unroll
        for (int kk = 0; kk < 2; ++kk) { u32x4 pw; pw.x = pk2(pv[2 * kk][0], pv[2 * kk][1]); pw.y = pk2(pv[2 * kk][2], pv[2 * kk][3]); pw.z = pk2(pv[2 * kk + 1][0], pv[2 * kk + 1][1]); pw.w = pk2(pv[2 * kk + 1][2], pv[2 * kk + 1][3]);
            Pb[s][kk] = __builtin_bit_cast(bf16x8, pw); }
        bw[s][0] = bwn[s][0]; bw[s][1] = bwn[s][1];
    }
}
#ifndef PROBE_D2
#define PROBE_D2 0
#endif
__device__ __forceinline__ void d2_unit(Frame& F, LAS unsigned char* lds, int b, int jb, int h, int rep) {
    const bf16_t* PA = (const bf16_t*)(F.ws + WS_P); const bf16_t* KVT = (const bf16_t*)(F.ws + WS_KVT); const unsigned* BMP = (const unsigned*)(F.ws + WS_BMP);
    bf16_t* Y = (bf16_t*)(F.ws + WS_Y);
    LAS float* lut = (LAS float*)(lds + D2_LUT);
    const int lane = F.lane, ql = lane & 15, g = lane >> 4, w = F.wave, tid = F.tid;
    const int qbase = jb * 256 + w * 32;
    const int qlast = (jb * 256 + 255 < LR - 1) ? jb * 256 + 255 : LR - 1;
    const int ntile = (dsa_kend(qlast) + 63) / 64;
    const int kr = tid >> 3, ksg = tid & 7, vd = tid >> 2, vst = tid & 3;
    const bf16_t* ksrc = PA + ((size_t)b * LP + kr) * NIN_OA + CA_KD + h * 128 + ksg * 16;
    const bf16_t* vsrc = KVT + (size_t)(RB_VD + h * 128 + vd) * M + (size_t)b * LP + vst * 16;
    const int kdst = D2_KS + kr * D2_KROW + ksg * 32, vdst = D2_VS + vd * D2_VROW + (vst >> 1) * 64 + (vst & 1) * 8;
    u32x4 rk0, rk1, rva, rvc;
#define D2_LOAD(kt_) do { const bf16_t* ks_ = ksrc + (size_t)(kt_) * 64 * NIN_OA; rk0 = *(const u32x4*)ks_; rk1 = *(const u32x4*)(ks_ + 8); const bf16_t* vs_ = vsrc + (kt_) * 64; rva = *(const u32x4*)vs_; rvc = *(const u32x4*)(vs_ + 8); } while (0)
#define D2_STORE(p_) do { LAS unsigned char* kb_ = lds + (p_) * D2_BUF; *(LAS u32x4*)(kb_ + kdst) = rk0; *(LAS u32x4*)(kb_ + kdst + 16) = rk1; \
        *(LAS u32x2*)(kb_ + vdst) = (u32x2){rva.x, rva.y}; *(LAS u32x2*)(kb_ + vdst + 16) = (u32x2){rva.z, rva.w}; *(LAS u32x2*)(kb_ + vdst + 32) = (u32x2){rvc.x, rvc.y}; *(LAS u32x2*)(kb_ + vdst + 48) = (u32x2){rvc.z, rvc.w}; } while (0)
    RAW_BAR();
    D2_LOAD(0);
    if (tid < 258) { const int n = tid < 129 ? tid : tid - 129; const int rel = tid < 129 ? -n : n; lut[tid] = F.in[I_RELB][t5_bucket_dev(rel) * 8 + h] * D2_L2E; }
    int qpos[2]; size_t qrow[2]; bool qok[2];
    bf16x8 Bq[2][4];
#pragma unroll
    for (int s = 0; s < 2; ++s) { qpos[s] = qbase + 16 * s + ql; qok[s] = qpos[s] < LR; qrow[s] = (size_t)b * LP + (qok[s] ? qpos[s] : 0);
#pragma unroll
        for (int ks = 0; ks < 4; ++ks) Bq[s][ks] = *(const bf16x8*)(PA + qrow[s] * NIN_OA + CA_QD + h * 128 + ks * 32 + 8 * g); }
    f32x4 O[2][8]; float mrun[2], lrun[2];
#pragma unroll
    for (int s = 0; s < 2; ++s) { mrun[s] = -1.0e30f; lrun[s] = 0.f;
#pragma unroll
        for (int dt = 0; dt < 8; ++dt) O[s][dt] = (f32x4){0.f, 0.f, 0.f, 0.f}; }
    unsigned bw[2][2], bwn[2][2];
#pragma unroll
    for (int s = 0; s < 2; ++s) { bw[s][0] = qok[s] ? BMP[qrow[s] * BMP_PITCH] : 0u; bw[s][1] = qok[s] ? BMP[qrow[s] * BMP_PITCH + 1] : 0u; bwn[s][0] = 0u; bwn[s][1] = 0u; }
    D2_STORE(0);
#pragma unroll
    for (int s = 0; s < 2; ++s) {
#pragma unroll
        for (int ks = 0; ks < 4; ++ks) asm volatile("" :: "v"(Bq[s][ks]));
        asm volatile("" :: "v"(bw[s][0]), "v"(bw[s][1])); }
    if (ntile > 1) D2_LOAD(1);
    RAW_BAR();
    for (int kt = 0; kt < ntile; ++kt) {
        const int key0 = kt * 64;
        LAS unsigned char* tb = lds + (kt & 1) * D2_BUF;
        if (kt + 1 < ntile && !(rep && (PROBE_D2 & 2))) { D2_STORE((kt + 1) & 1); if (kt + 2 < ntile) D2_LOAD(kt + 2);
#pragma unroll
            for (int s = 0; s < 2; ++s) { bwn[s][0] = qok[s] ? BMP[qrow[s] * BMP_PITCH + 2 * kt + 2] : 0u; bwn[s][1] = qok[s] ? BMP[qrow[s] * BMP_PITCH + 2 * kt + 3] : 0u; } }
        f32x4 St[2][4];
#pragma unroll
        for (int s = 0; s < 2; ++s)
#pragma unroll
            for (int sub = 0; sub < 4; ++sub) St[s][sub] = (f32x4){0.f, 0.f, 0.f, 0.f};
#pragma unroll
        for (int ks = 0; ks < 4; ++ks)
#pragma unroll
            for (int sub = 0; sub < 4; ++sub) { const bf16x8 Ak = *(const LAS bf16x8*)(tb + D2_KS + (16 * sub + ql) * D2_KROW + (32 * ks + 8 * g) * 2);
#pragma unroll
                for (int s = 0; s < 2; ++s) St[s][sub] = __builtin_amdgcn_mfma_f32_16x16x32_bf16(Ak, Bq[s][ks], St[s][sub], 0, 0, 0); }
        const bool far = (key0 + 63 + 129 <= qbase);
        bf16x8 Pb[2][2];
        if (!far) {
            const float bf_ = lut[128];
#pragma unroll
            for (int s = 0; s < 2; ++s)
#pragma unroll
                for (int sub = 0; sub < 4; ++sub)
#pragma unroll
                    for (int i = 0; i < 4; ++i) { const int rel = key0 + 16 * sub + 4 * g + i - qpos[s]; const int n = rel < 0 ? -rel : rel; const int nn = n < 128 ? n : 128;
                        St[s][sub][i] += (lut[rel > 0 ? 129 + nn : nn] - bf_) * (1.0f / D2_SL2); }
        }
        if (rep && (PROBE_D2 & 1)) {
#pragma unroll
            for (int s = 0; s < 2; ++s)
#pragma unroll
                for (int kk = 0; kk < 2; ++kk) { u32x4 pw; pw.x = pk2(St[s][2 * kk][0], St[s][2 * kk][1]); pw.y = pk2(St[s][2 * kk][2], St[s][2 * kk][3]); pw.z = pk2(St[s][2 * kk + 1][0], St[s][2 * kk + 1][1]); pw.w = pk2(St[s][2 * kk + 1][2], St[s][2 * kk + 1][3]); Pb[s][kk] = __builtin_bit_cast(bf16x8, pw); }
        } else
        d2_softmax<true>(St, bw, bwn, mrun, lrun, O, Pb, lut, g, key0, qpos);
#pragma unroll
        for (int kk = 0; kk < 2; ++kk)
#pragma unroll
            for (int dt = 0; dt < 8; ++dt) { const bf16x8 Av = *(const LAS bf16x8*)(tb + D2_VS + (16 * dt + ql) * D2_VROW + kk * 64 + g * 16);
#pragma unroll
                for (int s = 0; s < 2; ++s) O[s][dt] = __builtin_amdgcn_mfma_f32_16x16x32_bf16(Av, Pb[s][kk], O[s][dt], 0, 0, 0); }
        RAW_BAR();
    }
#undef D2_LOAD
#undef D2_STORE
#pragma unroll
    for (int s = 0; s < 2; ++s) {
        float l = lrun[s]; l += __shfl_xor(l, 16); l += __shfl_xor(l, 32);
        const float inv = (qok[s] && l > 0.f) ? 1.0f / l : 0.f;
        if (qpos[s] < LP) { bf16_t* yr = Y + ((size_t)b * LP + qpos[s]) * D + 1024 + h * 128 + 4 * g;
#pragma unroll
            for (int dt = 0; dt < 8; ++dt) { u32x2 o; o.x = pk2(O[s][dt][0] * inv, O[s][dt][1] * inv); o.y = pk2(O[s][dt][2] * inv, O[s][dt][3] * inv); *(u32x2*)(yr + 16 * dt) = o; } }
    }
}
constexpr int D2_NJB = (LP + 255) / 256, D2_NU = NB * D2_NJB * 8;
__device__ __forceinline__ void d2_worker(Frame& F, LAS unsigned char* lds, int rep) {
    LAS int* slot = (LAS int*)(F.lds + LDS_MISC);
    for (;;) {
        __syncthreads();
        if (F.tid == 0) slot[0] = (int)__hip_atomic_fetch_add(F.ctl + CW_Q2 + 64 * rep, 1u, __ATOMIC_RELAXED, __HIP_MEMORY_SCOPE_AGENT);
        __syncthreads();
        const int u = slot[0];
        if (u >= D2_NU) break;
        const int h = u & 7, b = (u >> 3) & 1, jb = D2_NJB - 1 - (u >> 4);
        d2_unit(F, lds, b, jb, h, rep);
    }
}
constexpr int ML_QS = 0, ML_ROW = 528, ML_KS = ML_QS + 64 * ML_ROW, ML_KT = ML_KS + 64 * ML_ROW, ML_TROW = 144, ML_VT = ML_KT + 256 * ML_TROW, ML_VW = ML_VT + 48 * ML_TROW, ML_CB = ML_VW + 48 * ML_TROW,
              ML_SD = ML_CB + 48 * ML_ROW, ML_SC = ML_SD + 64 * ML_TROW, ML_LDS = ML_SC + 2048;
typedef short s16x4 __attribute__((ext_vector_type(4)));
template <int CTRL, int ROWMASK> __device__ __forceinline__ float dpp_f(float old, float src) { return __int_as_float(__builtin_amdgcn_update_dpp(__float_as_int(old), __float_as_int(src), CTRL, ROWMASK, 0xf, false)); }
__device__ __forceinline__ float wave_scan_add(float v) {
    v += dpp_f<0x111, 0xf>(0.f, v); v += dpp_f<0x112, 0xf>(0.f, v); v += dpp_f<0x114, 0xf>(0.f, v); v += dpp_f<0x118, 0xf>(0.f, v);
    v += dpp_f<0x142, 0xa>(0.f, v); v += dpp_f<0x143, 0xc>(0.f, v); return v;
}
__device__ __forceinline__ float wave_scan_max(float v) {
    const float ni = -3.0e38f;
    v = fmaxf(v, dpp_f<0x111, 0xf>(ni, v)); v = fmaxf(v, dpp_f<0x112, 0xf>(ni, v)); v = fmaxf(v, dpp_f<0x114, 0xf>(ni, v)); v = fmaxf(v, dpp_f<0x118, 0xf>(ni, v));
    v = fmaxf(v, dpp_f<0x142, 0xa>(ni, v)); v = fmaxf(v, dpp_f<0x143, 0xc>(ni, v)); return v;
}
__device__ __forceinline__ float readlane_f(float v, int l) { return __int_as_float(__builtin_amdgcn_readlane(__float_as_int(v), l)); }
__device__ __forceinline__ void mlstm_worker(Frame& F, LAS unsigned char* lds, int wg, int noload) {
    const bf16_t* PA = (const bf16_t*)(F.ws + WS_P); const bf16_t* KVT = (const bf16_t*)(F.ws + WS_KVT); bf16_t* Y = (bf16_t*)(F.ws + WS_Y);
    const int b = wg >> 5, h = (wg >> 3) & 3, sl = wg & 7, v0 = sl * 32;
    const int tid = F.tid, lane = F.lane, w = F.wave, ql = lane & 15, g = lane >> 4;
    LAS float* sc = (LAS float*)(lds + ML_SC);
    const float b_i = F.in[I_MBI][h], b_f = F.in[I_MBF][h];
    for (int i = tid; i < (48 * ML_ROW) / 4; i += NTHREADS) ((LAS unsigned*)(lds + ML_CB))[i] = 0u;
    for (int i = tid; i < (48 * ML_TROW) / 4; i += NTHREADS) ((LAS unsigned*)(lds + ML_VT))[i] = 0u;
    __syncthreads();
    if (tid < 32) ((LAS unsigned*)(lds + ML_VT + 32 * ML_TROW))[tid] = 0x3F803F80u;
    if (tid == 0) sc[320] = 0.f;
    f32x4 Cacc[2][3];
#pragma unroll
    for (int a = 0; a < 2; ++a)
#pragma unroll
        for (int c = 0; c < 3; ++c) Cacc[a][c] = (f32x4){0.f, 0.f, 0.f, 0.f};
    u32x4 rq[4], rkt[4], rv; unsigned rli = 0, rlf = 0; u32x2 rog = (u32x2){0u, 0u};
    const int srow = tid >> 3, sseg = tid & 7;
    const int krow = tid >> 1, khalf = tid & 1;
    const int vrow = tid >> 3, vseg = tid & 7;
    const int tt = w & 3, vtA = (w < 4) ? 0 : 1;
    constexpr int NCHUNK = LP / 64;
#define ML_ISSUE(cc) do { \
        const size_t r0_ = (size_t)b * LP + (size_t)(cc) * 64; \
        const bf16_t* qs_ = PA + (r0_ + srow) * NIN_OA + CA_QM + h * 256 + sseg * 32; \
        _Pragma("unroll") for (int j = 0; j < 4; ++j) rq[j] = *(const u32x4*)(qs_ + 8 * j); \
        const bf16_t* kt_ = KVT + (size_t)(RB_KM + h * 256 + krow) * M + r0_ + khalf * 32; \
        _Pragma("unroll") for (int j = 0; j < 4; ++j) rkt[j] = *(const u32x4*)(kt_ + 8 * j); \
        if (tid < 256) rv = *(const u32x4*)(KVT + (size_t)(RB_VM + h * 256 + v0 + vrow) * M + r0_ + vseg * 8); \
        rog = *(const u32x2*)(PA + (r0_ + 16 * tt + ql) * NIN_OA + CA_OM + h * 256 + v0 + 16 * vtA + 4 * g); \
        if (tid < 64) { rli = PA[(r0_ + tid) * NIN_OA + CA_IM + h]; rlf = PA[(r0_ + tid) * NIN_OA + CA_FM + h]; } \
    } while (0)
    ML_ISSUE(0);
    for (int c = 0; c < NCHUNK; ++c) {
        const size_t r0 = (size_t)b * LP + (size_t)c * 64;
#pragma unroll
        for (int j = 0; j < 4; ++j) { *(LAS u32x4*)(lds + ML_QS + srow * ML_ROW + sseg * 64 + 16 * j) = rq[j];
            *(LAS u32x4*)(lds + ML_KT + krow * ML_TROW + khalf * 64 + 16 * j) = rkt[j]; }
        if (tid < 256) *(LAS u32x4*)(lds + ML_VT + vrow * ML_TROW + vseg * 16) = rv;
        const u32x2 ogc = rog;
        if (w == 0) {
            const float mprev = sc[320];
            const float li_ = bf2f(rli) + b_i, f_ = bf2f(rlf) + b_f, lf_ = fminf(f_, 0.f) - __logf(1.0f + __expf(-fabsf(f_)));
            const float bc = wave_scan_add(lf_);
            const float gg = li_ - bc, pm = wave_scan_max(gg);
            const float Mt = fmaxf(mprev, pm);
            const float M63 = readlane_f(Mt, 63), b63 = readlane_f(bc, 63);
            sc[lane] = gg; sc[64 + lane] = Mt; sc[128 + lane] = bc; sc[256 + lane] = __expf(gg - M63) * 0.0625f;
            if (lane == 0) { sc[321] = __expf(mprev - M63); sc[322] = b63 + M63; sc[323] = mprev; }
        }
        if (c + 1 < NCHUNK && !noload) ML_ISSUE(c + 1);
        RAW_BAR();
        {
            const int ss = w >> 1;
            f32x4 S2[2] = {(f32x4){0.f, 0.f, 0.f, 0.f}, (f32x4){0.f, 0.f, 0.f, 0.f}};
            {
                bf16x8 Ak[8], Bq0[8], Bq1[8];
#pragma unroll
                for (int ks = 0; ks < 8; ++ks) {
                    const LAS unsigned char* ta = lds + ML_KT + (32 * ks + 8 * g + (ql >> 2)) * ML_TROW + (16 * ss + 4 * (ql & 3)) * 2;
                    const s16x4 lo = __builtin_amdgcn_ds_read_tr16_b64_v4i16((LAS s16x4*)ta), hi = __builtin_amdgcn_ds_read_tr16_b64_v4i16((LAS s16x4*)(ta + 4 * ML_TROW));
                    Ak[ks] = (bf16x8){lo[0], lo[1], lo[2], lo[3], hi[0], hi[1], hi[2], hi[3]};
                    Bq0[ks] = *(const LAS bf16x8*)(lds + ML_QS + (16 * (2 * (w & 1)) + ql) * ML_ROW + (32 * ks + 8 * g) * 2);
                    Bq1[ks] = *(const LAS bf16x8*)(lds + ML_QS + (16 * (2 * (w & 1) + 1) + ql) * ML_ROW + (32 * ks + 8 * g) * 2); }
#pragma unroll
                for (int ks = 0; ks < 8; ++ks) { S2[0] = __builtin_amdgcn_mfma_f32_16x16x32_bf16(Ak[ks], Bq0[ks], S2[0], 0, 0, 0); S2[1] = __builtin_amdgcn_mfma_f32_16x16x32_bf16(Ak[ks], Bq1[ks], S2[1], 0, 0, 0); }
            }
            const f32x4 gg4 = *(const LAS f32x4*)(sc + 16 * ss + 4 * g);
#pragma unroll
            for (int j = 0; j < 2; ++j) { const int t = 16 * (2 * (w & 1) + j) + ql; const float Mt = sc[64 + t]; float v[4];
#pragma unroll
                for (int i = 0; i < 4; ++i) { const int s_ = 16 * ss + 4 * g + i; const float e = __expf(fminf(gg4[i] - Mt, 0.f)) * 0.0625f; v[i] = (s_ <= t) ? S2[j][i] * e : 0.f; }
                *(LAS u32x2*)(lds + ML_SD + t * ML_TROW + (16 * ss + 4 * g) * 2) = (u32x2){pk2(v[0], v[1]), pk2(v[2], v[3])}; }
            if (tid < 384) { const int v_ = tid >> 3, sg = tid & 7; const u32x4 vv = *(const LAS u32x4*)(lds + ML_VT + v_ * ML_TROW + sg * 16);
                const f32x4 wa = *(const LAS f32x4*)(sc + 256 + 8 * sg), wb = *(const LAS f32x4*)(sc + 256 + 8 * sg + 4);
                u32x4 o; o.x = pk2(bflo(vv.x) * wa[0], bfhi(vv.x) * wa[1]); o.y = pk2(bflo(vv.y) * wa[2], bfhi(vv.y) * wa[3]); o.z = pk2(bflo(vv.z) * wb[0], bfhi(vv.z) * wb[1]); o.w = pk2(bflo(vv.w) * wb[2], bfhi(vv.w) * wb[3]);
                *(LAS u32x4*)(lds + ML_VW + v_ * ML_TROW + sg * 16) = o; }
        }
        RAW_BAR();
        f32x4 N0 = (f32x4){0.f, 0.f, 0.f, 0.f}, N1 = (f32x4){0.f, 0.f, 0.f, 0.f};
        const int t_ = 16 * tt + ql;
        {
#pragma unroll
            for (int hf = 0; hf < 2; ++hf) {
                bf16x8 Bq[4], Ac[4], Ac2[4];
#pragma unroll
                for (int k4 = 0; k4 < 4; ++k4) { const int ks = 4 * hf + k4; Bq[k4] = *(const LAS bf16x8*)(lds + ML_QS + t_ * ML_ROW + (32 * ks + 8 * g) * 2);
                    Ac[k4] = *(const LAS bf16x8*)(lds + ML_CB + (16 * vtA + ql) * ML_ROW + (32 * ks + 8 * g) * 2);
                    if (w < 4) Ac2[k4] = *(const LAS bf16x8*)(lds + ML_CB + (32 + ql) * ML_ROW + (32 * ks + 8 * g) * 2); }
#pragma unroll
                for (int k4 = 0; k4 < 4; ++k4) { N0 = __builtin_amdgcn_mfma_f32_16x16x32_bf16(Ac[k4], Bq[k4], N0, 0, 0, 0);
                    if (w < 4) N1 = __builtin_amdgcn_mfma_f32_16x16x32_bf16(Ac2[k4], Bq[k4], N1, 0, 0, 0); }
            }
            const float wi = __expf(sc[323] - sc[64 + t_]);
            N0 = N0 * wi; N1 = N1 * wi;
#pragma unroll
            for (int ks = 0; ks < 2; ++ks) { const bf16x8 Bs = *(const LAS bf16x8*)(lds + ML_SD + t_ * ML_TROW + (32 * ks + 8 * g) * 2);
                const bf16x8 Av = *(const LAS bf16x8*)(lds + ML_VT + (16 * vtA + ql) * ML_TROW + (32 * ks + 8 * g) * 2);
                N0 = __builtin_amdgcn_mfma_f32_16x16x32_bf16(Av, Bs, N0, 0, 0, 0);
                if (w < 4) { const bf16x8 Av2 = *(const LAS bf16x8*)(lds + ML_VT + (32 + ql) * ML_TROW + (32 * ks + 8 * g) * 2); N1 = __builtin_amdgcn_mfma_f32_16x16x32_bf16(Av2, Bs, N1, 0, 0, 0); } }
            if (w < 4 && g == 0) sc[192 + t_] = N1[0];
        }
        RAW_BAR();
        {
            const float den = sc[192 + t_], mt = sc[128 + t_] + sc[64 + t_];
            const float inv = 1.0f / fmaxf(fabsf(den), __expf(-mt));
            const float o0 = N0[0] * inv * fast_sigmoid(bflo(ogc.x)), o1 = N0[1] * inv * fast_sigmoid(bfhi(ogc.x)), o2 = N0[2] * inv * fast_sigmoid(bflo(ogc.y)), o3 = N0[3] * inv * fast_sigmoid(bfhi(ogc.y));
            *(u32x2*)(Y + (r0 + t_) * D + h * 256 + v0 + 16 * vtA + 4 * g) = (u32x2){pk2(o0, o1), pk2(o2, o3)};
        }
        {
            const float decay = sc[321];
            bf16x8 Bv[3][2];
#pragma unroll
            for (int ks = 0; ks < 2; ++ks)
#pragma unroll
                for (int vt = 0; vt < 3; ++vt) Bv[vt][ks] = *(const LAS bf16x8*)(lds + ML_VW + (16 * vt + ql) * ML_TROW + (32 * ks + 8 * g) * 2);
#pragma unroll
            for (int a = 0; a < 2; ++a) { const int kt = 2 * w + a;
#pragma unroll
                for (int vt = 0; vt < 3; ++vt) Cacc[a][vt] = Cacc[a][vt] * decay;
#pragma unroll
                for (int ks = 0; ks < 2; ++ks) { const bf16x8 Ak = *(const LAS bf16x8*)(lds + ML_KT + (16 * kt + ql) * ML_TROW + (32 * ks + 8 * g) * 2);
#pragma unroll
                    for (int vt = 0; vt < 3; ++vt) Cacc[a][vt] = __builtin_amdgcn_mfma_f32_16x16x32_bf16(Ak, Bv[vt][ks], Cacc[a][vt], 0, 0, 0); }
#pragma unroll
                for (int vt = 0; vt < 3; ++vt) *(LAS u32x2*)(lds + ML_CB + (16 * vt + ql) * ML_ROW + (16 * kt + 4 * g) * 2) = (u32x2){pk2(Cacc[a][vt][0], Cacc[a][vt][1]), pk2(Cacc[a][vt][2], Cacc[a][vt][3])}; }
            if (tid == 0) sc[320] = sc[322];
        }
        RAW_BAR();
    }
#undef ML_ISSUE
}
constexpr int NPHASE = 18;
struct Args { const float* in[35]; float* out; unsigned char* ws; int ph_lo, ph_hi, rep, pad; };
__global__ void __launch_bounds__(NTHREADS, 2) fwd_kernel(Args args) {
    extern __shared__ __attribute__((aligned(16))) unsigned char lds_raw[];
    Frame F;
    F.lds = (LAS unsigned char*)lds_raw;
    F.ws = args.ws; F.ctl = (unsigned*)(args.ws + WS_CTL); F.out = args.out;
#pragma unroll
    for (int i = 0; i < 35; ++i) F.in[i] = args.in[i];
    F.tid = threadIdx.x; F.lane = F.tid & 63; F.wave = __builtin_amdgcn_readfirstlane(F.tid >> 6); F.G = gridDim.x; F.bid = blockIdx.x;
    if (F.tid < 64) ((LAS unsigned*)(F.lds + LDS_MISC))[F.tid] = 0u;
    __syncthreads();
    const int lo = args.ph_lo, hi = args.ph_hi;
    XcdBarrier bar; bar.bar = F.ctl + CW_BAR; bar.x = 0; bar.st = (volatile LAS unsigned*)(F.lds + LDS_MISC + 32);
    if (hi - lo > 1) bar = xcd_barrier_post(F.ctl + CW_BAR, (volatile LAS unsigned*)(F.lds + LDS_MISC + 32));
#define IN(k) (lo <= (k) && (k) < hi)
#define SEAM(k) do { if (IN(k) && IN((k) + 1)) xcd_barrier(bar); } while (0)
    unsigned char* ws = args.ws;
    const int nM = M / 256;

    if (IN(0)) { p0_prologue(F); } SEAM(0);
    if (IN(1)) {
        s5_build_matrices(F);
        pg8::LinProv S; S.so.init(nM, NIN_E / 256, F.G, F.bid); S.Bt = (const char*)(ws + WS_WINE); S.K = D;
        pg8::EpiBf16 E{(bf16_t*)(ws + WS_P), NIN_E};
        pg8::gemm_phase(F.lds, (const char*)(ws + WS_HA), D, S, E); } SEAM(1);
    if (IN(2)) { if (F.bid < 64) { if (!(args.rep && PROBE_ML == 2)) s5_ssd_unit<false>(F, F.bid >> 5, F.bid & 31, 0); } else { if (!(args.rep && PROBE_ML == 1)) conv_phase(F, 64, F.G - 64); } } do { if (IN(2) && IN(4)) xcd_barrier(bar); } while (0);
    if (IN(4)) {
        pg8::LinProv S; S.so.init(nM, D / 256, F.G, F.bid); S.Bt = (const char*)(ws + WS_WOUTE); S.K = D;
        pg8::EpiResBf16 E{(bf16_t*)(ws + WS_PRE), (const bf16_t*)(ws + WS_HA), D, ALPHA};
        pg8::gemm_phase(F.lds, (const char*)(ws + WS_Y), D, S, E); } SEAM(4);
    if (IN(5)) { ln_phase<false, 2>(F, (const bf16_t*)(ws + WS_PRE), (bf16_t*)(ws + WS_HB), F.in[I_LN1G], F.in[I_LN1B], ws + WS_HBF8); } SEAM(5);
    if (IN(6)) {
        pg8::LinProv S; S.so.init(nM, N13 / 256, F.G, F.bid); S.Bt = (const char*)(ws + WS_W13); S.K = D / 2;
#if FFN_DOWN_F8
        pg8::EpiGatedF8 E{ws + WS_P, DFF, 1.f / (I8S_H * I8S_W13), F8S_GH};
        pg8::gemm_phase<pg8::EpiGatedF8, pg8::LinProv, 2>(F.lds, (const char*)(ws + WS_HBF8), D / 2, S, E); } SEAM(6);
#else
        pg8::EpiGatedS E{(bf16_t*)(ws + WS_P), DFF, 1.f / (I8S_H * I8S_W13)};
        pg8::gemm_phase<pg8::EpiGatedS, pg8::LinProv, 2>(F.lds, (const char*)(ws + WS_HBF8), D / 2, S, E); } SEAM(6);
#endif
    if (IN(7)) {
#if FFN_DOWN_F8
        pg8::LinProv S; S.so.init(nM, D / 256, F.G, F.bid); S.Bt = (const char*)(ws + WS_W2); S.K = DFF / 2;
        pg8::EpiResBf16S E{(bf16_t*)(ws + WS_PRE), (const bf16_t*)(ws + WS_HB), D, ALPHA, 1.f / (F8S_GH * F8S_W2)};
        pg8::gemm_phase<pg8::EpiResBf16S, pg8::LinProv, 1>(F.lds, (const char*)(ws + WS_P), DFF / 2, S, E); } SEAM(7);
#else
        pg8::LinProv S; S.so.init(nM, D / 256, F.G, F.bid); S.Bt = (const char*)(ws + WS_W2); S.K = DFF;
        pg8::EpiResBf16 E{(bf16_t*)(ws + WS_PRE), (const bf16_t*)(ws + WS_HB), D, ALPHA};
        pg8::gemm_phase(F.lds, (const char*)(ws + WS_P), DFF, S, E); } SEAM(7);
#endif
    if (IN(8)) { ln_phase<false>(F, (const bf16_t*)(ws + WS_PRE), (bf16_t*)(ws + WS_H2), F.in[I_LN2G], F.in[I_LN2B]); } SEAM(8);
    if (IN(9)) {
        { pg8::LinProv S; S.so.init(nM, NIN_OA / 256, F.G, F.bid); S.Bt = (const char*)(ws + WS_WINOA); S.K = D;
          pg8::EpiBf16 E{(bf16_t*)(ws + WS_P), NIN_OA, (bf16_t*)(ws + WS_KIC), CA_KI / 256};
          pg8::gemm_phase(F.lds, (const char*)(ws + WS_H2), D, S, E); }
        { pg8::LinProv S; S.so.init(NIN_OB / 256, nM, F.G, F.bid); S.Bt = (const char*)(ws + WS_H2); S.K = D;
          pg8::EpiBf16 E{(bf16_t*)(ws + WS_KVT), M};
          pg8::gemm_phase(F.lds, (const char*)(ws + WS_WINOB), D, S, E); } } SEAM(9);
    if (IN(10)) { d1_phase(F, args.rep); if (F.wave >= 4 && !args.rep) convert_experts(F); } SEAM(10);
    #ifndef PROBE_G3
#define PROBE_G3 1
#endif
#ifndef PROBE_ML
#define PROBE_ML 0
#endif
    if (IN(11)) { if (F.bid < 64) { if (!(args.rep && PROBE_ML == 2)) mlstm_worker(F, F.lds, F.bid, args.rep && PROBE_ML == 3); }
        if (!(args.rep && (PROBE_ML == 1 || PROBE_ML == 3))) d2_worker(F, F.lds, args.rep); } SEAM(11);
    if (IN(12)) {
        pg8::LinProv S; S.so.init(nM, D / 256, F.G, F.bid); S.Bt = (const char*)(ws + WS_WOUTO); S.K = D;
        pg8::EpiResBf16 E{(bf16_t*)(ws + WS_PRE1), (const bf16_t*)(ws + WS_H2), D, ALPHA};
        pg8::gemm_phase(F.lds, (const char*)(ws + WS_Y), D, S, E); } SEAM(12);
    if (IN(13)) { if (!args.rep) ln_phase<true>(F, (const bf16_t*)(ws + WS_PRE1), (bf16_t*)(ws + WS_H3), F.in[I_LN3G], F.in[I_LN3B], ws + WS_H3F8); } SEAM(13);
    if (IN(14)) { route_phase(F); } SEAM(14);
    const int* TL = (const int*)(ws + WS_MOE + MO_TILEE);
#define MOE_UP(tlo, cnt) do { pg8::GatherProv S; S.so.init((cnt), N13 / 256, F.G, F.bid); S.Bt = (const char*)(ws + WS_EW13); S.K = D / 2; S.rowidx = (const int*)(ws + WS_MOE + MO_SLOTTOK); S.tile_e = TL; S.t_lo = (tlo); S.estride = (size_t)N13 * D; \
        pg8::EpiGatedF8 E{ws + WS_GH, DFF, 1.f / (F8S_H3 * F8S_W13), F8S_GH}; pg8::gemm_phase<pg8::EpiGatedF8, pg8::GatherProv, 1>(F.lds, (const char*)(ws + WS_H3F8), D / 2, S, E); } while (0)
#define MOE_DOWN(tlo, cnt) do { pg8::GatherProv S; S.so.init((cnt), D / 256, F.G, F.bid); S.Bt = (const char*)(ws + WS_EW2); S.K = DFF / 2; S.rowidx = nullptr; S.tile_e = TL; S.t_lo = (tlo); S.estride = (size_t)D * DFF; \
        pg8::EpiBf16S E{(bf16_t*)(ws + WS_YB) + (size_t)(tlo) * 256 * D, D, 1.f / (F8S_GH * F8S_W2)}; pg8::gemm_phase<pg8::EpiBf16S, pg8::GatherProv, 1>(F.lds, (const char*)(ws + WS_GH), DFF / 2, S, E); } while (0)
    if (IN(15)) { const int nt = __builtin_amdgcn_readfirstlane(TL[300]); MOE_UP(0, nt); } SEAM(15);
    if (IN(16)) { const int nt = __builtin_amdgcn_readfirstlane(TL[300]); MOE_DOWN(0, nt); } SEAM(16);
    if (IN(17)) { final_phase(F); }
#undef IN
#undef SEAM
}

extern "C" void kernel_launch(void* const* d_in, const int* in_sizes, int n_in, void* d_out, int out_size, void* d_ws, size_t ws_size, hipStream_t stream) {
    static int grid = 0;
    if (grid == 0) {
        int dev = 0, cus = 0;
        if (n_in != 35 || ws_size < WS_END) { fprintf(stderr, "kernel_launch: expected 35 inputs and >= %zu bytes of workspace (got %d, %zu)\n", (size_t)WS_END, n_in, ws_size); grid = -1; return; }
        if (hipGetDevice(&dev) != hipSuccess || hipDeviceGetAttribute(&cus, hipDeviceAttributeMultiprocessorCount, dev) != hipSuccess) { grid = -1; return; }
        if (hipFuncSetAttribute((const void*)fwd_kernel, hipFuncAttributeMaxDynamicSharedMemorySize, LDS_BYTES) != hipSuccess) { fprintf(stderr, "kernel_launch: hipFuncSetAttribute failed\n"); grid = -1; return; }
        int per_cu = 0;
        (void)hipOccupancyMaxActiveBlocksPerMultiprocessor(&per_cu, (const void*)fwd_kernel, NTHREADS, LDS_BYTES);
        (void)hipGetLastError();
        grid = cus;
        if (per_cu < 1) fprintf(stderr, "kernel_launch: occupancy query reports %d\n", per_cu);
    }
    if (grid < 0) return;
    (void)in_sizes; (void)out_size;
    hipMemsetAsync((char*)d_ws + WS_CTL, 0, 65536, stream);
    Args a; memset(&a, 0, sizeof(a));
    for (int i = 0; i < 35; ++i) a.in[i] = (const float*)d_in[i];
    a.out = (float*)d_out; a.ws = (unsigned char*)d_ws;
#if MK_N_LAUNCHES == 1
    a.ph_lo = 0; a.ph_hi = NPHASE;
    hipLaunchKernelGGL(fwd_kernel, dim3(grid), dim3(NTHREADS), LDS_BYTES, stream, a);
#else
#ifndef PROBE_REP
#define PROBE_REP 0
#endif
    for (int p = 0; p < NPHASE; ++p) { a.ph_lo = p; a.ph_hi = p + 1;
        if ((PROBE_REP >> p) & 1) { a.rep = 1; hipLaunchKernelGGL(fwd_kernel, dim3(grid), dim3(NTHREADS), LDS_BYTES, stream, a); }
        a.rep = 0; hipLaunchKernelGGL(fwd_kernel, dim3(grid), dim3(NTHREADS), LDS_BYTES, stream, a); }
#endif
}
```

```cpp
#include <hip/hip_runtime.h>
#include <cstdio>
#include <cstdint>
#include <cstring>

#define LAS __attribute__((address_space(3)))
#define GAS __attribute__((address_space(1)))
typedef unsigned short bf16_t;
typedef short bf16x8 __attribute__((ext_vector_type(8)));
typedef float f32x4 __attribute__((ext_vector_type(4)));
typedef float f32x16 __attribute__((ext_vector_type(16)));
typedef float f32x2 __attribute__((ext_vector_type(2)));
typedef unsigned u32x4 __attribute__((ext_vector_type(4)));
typedef unsigned u32x2 __attribute__((ext_vector_type(2)));

#ifndef MK_N_LAUNCHES
#define MK_N_LAUNCHES 1
#endif

constexpr int D = 2048, NB = 2, SEQ = 16384, NMETA = 16, LR = 16400, LP = 16512, M = NB * LP;
constexpr int DCONV = 1536, DSSM = 512, NIN_E = 5120, DFF = 5632, N13 = 2 * DFF;
constexpr int NIN_OA = 4864, NIN_OB = 3072;
constexpr int CA_QM = 0, CA_OM = 1024, CA_QD = 2048, CA_KD = 3072, CA_QI = 4096, CA_KI = 4608, CA_IM = 4672, CA_FM = 4676, CA_WI = 4680;
constexpr int RB_KM = 0, RB_VM = 1024, RB_VD = 2048;
constexpr float ALPHA = 1.41421356237309515f;
constexpr float LN_EPS = 1e-5f;
constexpr int S5CH = 128, S5NCH = LP / S5CH;
constexpr int NEXP = 8, MOE_CAP_TILES = 265, MOE_CAP = MOE_CAP_TILES * 256;
constexpr int BMP_PITCH = 544;
constexpr int NWAVES = 8, NTHREADS = 512;

constexpr size_t MiB = 1u << 20;
constexpr size_t WS_CTL = 0, CTL_BYTES = 1 * MiB;
constexpr size_t WS_WINE = 1 * MiB, WS_WOUTE = 21 * MiB, WS_W13 = 29 * MiB, WS_W2 = 73 * MiB, WS_WINOA = 95 * MiB, WS_WINOB = 118 * MiB;
constexpr size_t WS_HA = 138 * MiB, WS_HB = 267 * MiB, WS_PRE = 396 * MiB;
constexpr size_t WS_EW13 = 1 * MiB, WS_EW2 = 353 * MiB, WS_YB = 1 * MiB;
constexpr size_t WS_P = 529 * MiB, WS_KVT = 900 * MiB, WS_BMP = 1094 * MiB, WS_Y = 1163 * MiB, WS_PRE1 = 529 * MiB, WS_GH = 529 * MiB;
constexpr size_t WS_H2 = 1292 * MiB, WS_H3 = 1421 * MiB;
constexpr size_t WS_HBF8 = WS_HA;
constexpr size_t WS_H3F8 = 270 * MiB;
constexpr size_t WS_XE = 1550 * MiB;
constexpr size_t WS_S5T = WS_XE + 3584 * 1024;
constexpr size_t WS_MOE = 1555 * MiB;
constexpr size_t WS_KIC = 1558 * MiB;
constexpr size_t WS_WOUTO = 1563 * MiB;
constexpr size_t WS_END = 1571 * MiB;
constexpr size_t MO_TOKE = 0, MO_TOKG = 512 * 1024, MO_TOKPOS = 1024 * 1024, MO_TOKSLOT = 1536 * 1024, MO_SLOTTOK = 2048 * 1024, MO_TILEE = 2560 * 1024;
constexpr int CW_BAR = 0;
constexpr int CW_CNT = 4096;
constexpr int CW_Q2 = 8192;
constexpr int CW_Q1 = 8448;

constexpr int LDS_BYTES = 163840;
constexpr int LDS_MISC = 163840 - 256;
constexpr int D1_WAVE_BYTES = 36032;

#define LDS_WAIT() asm volatile("s_waitcnt lgkmcnt(0)" ::: "memory")
#define VM_WAIT() asm volatile("s_waitcnt vmcnt(0)" ::: "memory")
#define RAW_BAR() do { asm volatile("s_waitcnt lgkmcnt(0)" ::: "memory"); __builtin_amdgcn_s_barrier(); asm volatile("" ::: "memory"); } while (0)
__device__ __forceinline__ float bf2f(unsigned v) { return __uint_as_float(v << 16); }
__device__ __forceinline__ float bflo(unsigned w) { return __uint_as_float(w << 16); }
__device__ __forceinline__ float bfhi(unsigned w) { return __uint_as_float(w & 0xffff0000u); }
__device__ __forceinline__ unsigned f2bf(float f) { unsigned u = __float_as_uint(f); return (u + 0x7fffu + ((u >> 16) & 1u)) >> 16; }
typedef __bf16 bf16x2_t __attribute__((ext_vector_type(2)));
__device__ __forceinline__ unsigned pk4_f8(float a, float b, float c, float d) {
    a = __builtin_amdgcn_fmed3f(a, -448.f, 448.f); b = __builtin_amdgcn_fmed3f(b, -448.f, 448.f); c = __builtin_amdgcn_fmed3f(c, -448.f, 448.f); d = __builtin_amdgcn_fmed3f(d, -448.f, 448.f);
    int w = __builtin_amdgcn_cvt_pk_fp8_f32(a, b, 0, false); w = __builtin_amdgcn_cvt_pk_fp8_f32(c, d, w, true); return (unsigned)w; }
__device__ __forceinline__ unsigned pk4_i8(float a, float b, float c, float d) {
    const int ia = (int)__builtin_rintf(__builtin_amdgcn_fmed3f(a, -127.f, 127.f)), ib = (int)__builtin_rintf(__builtin_amdgcn_fmed3f(b, -127.f, 127.f));
    const int ic = (int)__builtin_rintf(__builtin_amdgcn_fmed3f(c, -127.f, 127.f)), id = (int)__builtin_rintf(__builtin_amdgcn_fmed3f(d, -127.f, 127.f));
    return (unsigned)(ia & 255) | ((unsigned)(ib & 255) << 8) | ((unsigned)(ic & 255) << 16) | ((unsigned)id << 24); }
constexpr float I8S_H = 28.f, I8S_W13 = 1280.f;
#ifndef FFN_DOWN_F8
#define FFN_DOWN_F8 1
#endif
constexpr float F8S_H3 = 8.f, F8S_W13 = 512.f, F8S_GH = 4.f, F8S_W2 = 2048.f;
__device__ __forceinline__ unsigned pk2(float lo, float hi) { bf16x2_t v; v[0] = (__bf16)lo; v[1] = (__bf16)hi; return __builtin_bit_cast(unsigned, v); }
template <int CTRL, int ROWMASK> __device__ __forceinline__ float dpp_add_f(float v) { return v + __int_as_float(__builtin_amdgcn_update_dpp(0, __float_as_int(v), CTRL, ROWMASK, 0xf, false)); }
__device__ __forceinline__ float wave_sum(float v) {
    v = dpp_add_f<0x111, 0xf>(v); v = dpp_add_f<0x112, 0xf>(v); v = dpp_add_f<0x114, 0xf>(v); v = dpp_add_f<0x118, 0xf>(v);
    v = dpp_add_f<0x142, 0xa>(v); v = dpp_add_f<0x143, 0xc>(v);
    return __int_as_float(__builtin_amdgcn_readlane(__float_as_int(v), 63));
}
__device__ __forceinline__ float fast_sigmoid(float x) { return __builtin_amdgcn_rcpf(1.0f + __expf(-x)); }

#define XB_TMO      128
#define XB_XCNT(j)  (256  + 64 * (j))
#define XB_XSUB(j)  (1280 + 64 * (j))
#define XB_XGEN(j)  (2304 + 64 * (j))
#define XB_TOP      3328
#define XB_TOPGEN   3392
#define XCD_BAR_WORDS 3456
#define XB_SPIN_CAP (1u << 22)

__device__ __forceinline__ unsigned xb_ld(unsigned* p)              { return __hip_atomic_load(p, __ATOMIC_RELAXED, __HIP_MEMORY_SCOPE_AGENT); }
__device__ __forceinline__ unsigned xb_add(unsigned* p, unsigned v) { return __hip_atomic_fetch_add(p, v, __ATOMIC_RELAXED, __HIP_MEMORY_SCOPE_AGENT); }
__device__ __forceinline__ unsigned xb_xcc_id() { return (unsigned)__builtin_amdgcn_s_getreg((3 << 11) | 20) & 0xFu; }
#define XB_SPIN(cond, bar) do { unsigned _sp = 0; while (cond) { __builtin_amdgcn_s_sleep(1); \
    if ((++_sp & 255u) == 0u) { if (xb_ld(&(bar)[XB_TMO])) break; if (_sp > XB_SPIN_CAP) { atomicAdd(&(bar)[XB_TMO], 1u); break; } } } } while (0)

struct XcdBarrier { unsigned* bar; unsigned x; volatile LAS unsigned* st; };

__device__ __forceinline__ XcdBarrier xcd_barrier_post(unsigned* bar, volatile LAS unsigned* st) {
    XcdBarrier b; b.bar = bar; b.x = xb_xcc_id(); b.st = st;
    if (threadIdx.x == 0) (void)xb_add(&bar[XB_XCNT(b.x)], 1u);
    return b;
}
__device__ __forceinline__ void xcd_barrier_complete(unsigned* bar, unsigned x, unsigned& nloc, unsigned& nx) {
    const unsigned G = gridDim.x * gridDim.y * gridDim.z;
    unsigned sum, cnt, mine, sp = 0u;
    for (;;) {
        sum = 0u; cnt = 0u; mine = 0u;
#pragma unroll
        for (unsigned j = 0; j < 16; ++j) { const unsigned c = xb_ld(&bar[XB_XCNT(j)]); sum += c; cnt += (c > 0u) ? 1u : 0u; mine = (j == x) ? c : mine; }
        if (sum == G) break;
        __builtin_amdgcn_s_sleep(1);
        if ((++sp & 255u) == 0u) { if (xb_ld(&bar[XB_TMO])) break; if (sp > XB_SPIN_CAP) { atomicAdd(&bar[XB_TMO], 1u); break; } }
    }
    nloc = mine > 0u ? mine : 1u; nx = cnt > 0u ? cnt : 1u;
}
__device__ __forceinline__ void xcd_barrier(const XcdBarrier& b) {
    asm volatile("s_waitcnt vmcnt(0)" ::: "memory");
    __syncthreads();
    if (threadIdx.x == 0) {
        unsigned* bar = b.bar;
        __builtin_amdgcn_s_waitcnt(0);
        unsigned nloc = b.st[0], nx = b.st[1];
        if (nloc == 0u) { xcd_barrier_complete(bar, b.x, nloc, nx); b.st[0] = nloc; b.st[1] = nx; }
        const unsigned old = xb_add(&bar[XB_XSUB(b.x)], 1u);
        const unsigned gen = old / nloc;
        if (old + 1u == (gen + 1u) * nloc) {
            __builtin_amdgcn_fence(__ATOMIC_RELEASE, "agent");
            asm volatile("s_waitcnt vmcnt(0)" ::: "memory");
            const unsigned og = xb_add(&bar[XB_TOP], 1u);
            const unsigned tg = og / nx;
            if (og + 1u == (tg + 1u) * nx) xb_add(&bar[XB_TOPGEN], 1u);
            else XB_SPIN(xb_ld(&bar[XB_TOPGEN]) == tg, bar);
            __builtin_amdgcn_fence(__ATOMIC_ACQUIRE, "agent");
            xb_add(&bar[XB_XGEN(b.x)], 1u);
            asm volatile("s_waitcnt vmcnt(0)" ::: "memory");
        } else {
            XB_SPIN(xb_ld(&bar[XB_XGEN(b.x)]) == gen, bar);
            __builtin_amdgcn_fence(__ATOMIC_ACQUIRE, "agent");
            asm volatile("s_waitcnt vmcnt(0)" ::: "memory");
        }
    }
    __syncthreads();
}
#define PROBE_REP 0
#define PROBE_ML 0
#define PROBE_D1 0
#define PROBE_D2 0
#define PROBE_G3 1
namespace pg8 {
constexpr int BM = 256, BK = 64, HALF = 128, HTB = HALF * BK * 2, STAGE_BYTES = 8 * HTB, NXCD = 8, WGM = 8;
__host__ __device__ __forceinline__ int lds_byte(int r, int c) { const int st = (r >> 4) * 2 + (c >> 5), rr = r & 15, cc = c & 31, ob = rr * 64 + cc * 2; return st * 1024 + (ob ^ (((ob >> 9) & 1) << 5)); }
__host__ __device__ __forceinline__ void stage_rc(int b, int& R, int& C) { const int st = b / 1024, sb = b % 1024, swz = sb ^ (((sb >> 9) & 1) << 5); R = (st >> 1) * 16 + swz / 64; C = (st & 1) * 32 + (swz % 64) / 2; }
__host__ __device__ __forceinline__ int perm32(int rho) { const int n = rho >> 4, i = rho & 15; return 8 * (i >> 2) + 4 * n + (i & 3); }

struct Unit { int pm, pn; };
__device__ __forceinline__ int frame_row0(int pm) { return (pm >> 6) * LP + NMETA + (pm & 63) * BM; }
struct StaticOrder {
    int nM, nN, nwg, G, c;
    __device__ void init(int nM_, int nN_, int G_, int c_) { nM = nM_; nN = nN_; nwg = nM * nN; G = G_; c = c_; }
    __device__ bool next(int i, Unit& u) const {
        const long L = (long)i * G + c; if (L >= nwg) return false;
        int wgid = (int)L; { const int q = nwg / NXCD, r = nwg % NXCD, xcd = wgid % NXCD, off = wgid / NXCD; wgid = (xcd < r ? xcd * (q + 1) : r * (q + 1) + (xcd - r) * q) + off; }
        const int nig = WGM * nN, gid = wgid / nig, fm = gid * WGM, gsz = (nM - fm) < WGM ? (nM - fm) : WGM;
        u.pm = fm + ((wgid % nig) % gsz); u.pn = (wgid % nig) / gsz; return true;
    }
};
struct LinProv {
    StaticOrder so; const char* Bt; int K; int probe_same = 0; int frames = 0;
    __device__ __forceinline__ bool next(int i, Unit& u) const { const bool r = so.next(i, u); if (probe_same) { u.pm &= 3; u.pn &= 3; } return r; }
    __device__ __forceinline__ void aoffs(const Unit& u, const int (&RA)[2], const int (&CA)[2], unsigned (&v)[2][2]) const {
#pragma unroll
        for (int h = 0; h < 2; ++h)
#pragma unroll
            for (int i = 0; i < 2; ++i) v[h][i] = (unsigned)(((frames ? frame_row0(u.pm) : u.pm * BM) + h * HALF + RA[i]) * K + CA[i]) * 2u;
    }
    __device__ __forceinline__ const char* bbase(const Unit& u) const { return Bt + (size_t)u.pn * BM * K * 2; }
};
struct GatherProv {
    StaticOrder so; const char* Bt; int K; const int* rowidx; const int* tile_e; int t_lo; size_t estride;
    __device__ __forceinline__ bool next(int i, Unit& u) const { return so.next(i, u); }
    __device__ __forceinline__ void aoffs(const Unit& u, const int (&RA)[2], const int (&CA)[2], unsigned (&v)[2][2]) const {
#pragma unroll
        for (int h = 0; h < 2; ++h)
#pragma unroll
            for (int i = 0; i < 2; ++i) { const int row = rowidx ? rowidx[(t_lo + u.pm) * BM + h * HALF + RA[i]] : (u.pm * BM + h * HALF + RA[i]); v[h][i] = (unsigned)(row * K + CA[i]) * 2u; }
    }
    __device__ __forceinline__ const char* bbase(const Unit& u) const { const int e = __builtin_amdgcn_readfirstlane(tile_e[t_lo + u.pm]); return Bt + (size_t)e * estride + (size_t)u.pn * BM * K * 2; }
};

struct EpiBf16 {
    static constexpr bool PERM = true;
    bf16_t* O; int ldc; bf16_t* X = nullptr; int xpn = -1;
    __device__ __forceinline__ void operator()(const f32x4 (&acc)[2][2][4][2], const Unit& u, int wr, int wc, int fr, int fq) const {
        const int row0 = u.pm * BM + wr * 64 + fr, col0 = u.pn * BM + wc * 32 + 8 * fq;
        const bool xc = (u.pn == xpn) && (wc < 2);
#pragma unroll
        for (int ai = 0; ai < 2; ++ai)
#pragma unroll
            for (int m = 0; m < 4; ++m) { bf16_t* rowp = O + (size_t)(row0 + ai * HALF + m * 16) * ldc + col0;
#pragma unroll
                for (int bj = 0; bj < 2; ++bj) { const f32x4 v0 = acc[ai][bj][m][0], v1 = acc[ai][bj][m][1];
                    u32x4 w; w.x = pk2(v0[0], v0[1]); w.y = pk2(v0[2], v0[3]); w.z = pk2(v1[0], v1[1]); w.w = pk2(v1[2], v1[3]);
                    *(u32x4*)(rowp + bj * HALF) = w;
                    if (bj == 0 && xc) *(u32x4*)(X + (size_t)(row0 + ai * HALF + m * 16) * 64 + wc * 32 + 8 * fq) = w; } }
    }
};
struct EpiGated {
    static constexpr bool PERM = true;
    bf16_t* O; int ldc; int nostore;
    __device__ __forceinline__ void operator()(const f32x4 (&acc)[2][2][4][2], const Unit& u, int wr, int wc, int fr, int fq) const {
        if (nostore == 1) return;
        if (nostore == 2) {
            const int wv = wr * 4 + wc; char* slab = (char*)O + ((size_t)(u.pm * 44 + u.pn) * 8 + wv) * 8192 + (fq * 16 + fr) * 16;
#pragma unroll
            for (int ai = 0; ai < 2; ++ai)
#pragma unroll
                for (int m = 0; m < 4; ++m) { float r[8];
#pragma unroll
                    for (int n = 0; n < 2; ++n)
#pragma unroll
                        for (int j = 0; j < 4; ++j) { const float a = acc[ai][0][m][n][j], b = acc[ai][1][m][n][j]; r[n * 4 + j] = a * b * __builtin_amdgcn_rcpf(1.0f + __expf(-a)); }
                    u32x4 w; w.x = pk2(r[0], r[1]); w.y = pk2(r[2], r[3]); w.z = pk2(r[4], r[5]); w.w = pk2(r[6], r[7]);
                    *(u32x4*)(slab + (ai * 4 + m) * 1024) = w; }
            return; }
        const int row0 = u.pm * BM + wr * 64 + fr, col0 = u.pn * HALF + wc * 32 + 8 * fq;
#pragma unroll
        for (int ai = 0; ai < 2; ++ai)
#pragma unroll
            for (int m = 0; m < 4; ++m) { bf16_t* rowp = O + (size_t)(row0 + ai * HALF + m * 16) * ldc + col0;
                float r[8];
#pragma unroll
                for (int n = 0; n < 2; ++n)
#pragma unroll
                    for (int j = 0; j < 4; ++j) { const float a = acc[ai][0][m][n][j], b = acc[ai][1][m][n][j]; r[n * 4 + j] = a * b * __builtin_amdgcn_rcpf(1.0f + __expf(-a)); }
                u32x4 w; w.x = pk2(r[0], r[1]); w.y = pk2(r[2], r[3]); w.z = pk2(r[4], r[5]); w.w = pk2(r[6], r[7]);
                *(u32x4*)rowp = w; }
    }
};
struct EpiResBf16S {
    static constexpr bool PERM = true;
    bf16_t* C; const bf16_t* H; int ldc; float alpha, scale;
    __device__ __forceinline__ void operator()(const f32x4 (&acc)[2][2][4][2], const Unit& u, int wr, int wc, int fr, int fq) const {
        const int row0 = u.pm * BM + wr * 64 + fr, col0 = u.pn * BM + wc * 32 + 8 * fq;
#pragma unroll
        for (int ai = 0; ai < 2; ++ai)
#pragma unroll
            for (int m = 0; m < 4; ++m) { const size_t off = (size_t)(row0 + ai * HALF + m * 16) * ldc + col0;
#pragma unroll
                for (int bj = 0; bj < 2; ++bj) { const u32x4 hv = *(const u32x4*)(H + off + bj * HALF); const f32x4 v0 = acc[ai][bj][m][0] * scale, v1 = acc[ai][bj][m][1] * scale;
                    u32x4 w; w.x = pk2(alpha * bflo(hv.x) + v0[0], alpha * bfhi(hv.x) + v0[1]); w.y = pk2(alpha * bflo(hv.y) + v0[2], alpha * bfhi(hv.y) + v0[3]);
                    w.z = pk2(alpha * bflo(hv.z) + v1[0], alpha * bfhi(hv.z) + v1[1]); w.w = pk2(alpha * bflo(hv.w) + v1[2], alpha * bfhi(hv.w) + v1[3]);
                    *(u32x4*)(C + off + bj * HALF) = w; } }
    }
};
struct EpiBf16S {
    static constexpr bool PERM = true;
    bf16_t* O; int ldc; float scale;
    __device__ __forceinline__ void operator()(const f32x4 (&acc)[2][2][4][2], const Unit& u, int wr, int wc, int fr, int fq) const {
        const int row0 = u.pm * BM + wr * 64 + fr, col0 = u.pn * BM + wc * 32 + 8 * fq;
#pragma unroll
        for (int ai = 0; ai < 2; ++ai)
#pragma unroll
            for (int m = 0; m < 4; ++m) { bf16_t* rowp = O + (size_t)(row0 + ai * HALF + m * 16) * ldc + col0;
#pragma unroll
                for (int bj = 0; bj < 2; ++bj) { const f32x4 v0 = acc[ai][bj][m][0] * scale, v1 = acc[ai][bj][m][1] * scale;
                    u32x4 w; w.x = pk2(v0[0], v0[1]); w.y = pk2(v0[2], v0[3]); w.z = pk2(v1[0], v1[1]); w.w = pk2(v1[2], v1[3]);
                    *(u32x4*)(rowp + bj * HALF) = w; } }
    }
};
struct EpiGatedS {
    static constexpr bool PERM = true;
    bf16_t* O; int ldc; float sin;
    __device__ __forceinline__ void operator()(const f32x4 (&acc)[2][2][4][2], const Unit& u, int wr, int wc, int fr, int fq) const {
        const int row0 = u.pm * BM + wr * 64 + fr, col0 = u.pn * HALF + wc * 32 + 8 * fq;
#pragma unroll
        for (int ai = 0; ai < 2; ++ai)
#pragma unroll
            for (int m = 0; m < 4; ++m) { bf16_t* rowp = O + (size_t)(row0 + ai * HALF + m * 16) * ldc + col0;
                float r[8];
#pragma unroll
                for (int n = 0; n < 2; ++n)
#pragma unroll
                    for (int j = 0; j < 4; ++j) { const float a = acc[ai][0][m][n][j] * sin, b = acc[ai][1][m][n][j] * sin; r[n * 4 + j] = a * b * __builtin_amdgcn_rcpf(1.0f + __expf(-a)); }
                u32x4 w; w.x = pk2(r[0], r[1]); w.y = pk2(r[2], r[3]); w.z = pk2(r[4], r[5]); w.w = pk2(r[6], r[7]);
                *(u32x4*)rowp = w; }
    }
};
struct EpiGatedF8 {
    static constexpr bool PERM = true;
    unsigned char* O; int ldc; float sin, sout;
    __device__ __forceinline__ void operator()(const f32x4 (&acc)[2][2][4][2], const Unit& u, int wr, int wc, int fr, int fq) const {
        const int row0 = u.pm * BM + wr * 64 + fr, col0 = u.pn * HALF + wc * 32 + 8 * fq;
        const float sb = sin * sout;
#pragma unroll
        for (int ai = 0; ai < 2; ++ai)
#pragma unroll
            for (int m = 0; m < 4; ++m) { unsigned char* rowp = O + (size_t)(row0 + ai * HALF + m * 16) * ldc + col0;
                float r[8];
#pragma unroll
                for (int n = 0; n < 2; ++n)
#pragma unroll
                    for (int j = 0; j < 4; ++j) { const float a = acc[ai][0][m][n][j] * sin, b = acc[ai][1][m][n][j] * sb; r[n * 4 + j] = a * b * __builtin_amdgcn_rcpf(1.0f + __expf(-a)); }
                u32x2 w; w.x = pk4_f8(r[0], r[1], r[2], r[3]); w.y = pk4_f8(r[4], r[5], r[6], r[7]);
                *(u32x2*)rowp = w; }
    }
};
struct EpiResBf16 {
    static constexpr bool PERM = true;
    bf16_t* C; const bf16_t* H; int ldc; float alpha; int frames = 0;
    __device__ __forceinline__ void operator()(const f32x4 (&acc)[2][2][4][2], const Unit& u, int wr, int wc, int fr, int fq) const {
        const int row0 = (frames ? frame_row0(u.pm) : u.pm * BM) + wr * 64 + fr, col0 = u.pn * BM + wc * 32 + 8 * fq;
#pragma unroll
        for (int ai = 0; ai < 2; ++ai)
#pragma unroll
            for (int m = 0; m < 4; ++m) { const size_t off = (size_t)(row0 + ai * HALF + m * 16) * ldc + col0;
#pragma unroll
                for (int bj = 0; bj < 2; ++bj) { const u32x4 hv = *(const u32x4*)(H + off + bj * HALF); const f32x4 v0 = acc[ai][bj][m][0], v1 = acc[ai][bj][m][1];
                    u32x4 w; w.x = pk2(alpha * bflo(hv.x) + v0[0], alpha * bfhi(hv.x) + v0[1]); w.y = pk2(alpha * bflo(hv.y) + v0[2], alpha * bfhi(hv.y) + v0[3]);
                    w.z = pk2(alpha * bflo(hv.z) + v1[0], alpha * bfhi(hv.z) + v1[1]); w.w = pk2(alpha * bflo(hv.w) + v1[2], alpha * bfhi(hv.w) + v1[3]);
                    *(u32x4*)(C + off + bj * HALF) = w; } }
    }
};

typedef int i32x4v __attribute__((ext_vector_type(4)));
typedef int i32x8v __attribute__((ext_vector_type(8)));
template <int MODE> struct Frag;
template <> struct Frag<0> { bf16x8 v[2]; };
template <> struct Frag<1> { i32x8v v; };
template <> struct Frag<2> { i32x4v v[2]; };
__device__ __forceinline__ void ldfrag(Frag<0>& f, const LAS unsigned char* p) { f.v[0] = *(const LAS bf16x8*)p; f.v[1] = *(const LAS bf16x8*)(p + 1024); }
__device__ __forceinline__ void ldfrag(Frag<1>& f, const LAS unsigned char* p) { const i32x4v a = *(const LAS i32x4v*)p, b = *(const LAS i32x4v*)(p + 1024); f.v = __builtin_shufflevector(a, b, 0, 1, 2, 3, 4, 5, 6, 7); }
__device__ __forceinline__ void ldfrag(Frag<2>& f, const LAS unsigned char* p) { f.v[0] = *(const LAS i32x4v*)p; f.v[1] = *(const LAS i32x4v*)(p + 1024); }
__device__ __forceinline__ void mmafrag(f32x4& acc, const Frag<0>& b, const Frag<0>& a) { acc = __builtin_amdgcn_mfma_f32_16x16x32_bf16(b.v[0], a.v[0], acc, 0, 0, 0); acc = __builtin_amdgcn_mfma_f32_16x16x32_bf16(b.v[1], a.v[1], acc, 0, 0, 0); }
__device__ __forceinline__ void mmafrag(f32x4& acc, const Frag<1>& b, const Frag<1>& a) { acc = __builtin_amdgcn_mfma_scale_f32_16x16x128_f8f6f4(b.v, a.v, acc, 0, 0, 0, 0, 0, 0); }
__device__ __forceinline__ void mmafrag(f32x4& acc, const Frag<2>& b, const Frag<2>& a) {
    i32x4v c = __builtin_bit_cast(i32x4v, acc); c = __builtin_amdgcn_mfma_i32_16x16x64_i8(b.v[0], a.v[0], c, 0, 0, 0); c = __builtin_amdgcn_mfma_i32_16x16x64_i8(b.v[1], a.v[1], c, 0, 0, 0); acc = __builtin_bit_cast(f32x4, c); }
template <class Epi, class Prov, int MODE = 0>
__device__ __forceinline__ void gemm_phase(LAS unsigned char* lds, const char* Abase, const int K, const Prov& S, const Epi& E) {
    constexpr bool F8 = (MODE == 1);
    const int tid = threadIdx.x, wid = __builtin_amdgcn_readfirstlane(tid >> 6), lane = tid & 63, wr = wid >> 2, wc = wid & 3, fr = lane & 15, fq = lane >> 4;
    const int nt = K / BK;
    int RA[2], CA[2]; unsigned voffB[2];
#pragma unroll
    for (int i = 0; i < 2; ++i) { int R, C; stage_rc(tid * 16 + i * 8192, R, C); const int Rb = Epi::PERM ? ((R & ~31) + perm32(R & 31)) : R;
        RA[i] = R; CA[i] = C; voffB[i] = (unsigned)(Rb * K + C) * 2u; }
    const size_t kstep = (size_t)(BK * 2);
    const size_t hstep = (size_t)HALF * K * 2;
    const unsigned ldsw = (unsigned)wid * 1024u;
    const unsigned ldsb = (unsigned)(size_t)lds + ldsw;
    const int aoff = lds_byte(wr * 64 + fr, fq * 8), boff = lds_byte(wc * 32 + fr, fq * 8);
#define PG8_SA(b, h) (((b) * 2 + (h)) * HTB)
#define PG8_SB(b, h) ((4 + (b) * 2 + (h)) * HTB)
#define PG8_STAGE(bufoff, gbase, voff) do { _Pragma("unroll") for (int _i = 0; _i < 2; ++_i) { \
        if (F8) asm volatile("s_mov_b32 m0, %0\n\ts_nop 0\n\tglobal_load_lds_dwordx4 %1, %2" :: "s"(ldsb + (unsigned)((bufoff) + _i * 8192)), "v"((voff)[_i]), "s"((const char*)(gbase)) : "memory", "m0"); \
        else __builtin_amdgcn_global_load_lds((const unsigned*)((const char*)(gbase) + (voff)[_i]), (LAS unsigned*)(lds + (bufoff) + ldsw + _i * 8192), 16, 0, 0); } } while (0)
#define PG8_LDA(dst, b, h) do { _Pragma("unroll") for (int m = 0; m < 4; ++m) ldfrag(dst[m], lds + PG8_SA(b, h) + aoff + m * 2048); } while (0)
#define PG8_LDB(dst, b, h) do { _Pragma("unroll") for (int n = 0; n < 2; ++n) ldfrag(dst[n], lds + PG8_SB(b, h) + boff + n * 2048); } while (0)
#define PG8_MMA(ai, bj, At, Bt) do { __builtin_amdgcn_s_setprio(1); _Pragma("unroll") for (int m = 0; m < 4; ++m) _Pragma("unroll") for (int n = 0; n < 2; ++n) { \
        if (F8) { f32x4 c_; _Pragma("unroll") for (int j_ = 0; j_ < 4; ++j_) c_[j_] = acc16[ai][bj][m >> 1][8 * (m & 1) + 4 * n + j_]; mmafrag(c_, Bt[n], At[m]); \
                  _Pragma("unroll") for (int j_ = 0; j_ < 4; ++j_) acc16[ai][bj][m >> 1][8 * (m & 1) + 4 * n + j_] = c_[j_]; } \
        else mmafrag(acc[ai][bj][m][n], Bt[n], At[m]); } __builtin_amdgcn_s_setprio(0); } while (0)
#define PG8_WAIT_V(n) asm volatile("s_waitcnt vmcnt(" #n ")" ::: "memory")
#define PG8_WAIT_L(n) asm volatile("s_waitcnt lgkmcnt(" #n ")" ::: "memory")
#define PG8_BAR __builtin_amdgcn_s_barrier()
#define PG8_SCHED __builtin_amdgcn_sched_barrier(0)
    Unit cur, nxt; int ui = 0;
    if (!S.next(0, cur)) return;
    f32x4 acc[2][2][4][2];
    f32x16 acc16[2][2][2];
#pragma unroll
    for (int a = 0; a < 2; ++a)
#pragma unroll
        for (int b = 0; b < 2; ++b)
#pragma unroll
            for (int q = 0; q < 2; ++q)
#pragma unroll
                for (int j = 0; j < 16; ++j) acc16[a][b][q][j] = 0.f;
#pragma unroll
    for (int a = 0; a < 2; ++a)
#pragma unroll
        for (int b = 0; b < 2; ++b)
#pragma unroll
            for (int m = 0; m < 4; ++m)
#pragma unroll
                for (int n = 0; n < 2; ++n) acc[a][b][m][n] = (f32x4){0.f, 0.f, 0.f, 0.f};
    Frag<MODE> At[4], B0[2], B1[2];
    unsigned vAc[2][2], vAn[2][2];
    S.aoffs(cur, RA, CA, vAc);
    const char* cB = S.bbase(cur);
    const char* A0 = Abase;
    PG8_STAGE(PG8_SB(0, 0), cB, voffB); PG8_STAGE(PG8_SA(0, 0), A0, vAc[0]); PG8_STAGE(PG8_SB(0, 1), cB + hstep, voffB); PG8_STAGE(PG8_SA(0, 1), A0, vAc[1]);
    if (wr == 1) PG8_BAR;
    PG8_WAIT_V(4); PG8_BAR;
    PG8_STAGE(PG8_SB(1, 0), cB + kstep, voffB); PG8_STAGE(PG8_SA(1, 0), A0 + kstep, vAc[0]); PG8_STAGE(PG8_SB(1, 1), cB + hstep + kstep, voffB);
    PG8_WAIT_V(6); PG8_BAR;
    for (;;) {
        const bool has_next = S.next(ui + 1, nxt);
        const char* nB = cB;
        if (has_next) { S.aoffs(nxt, RA, CA, vAn); nB = S.bbase(nxt); }
        else {
#pragma unroll
            for (int h = 0; h < 2; ++h)
#pragma unroll
                for (int i = 0; i < 2; ++i) vAn[h][i] = vAc[h][i];
        }
        for (int t = 0; t < nt; t += 2) {
            const bool last = (t == nt - 2);
            const char* a1 = A0 + (size_t)(t + 1) * kstep;
            const char* a2 = last ? A0 : A0 + (size_t)(t + 2) * kstep; const char* b2 = last ? nB : cB + (size_t)(t + 2) * kstep;
            const char* a3 = a2 + kstep; const char* b3 = b2 + kstep;
            unsigned v2[2][2];
#pragma unroll
            for (int h = 0; h < 2; ++h)
#pragma unroll
                for (int i = 0; i < 2; ++i) v2[h][i] = last ? vAn[h][i] : vAc[h][i];
            PG8_LDB(B0, 0, 0); PG8_SCHED; PG8_LDA(At, 0, 0); PG8_STAGE(PG8_SA(1, 1), a1, vAc[1]);
            PG8_WAIT_L(8); PG8_BAR; PG8_WAIT_L(0); PG8_MMA(0, 0, At, B0); PG8_BAR; PG8_SCHED;
            PG8_LDB(B1, 0, 1); PG8_STAGE(PG8_SB(0, 0), b2, voffB);
            PG8_BAR; PG8_WAIT_L(0); PG8_MMA(0, 1, At, B1); PG8_BAR;
            PG8_LDA(At, 0, 1); PG8_STAGE(PG8_SA(0, 0), a2, v2[0]);
            PG8_BAR; PG8_WAIT_L(0); PG8_MMA(1, 0, At, B0); PG8_BAR; PG8_SCHED;
            PG8_STAGE(PG8_SB(0, 1), b2 + hstep, voffB);
            PG8_WAIT_V(6); PG8_BAR; PG8_MMA(1, 1, At, B1); PG8_BAR;
            PG8_LDB(B0, 1, 0); PG8_SCHED; PG8_LDA(At, 1, 0); PG8_STAGE(PG8_SA(0, 1), a2, v2[1]);
            PG8_WAIT_L(8); PG8_BAR; PG8_WAIT_L(0); PG8_MMA(0, 0, At, B0); PG8_BAR; PG8_SCHED;
            PG8_LDB(B1, 1, 1); PG8_STAGE(PG8_SB(1, 0), b3, voffB);
            PG8_BAR; PG8_WAIT_L(0); PG8_MMA(0, 1, At, B1); PG8_BAR;
            PG8_LDA(At, 1, 1); PG8_STAGE(PG8_SA(1, 0), a3, v2[0]);
            PG8_BAR; PG8_WAIT_L(0); PG8_MMA(1, 0, At, B0); PG8_BAR; PG8_SCHED;
            PG8_STAGE(PG8_SB(1, 1), b3 + hstep, voffB);
            PG8_WAIT_V(6); PG8_BAR; PG8_MMA(1, 1, At, B1); PG8_BAR;
        }
        if (F8) {
#pragma unroll
            for (int a = 0; a < 2; ++a)
#pragma unroll
                for (int b = 0; b < 2; ++b)
#pragma unroll
                    for (int m = 0; m < 4; ++m)
#pragma unroll
                        for (int n = 0; n < 2; ++n)
#pragma unroll
                            for (int j = 0; j < 4; ++j) { acc[a][b][m][n][j] = acc16[a][b][m >> 1][8 * (m & 1) + 4 * n + j]; acc16[a][b][m >> 1][8 * (m & 1) + 4 * n + j] = 0.f; }
        }
        if (MODE == 2) {
#pragma unroll
            for (int a = 0; a < 2; ++a)
#pragma unroll
                for (int b = 0; b < 2; ++b)
#pragma unroll
                    for (int m = 0; m < 4; ++m)
#pragma unroll
                        for (int n = 0; n < 2; ++n)
#pragma unroll
                            for (int j = 0; j < 4; ++j) acc[a][b][m][n][j] = (float)__float_as_int(acc[a][b][m][n][j]);
        }
        E(acc, cur, wr, wc, fr, fq);
        if (!has_next) break;
#pragma unroll
        for (int a = 0; a < 2; ++a)
#pragma unroll
            for (int b = 0; b < 2; ++b)
#pragma unroll
                for (int m = 0; m < 4; ++m)
#pragma unroll
                    for (int n = 0; n < 2; ++n) acc[a][b][m][n] = (f32x4){0.f, 0.f, 0.f, 0.f};
        cur = nxt; cB = nB; ++ui;
#pragma unroll
        for (int h = 0; h < 2; ++h)
#pragma unroll
            for (int i = 0; i < 2; ++i) vAc[h][i] = vAn[h][i];
    }
    PG8_WAIT_V(0);
    if (wr == 0) PG8_BAR;
    PG8_BAR;
#undef PG8_SA
#undef PG8_SB
#undef PG8_STAGE
#undef PG8_LDA
#undef PG8_LDB
#undef PG8_MMA
#undef PG8_WAIT_V
#undef PG8_WAIT_L
#undef PG8_BAR
#undef PG8_SCHED
}
}
struct Frame {
    LAS unsigned char* lds;
    unsigned* ctl;
    unsigned char* ws;
    const float* in[35];
    float* out;
    int tid, lane, wave, G, bid;
};
enum { I_X = 0, I_META, I_WINE, I_CONVW, I_ARE, I_AIM, I_LOGDT, I_BRE, I_BIM, I_CRE, I_CIM, I_S5D, I_WGLU, I_WOUTE, I_LN1G, I_LN1B, I_W1, I_W3, I_W2, I_LN2G, I_LN2B,
       I_WINO, I_MBI, I_MBF, I_RELB, I_WOUTO, I_LN3G, I_LN3B, I_RW, I_RB, I_EW1, I_EW3, I_EW2, I_LN4G, I_LN4B };

struct SrcRef { const float* p; int col; float sc; };
template <class F> __device__ __forceinline__ void transpose_item(const F& f, int ldw, bf16_t* dst, int Kd, int k0, int n0, LAS float* scr, int lane) {
    const SrcRef s = f(n0 + (lane & 31));
#pragma unroll 8
    for (int i = 0; i < 32; ++i) { const int kk = 2 * i + (lane >> 5); scr[kk * 33 + (lane & 31)] = s.p[(size_t)(k0 + kk) * ldw + s.col] * s.sc; }
    LDS_WAIT();
    const int c = lane & 7;
#pragma unroll
    for (int j = 0; j < 4; ++j) { const int n = (lane >> 3) + 8 * j; const LAS float* sp = scr + (8 * c) * 33 + n;
        u32x4 o; o.x = pk2(sp[0 * 33], sp[1 * 33]); o.y = pk2(sp[2 * 33], sp[3 * 33]); o.z = pk2(sp[4 * 33], sp[5 * 33]); o.w = pk2(sp[6 * 33], sp[7 * 33]);
        *(u32x4*)(dst + (size_t)(n0 + n) * Kd + k0 + 8 * c) = o; }
    LDS_WAIT();
}
#define PK4(a, b, c, d) (I8 ? pk4_i8(a, b, c, d) : pk4_f8(a, b, c, d))
template <bool I8, class F> __device__ __forceinline__ void transpose_item_f8(const F& f, int ldw, unsigned char* dst, int Kd, int k0, int n0, float scale, LAS float* scr, int lane) {
    const SrcRef s = f(n0 + (lane & 31));
#pragma unroll 8
    for (int i = 0; i < 32; ++i) { const int kk = 2 * i + (lane >> 5); scr[kk * 33 + (lane & 31)] = s.p[(size_t)(k0 + kk) * ldw + s.col] * (s.sc * scale); }
    LDS_WAIT();
    const int c = lane & 3;
#pragma unroll
    for (int j = 0; j < 2; ++j) { const int n = (lane >> 2) + 16 * j; const LAS float* sp = scr + (16 * c) * 33 + n;
        u32x4 o; o.x = PK4(sp[0 * 33], sp[1 * 33], sp[2 * 33], sp[3 * 33]); o.y = PK4(sp[4 * 33], sp[5 * 33], sp[6 * 33], sp[7 * 33]);
        o.z = PK4(sp[8 * 33], sp[9 * 33], sp[10 * 33], sp[11 * 33]); o.w = PK4(sp[12 * 33], sp[13 * 33], sp[14 * 33], sp[15 * 33]);
        *(u32x4*)(dst + (size_t)(n0 + n) * Kd + k0 + 16 * c) = o; }
    LDS_WAIT();
}
#undef PK4
struct MapIdent { const float* w; __device__ __forceinline__ SrcRef operator()(int n) const { return SrcRef{w, n, 1.f}; } };
struct MapGated { const float* w1; const float* w3; __device__ __forceinline__ SrcRef operator()(int n) const { const int t = n >> 8, r = n & 255; return r < 128 ? SrcRef{w1, t * 128 + r, 1.f} : SrcRef{w3, t * 128 + r - 128, 1.f}; } };
struct MapOddA { const float* w; __device__ __forceinline__ SrcRef operator()(int n) const {
    int c;
    if (n < 1024) c = n;
    else if (n < 2048) c = 3072 + (n - 1024);
    else if (n < 3072) c = 4104 + (n - 2048);
    else if (n < 4096) c = 5128 + (n - 3072);
    else if (n < 4608) c = 7176 + (n - 4096);
    else if (n < 4672) c = 7688 + (n - 4608);
    else if (n < 4676) c = 4096 + (n - 4672);
    else if (n < 4680) c = 4100 + (n - 4676);
    else if (n < 4688) c = 7752 + (n - 4680);
    else return SrcRef{w, 0, 0.f};
    return SrcRef{w, c, 1.f}; } };
struct MapOddB { const float* w; __device__ __forceinline__ SrcRef operator()(int n) const {
    int c;
    if (n < 1024) c = 1024 + n;
    else if (n < 2048) c = 2048 + (n - 1024);
    else c = 6152 + (n - 2048);
    return SrcRef{w, c, 1.f}; } };

__device__ __forceinline__ void p0_prologue(Frame& F) {
    LAS float* scr = (LAS float*)(F.lds + F.wave * 16384);
    const int gw = F.bid * NWAVES + F.wave, NGW = F.G * NWAVES;
    bf16_t* WINE = (bf16_t*)(F.ws + WS_WINE); bf16_t* WOUTE = (bf16_t*)(F.ws + WS_WOUTE);
    bf16_t* WINOA = (bf16_t*)(F.ws + WS_WINOA); bf16_t* WINOB = (bf16_t*)(F.ws + WS_WINOB); bf16_t* WOUTO = (bf16_t*)(F.ws + WS_WOUTO);
    constexpr int I1 = (NIN_E / 32) * (D / 64), I2 = (D / 32) * (D / 64), I3 = (N13 / 32) * (D / 64), I4 = (D / 32) * (DFF / 64), I5 = (NIN_OA / 32) * (D / 64), I6 = (NIN_OB / 32) * (D / 64), I7 = I2;
    constexpr int NITEMS = I1 + I2 + I3 + I4 + I5 + I6 + I7;
    for (int it = gw; it < NITEMS; it += NGW) {
        int r = it;
        if (r < I1) { const int nb = NIN_E / 32; transpose_item(MapIdent{F.in[I_WINE]}, NIN_E, WINE, D, (r / nb) * 64, (r % nb) * 32, scr, F.lane); continue; } r -= I1;
        if (r < I2) { const int nb = D / 32; transpose_item(MapIdent{F.in[I_WOUTE]}, D, WOUTE, D, (r / nb) * 64, (r % nb) * 32, scr, F.lane); continue; } r -= I2;
        if (r < I3) { const int nb = N13 / 32; transpose_item_f8<true>(MapGated{F.in[I_W1], F.in[I_W3]}, DFF, F.ws + WS_W13, D, (r / nb) * 64, (r % nb) * 32, I8S_W13, scr, F.lane); continue; } r -= I3;
        if (r < I4) { const int nb = D / 32;
#if FFN_DOWN_F8
            transpose_item_f8<false>(MapIdent{F.in[I_W2]}, D, F.ws + WS_W2, DFF, (r / nb) * 64, (r % nb) * 32, F8S_W2, scr, F.lane);
#else
            transpose_item(MapIdent{F.in[I_W2]}, D, (bf16_t*)(F.ws + WS_W2), DFF, (r / nb) * 64, (r % nb) * 32, scr, F.lane);
#endif
            continue; } r -= I4;
        if (r < I5) { const int nb = NIN_OA / 32; transpose_item(MapOddA{F.in[I_WINO]}, 7760, WINOA, D, (r / nb) * 64, (r % nb) * 32, scr, F.lane); continue; } r -= I5;
        if (r < I6) { const int nb = NIN_OB / 32; transpose_item(MapOddB{F.in[I_WINO]}, 7760, WINOB, D, (r / nb) * 64, (r % nb) * 32, scr, F.lane); continue; } r -= I6;
        { const int nb = D / 32; transpose_item(MapIdent{F.in[I_WOUTO]}, D, WOUTO, D, (r / nb) * 64, (r % nb) * 32, scr, F.lane); }
    }
    bf16_t* HA = (bf16_t*)(F.ws + WS_HA);
    const size_t gt = (size_t)F.bid * NTHREADS + F.tid, NGT = (size_t)F.G * NTHREADS;
    for (size_t e = gt; e < (size_t)M * (D / 8); e += NGT) {
        const int r = (int)(e / (D / 8)), c = (int)(e % (D / 8)) * 8, b = r / LP, pos = r % LP;
        u32x4 o = (u32x4){0u, 0u, 0u, 0u};
        if (pos < LR) { const float* src = pos < NMETA ? F.in[I_META] + (size_t)pos * D + c : F.in[I_X] + ((size_t)b * SEQ + (pos - NMETA)) * D + c;
            const f32x4 v0 = *(const f32x4*)src, v1 = *(const f32x4*)(src + 4);
            o.x = pk2(v0[0], v0[1]); o.y = pk2(v0[2], v0[3]); o.z = pk2(v1[0], v1[1]); o.w = pk2(v1[2], v1[3]); }
        *(u32x4*)(HA + (size_t)r * D + c) = o;
    }
    if (gt < 2048) {
        const int gp = (int)gt, g = gp >> 6;
        const double are = F.in[I_ARE][gp], aim = F.in[I_AIM][gp], dt = exp((double)F.in[I_LOGDT][g]);
        const double er = exp(dt * are), abr = er * cos(dt * aim), abi = er * sin(dt * aim);
        const double erp = exp(S5CH * dt * are), apr = erp * cos(S5CH * dt * aim), api = erp * sin(S5CH * dt * aim);
        const double nr = abr - 1.0, ni = abi, den = are * are + aim * aim;
        const double qr = (nr * are + ni * aim) / den, qi = (ni * are - nr * aim) / den;
        float* T = (float*)(F.ws + WS_S5T);
        T[gp * 2 + 0] = (float)abr; T[gp * 2 + 1] = (float)abi;
        T[4096 + gp * 2 + 0] = (float)apr; T[4096 + gp * 2 + 1] = (float)api;
        float* BB = T + 8192 + gp * 32;
        for (int c = 0; c < 16; ++c) { const double br = F.in[I_BRE][gp * 16 + c], bi = F.in[I_BIM][gp * 16 + c];
            BB[2 * c + 0] = (float)(qr * br - qi * bi); BB[2 * c + 1] = (float)(qr * bi + qi * br); }
        float* PW = T + 73728 + gp * 18;
        double pr = 1.0, pi = 0.0;
        for (int tau = 0; tau <= 8; ++tau) { PW[2 * tau] = (float)pr; PW[2 * tau + 1] = (float)pi; const double nr2 = pr * abr - pi * abi, ni2 = pr * abi + pi * abr; pr = nr2; pi = ni2; }
    }
}

template <class F> __device__ __forceinline__ void transpose_item32(const F& f, int ldw, bf16_t* dst, int Kd, int k0, int n0, LAS float* scr, int lane) {
    const SrcRef s = f(n0 + (lane & 31));
#pragma unroll 8
    for (int i = 0; i < 16; ++i) { const int kk = 2 * i + (lane >> 5); scr[kk * 33 + (lane & 31)] = s.p[(size_t)(k0 + kk) * ldw + s.col] * s.sc; }
    LDS_WAIT();
    const int c = lane & 3;
#pragma unroll
    for (int j = 0; j < 2; ++j) { const int n = (lane >> 2) + 16 * j; const LAS float* sp = scr + (8 * c) * 33 + n;
        u32x4 o; o.x = pk2(sp[0 * 33], sp[1 * 33]); o.y = pk2(sp[2 * 33], sp[3 * 33]); o.z = pk2(sp[4 * 33], sp[5 * 33]); o.w = pk2(sp[6 * 33], sp[7 * 33]);
        *(u32x4*)(dst + (size_t)(n0 + n) * Kd + k0 + 8 * c) = o; }
    LDS_WAIT();
}
template <class F> __device__ __forceinline__ void transpose_item32_f8(const F& f, int ldw, unsigned char* dst, int Kd, int k0, int n0, float scale, LAS float* scr, int lane) {
    const SrcRef s = f(n0 + (lane & 31));
#pragma unroll 8
    for (int i = 0; i < 16; ++i) { const int kk = 2 * i + (lane >> 5); scr[kk * 33 + (lane & 31)] = s.p[(size_t)(k0 + kk) * ldw + s.col] * (s.sc * scale); }
    LDS_WAIT();
    const int c = lane & 1, n = lane >> 1; const LAS float* sp = scr + (16 * c) * 33 + n;
    u32x4 o; o.x = pk4_f8(sp[0 * 33], sp[1 * 33], sp[2 * 33], sp[3 * 33]); o.y = pk4_f8(sp[4 * 33], sp[5 * 33], sp[6 * 33], sp[7 * 33]);
    o.z = pk4_f8(sp[8 * 33], sp[9 * 33], sp[10 * 33], sp[11 * 33]); o.w = pk4_f8(sp[12 * 33], sp[13 * 33], sp[14 * 33], sp[15 * 33]);
    *(u32x4*)(dst + (size_t)(n0 + n) * Kd + k0 + 16 * c) = o;
    LDS_WAIT();
}
__device__ __forceinline__ void convert_experts(Frame& F) {
    LAS float* scr = (LAS float*)(F.lds + 4 * D1_WAVE_BYTES + (F.wave - 4) * 4352);
    const int gw = F.bid * 4 + (F.wave - 4), NGW = F.G * 4;
    constexpr int J1 = (N13 / 32) * (D / 32), J2 = (D / 32) * (DFF / 32);
    for (int it = gw; it < NEXP * (J1 + J2); it += NGW) {
        const int e = it / (J1 + J2); int r = it % (J1 + J2);
        if (r < J1) { const int nb = N13 / 32; transpose_item32_f8(MapGated{F.in[I_EW1] + (size_t)e * D * DFF, F.in[I_EW3] + (size_t)e * D * DFF}, DFF, F.ws + WS_EW13 + (size_t)e * N13 * D, D, (r / nb) * 32, (r % nb) * 32, F8S_W13, scr, F.lane); }
        else { r -= J1; const int nb = D / 32; transpose_item32_f8(MapIdent{F.in[I_EW2] + (size_t)e * DFF * D}, D, F.ws + WS_EW2 + (size_t)e * D * DFF, DFF, (r / nb) * 32, (r % nb) * 32, F8S_W2, scr, F.lane); }
    }
}

__device__ __forceinline__ void cvt8(const u32x4 w, float (&f)[8]) { f[0] = bflo(w.x); f[1] = bfhi(w.x); f[2] = bflo(w.y); f[3] = bfhi(w.y); f[4] = bflo(w.z); f[5] = bfhi(w.z); f[6] = bflo(w.w); f[7] = bfhi(w.w); }
__device__ __forceinline__ void conv_phase(Frame& F, int wg0, int nwg) {
    const bf16_t* P = (const bf16_t*)(F.ws + WS_P); bf16_t* Y = (bf16_t*)(F.ws + WS_Y);
    const float* cw = F.in[I_CONVW];
    constexpr int STRIP = 16, NSTRIP = LP / STRIP, NCG = DCONV / 8;
    const int gt = (F.bid - wg0) * NTHREADS + F.tid, NGT = nwg * NTHREADS;
    for (int it = gt; it < NB * NSTRIP * NCG; it += NGT) {
        const int cg = it % NCG, sp = (it / NCG) % NSTRIP, b = it / (NCG * NSTRIP), c = cg * 8, p0 = sp * STRIP;
        float w0[8], w1[8], w2[8];
#pragma unroll
        for (int j = 0; j < 8; ++j) { w0[j] = cw[c + j]; w1[j] = cw[DCONV + c + j]; w2[j] = cw[2 * DCONV + c + j]; }
        float z1[8], z2[8];
#pragma unroll
        for (int j = 0; j < 8; ++j) { z1[j] = 0.f; z2[j] = 0.f; }
        for (int d = 2; d >= 1; --d) { const int pos = p0 - d; if (pos >= 0) { const bf16_t* row = P + (size_t)(b * LP + pos) * NIN_E;
                float cgv[8], xv[8]; cvt8(*(const u32x4*)(row + DCONV + c), cgv); cvt8(*(const u32x4*)(row + 2 * DCONV + c), xv);
#pragma unroll
                for (int j = 0; j < 8; ++j) { if (d == 2) z2[j] = cgv[j] * xv[j]; else z1[j] = cgv[j] * xv[j]; } } }
        for (int s4 = 0; s4 < STRIP; s4 += 4) {
            u32x4 rb[4], rc[4], rx[4];
#pragma unroll
            for (int q = 0; q < 4; ++q) { const bf16_t* row = P + (size_t)(b * LP + p0 + s4 + q) * NIN_E; rb[q] = *(const u32x4*)(row + c); rc[q] = *(const u32x4*)(row + DCONV + c); rx[q] = *(const u32x4*)(row + 2 * DCONV + c); }
#pragma unroll
            for (int q = 0; q < 4; ++q) { const int pos = p0 + s4 + q;
                float bg[8], cgv[8], xv[8]; cvt8(rb[q], bg); cvt8(rc[q], cgv); cvt8(rx[q], xv);
                float o[8];
#pragma unroll
                for (int j = 0; j < 8; ++j) { const float z0 = cgv[j] * xv[j]; o[j] = bg[j] * (w0[j] * z2[j] + w1[j] * z1[j] + w2[j] * z0); z2[j] = z1[j]; z1[j] = z0; }
                u32x4 w; w.x = pk2(o[0], o[1]); w.y = pk2(o[2], o[3]); w.z = pk2(o[4], o[5]); w.w = pk2(o[6], o[7]);
                *(u32x4*)(Y + (size_t)(b * LP + pos) * D + c) = w; } }
    }
}
constexpr size_t WS_MS5 = WS_XE;
__device__ __forceinline__ void s5_build_matrices(Frame& F) {
    const float* T = (const float*)(F.ws + WS_S5T); bf16_t* MS = (bf16_t*)(F.ws + WS_MS5);
    const int gt = F.bid * NTHREADS + F.tid, NGT = F.G * NTHREADS;
    for (int e = gt; e < 32 * 3 * 16384; e += NGT) {
        const int k = e & 127, r = (e >> 7) & 127, m = (e >> 14) % 3, g = e / (3 * 16384);
        const float* PW = T + 73728 + (size_t)g * 64 * 18; const float* BB = T + 8192 + (size_t)g * 64 * 32;
        float v = 0.f;
        if (m == 0) { const int t = r >> 4, c = r & 15, s = k >> 4, c2 = k & 15;
            if (s <= t) { const int tau = t - s; const float* cre = F.in[I_CRE] + ((size_t)g * 16 + c) * 64; const float* cim = F.in[I_CIM] + ((size_t)g * 16 + c) * 64;
                for (int p = 0; p < 64; ++p) { const float ar = PW[p * 18 + 2 * tau], ai = PW[p * 18 + 2 * tau + 1], br = BB[p * 32 + 2 * c2], bi = BB[p * 32 + 2 * c2 + 1];
                    const float abr_ = ar * br - ai * bi, abi_ = ar * bi + ai * br; v += cre[p] * abr_ - cim[p] * abi_; }
                if (tau == 0 && c == c2) v += F.in[I_S5D][g * 16 + c]; } }
        else if (m == 1) { const int p = r >> 1, ri = r & 1, s = k >> 4, c2 = k & 15; const int tau = 7 - s;
            const float ar = PW[p * 18 + 2 * tau], ai = PW[p * 18 + 2 * tau + 1], br = BB[p * 32 + 2 * c2], bi = BB[p * 32 + 2 * c2 + 1];
            v = ri ? (ar * bi + ai * br) : (ar * br - ai * bi); }
        else { const int t = r >> 4, c = r & 15, p = k >> 1, ri = k & 1; const int tau = t + 1;
            const float ar = PW[p * 18 + 2 * tau], ai = PW[p * 18 + 2 * tau + 1], cr = F.in[I_CRE][((size_t)g * 16 + c) * 64 + p], ci = F.in[I_CIM][((size_t)g * 16 + c) * 64 + p];
            v = ri ? -(cr * ai + ci * ar) : (cr * ar - ci * ai); }
        MS[e] = (bf16_t)f2bf(v);
    }
}
template <int CTRL> __device__ __forceinline__ float dpp_row_f(float old, float src) { return __int_as_float(__builtin_amdgcn_update_dpp(__float_as_int(old), __float_as_int(src), CTRL, 0xf, 0xf, false)); }
constexpr int S5X_ROW = 272, S5X_BUF = 16 * S5X_ROW;
template <bool SPLIT>
__device__ __forceinline__ void s5_ssd_unit(Frame& F, int b, int g, int half) {
    const bf16_t* P = (const bf16_t*)(F.ws + WS_P); bf16_t* Y = (bf16_t*)(F.ws + WS_Y);
    const float* T = (const float*)(F.ws + WS_S5T); const bf16_t* MS = (const bf16_t*)(F.ws + WS_MS5) + (size_t)g * 3 * 16384;
    const int lane = F.lane, w = F.wave, ql = lane & 15, gq = lane >> 4;
    bf16x8 A1[4], A2[4], A3[4];
#pragma unroll
    for (int ks = 0; ks < 4; ++ks) { const int off = (16 * w + ql) * 128 + 32 * ks + 8 * gq;
        A1[ks] = *(const bf16x8*)(MS + off); A2[ks] = *(const bf16x8*)(MS + 16384 + off); A3[ks] = *(const bf16x8*)(MS + 32768 + off); }
    float m1r[2], m1i[2], m2r[2], m2i[2], m4r[2], m4i[2], m8r[2], m8i[2];
#pragma unroll
    for (int j = 0; j < 2; ++j) { const float* PW = T + 73728 + ((size_t)g * 64 + 8 * w + 2 * gq + j) * 18 + 16;
        m1r[j] = PW[0]; m1i[j] = PW[1]; m2r[j] = m1r[j] * m1r[j] - m1i[j] * m1i[j]; m2i[j] = 2.f * m1r[j] * m1i[j];
        m4r[j] = m2r[j] * m2r[j] - m2i[j] * m2i[j]; m4i[j] = 2.f * m2r[j] * m2i[j]; m8r[j] = m4r[j] * m4r[j] - m4i[j] * m4i[j]; m8i[j] = 2.f * m4r[j] * m4i[j]; }
    bf16x8 Awg; { const float* wg = F.in[I_WGLU] + (size_t)g * 256 + ql * 16 + 4 * gq; u32x4 t_; t_.x = pk2(wg[0], wg[1]); t_.y = pk2(wg[2], wg[3]); t_.z = 0u; t_.w = 0u; Awg = __builtin_bit_cast(bf16x8, t_); }
    float cr[2] = {0.f, 0.f}, ci[2] = {0.f, 0.f};
    const size_t rowb = (size_t)b * LP;
    const bf16_t* ubase = P + (rowb + 8 * ql + (gq >> 1)) * NIN_E + 3 * DCONV + g * 16 + 8 * (gq & 1);
    bf16x8 Bu[4], Bn[4];
    constexpr int NCH = LP / 128, CSPLIT = 65;
    if (half) {
#pragma unroll
        for (int ks = 0; ks < 4; ++ks) Bu[ks] = *(const bf16x8*)(ubase + (size_t)(2 * ks) * NIN_E);
        for (int ch = 0; ch < CSPLIT; ++ch) {
            if (ch + 1 < CSPLIT) {
#pragma unroll
                for (int ks = 0; ks < 4; ++ks) Bn[ks] = *(const bf16x8*)(ubase + ((size_t)(ch + 1) * 128 + 2 * ks) * NIN_E); }
            f32x4 IN = (f32x4){0.f, 0.f, 0.f, 0.f};
#pragma unroll
            for (int ks = 0; ks < 4; ++ks) IN = __builtin_amdgcn_mfma_f32_16x16x32_bf16(A2[ks], Bu[ks], IN, 0, 0, 0);
            float er[2] = {IN[0], IN[2]}, ei[2] = {IN[1], IN[3]};
#pragma unroll
            for (int j = 0; j < 2; ++j) {
                if (ql == 0) { er[j] += m1r[j] * cr[j] - m1i[j] * ci[j]; ei[j] += m1r[j] * ci[j] + m1i[j] * cr[j]; }
                { const float tr = dpp_row_f<0x111>(0.f, er[j]), ti = dpp_row_f<0x111>(0.f, ei[j]); er[j] += m1r[j] * tr - m1i[j] * ti; ei[j] += m1r[j] * ti + m1i[j] * tr; }
                { const float tr = dpp_row_f<0x112>(0.f, er[j]), ti = dpp_row_f<0x112>(0.f, ei[j]); er[j] += m2r[j] * tr - m2i[j] * ti; ei[j] += m2r[j] * ti + m2i[j] * tr; }
                { const float tr = dpp_row_f<0x114>(0.f, er[j]), ti = dpp_row_f<0x114>(0.f, ei[j]); er[j] += m4r[j] * tr - m4i[j] * ti; ei[j] += m4r[j] * ti + m4i[j] * tr; }
                { const float tr = dpp_row_f<0x118>(0.f, er[j]), ti = dpp_row_f<0x118>(0.f, ei[j]); er[j] += m8r[j] * tr - m8i[j] * ti; ei[j] += m8r[j] * ti + m8i[j] * tr; }
                cr[j] = __shfl(er[j], (lane & 48) | 15); ci[j] = __shfl(ei[j], (lane & 48) | 15);
            }
#pragma unroll
            for (int ks = 0; ks < 4; ++ks) Bu[ks] = Bn[ks];
        }
    }
    const int ch0 = half ? CSPLIT : 0, ch1 = (half || !SPLIT) ? NCH : CSPLIT;
#pragma unroll
    for (int ks = 0; ks < 4; ++ks) Bu[ks] = *(const bf16x8*)(ubase + ((size_t)ch0 * 128 + 2 * ks) * NIN_E);
    for (int ch = ch0; ch < ch1; ++ch) {
        if (ch + 1 < ch1) {
#pragma unroll
            for (int ks = 0; ks < 4; ++ks) Bn[ks] = *(const bf16x8*)(ubase + ((size_t)(ch + 1) * 128 + 2 * ks) * NIN_E); }
        f32x4 IN = (f32x4){0.f, 0.f, 0.f, 0.f};
#pragma unroll
        for (int ks = 0; ks < 4; ++ks) IN = __builtin_amdgcn_mfma_f32_16x16x32_bf16(A2[ks], Bu[ks], IN, 0, 0, 0);
        float er[2] = {IN[0], IN[2]}, ei[2] = {IN[1], IN[3]}, xr[2], xi[2];
#pragma unroll
        for (int j = 0; j < 2; ++j) {
            if (ql == 0) { er[j] += m1r[j] * cr[j] - m1i[j] * ci[j]; ei[j] += m1r[j] * ci[j] + m1i[j] * cr[j]; }
            { const float tr = dpp_row_f<0x111>(0.f, er[j]), ti = dpp_row_f<0x111>(0.f, ei[j]); er[j] += m1r[j] * tr - m1i[j] * ti; ei[j] += m1r[j] * ti + m1i[j] * tr; }
            { const float tr = dpp_row_f<0x112>(0.f, er[j]), ti = dpp_row_f<0x112>(0.f, ei[j]); er[j] += m2r[j] * tr - m2i[j] * ti; ei[j] += m2r[j] * ti + m2i[j] * tr; }
            { const float tr = dpp_row_f<0x114>(0.f, er[j]), ti = dpp_row_f<0x114>(0.f, ei[j]); er[j] += m4r[j] * tr - m4i[j] * ti; ei[j] += m4r[j] * ti + m4i[j] * tr; }
            { const float tr = dpp_row_f<0x118>(0.f, er[j]), ti = dpp_row_f<0x118>(0.f, ei[j]); er[j] += m8r[j] * tr - m8i[j] * ti; ei[j] += m8r[j] * ti + m8i[j] * tr; }
            xr[j] = dpp_row_f<0x111>(cr[j], er[j]); xi[j] = dpp_row_f<0x111>(ci[j], ei[j]);
            cr[j] = __shfl(er[j], (lane & 48) | 15); ci[j] = __shfl(ei[j], (lane & 48) | 15);
        }
        LAS unsigned char* xb = F.lds + (ch & 1) * S5X_BUF;
        *(LAS u32x2*)(xb + ql * S5X_ROW + (16 * w + 4 * gq) * 2) = (u32x2){pk2(xr[0], xi[0]), pk2(xr[1], xi[1])};
        RAW_BAR();
        f32x4 Yt = (f32x4){0.f, 0.f, 0.f, 0.f};
#pragma unroll
        for (int ks = 0; ks < 4; ++ks) Yt = __builtin_amdgcn_mfma_f32_16x16x32_bf16(A1[ks], Bu[ks], Yt, 0, 0, 0);
#pragma unroll
        for (int ks = 0; ks < 4; ++ks) { const bf16x8 Bx = *(const LAS bf16x8*)(xb + ql * S5X_ROW + (32 * ks + 8 * gq) * 2); Yt = __builtin_amdgcn_mfma_f32_16x16x32_bf16(A3[ks], Bx, Yt, 0, 0, 0); }
        float y[4];
#pragma unroll
        for (int i = 0; i < 4; ++i) { const float v = Yt[i]; y[i] = v * fast_sigmoid(1.5957691216f * (v + 0.044715f * v * v * v)); }
        u32x4 by; by.x = pk2(y[0], y[1]); by.y = pk2(y[2], y[3]); by.z = 0u; by.w = 0u;
        const f32x4 Z = __builtin_amdgcn_mfma_f32_16x16x32_bf16(Awg, __builtin_bit_cast(bf16x8, by), (f32x4){0.f, 0.f, 0.f, 0.f}, 0, 0, 0);
        u32x2 o; o.x = pk2(y[0] * fast_sigmoid(Z[0]), y[1] * fast_sigmoid(Z[1])); o.y = pk2(y[2] * fast_sigmoid(Z[2]), y[3] * fast_sigmoid(Z[3]));
        *(u32x2*)(Y + (rowb + (size_t)ch * 128 + 8 * ql + w) * D + DCONV + g * 16 + 4 * gq) = o;
#pragma unroll
        for (int ks = 0; ks < 4; ++ks) Bu[ks] = Bn[ks];
    }
}

template <bool ROUTER, int QOUT = (ROUTER ? 1 : 0)>
__device__ __forceinline__ void ln_phase(Frame& F, const bf16_t* PRE, bf16_t* H, const float* gam, const float* bet, unsigned char* H8 = nullptr) {
    const int gw = F.bid * NWAVES + F.wave, NGW = F.G * NWAVES;
    LAS unsigned* lcnt = (LAS unsigned*)(F.lds + LDS_MISC + 64);
    if (ROUTER) { if (F.tid < 16) lcnt[F.tid] = 0u; __syncthreads(); }
    f32x4 gv[8], bv[8];
#pragma unroll
    for (int j = 0; j < 8; ++j) { gv[j] = *(const f32x4*)(gam + 4 * F.lane + 256 * j); bv[j] = *(const f32x4*)(bet + 4 * F.lane + 256 * j); }
    for (int r = gw; r < M; r += NGW) {
        if (ROUTER && !(r % LP >= NMETA && r % LP < LR)) continue;
        const u32x2* xr = (const u32x2*)(PRE + (size_t)r * D) + F.lane;
        f32x4 v[8]; float s = 0.f;
#pragma unroll
        for (int j = 0; j < 8; ++j) { const u32x2 x = xr[64 * j]; v[j] = (f32x4){bflo(x.x), bfhi(x.x), bflo(x.y), bfhi(x.y)}; s += (v[j][0] + v[j][1]) + (v[j][2] + v[j][3]); }
        const float mean = wave_sum(s) * (1.f / D); float s2 = 0.f;
#pragma unroll
        for (int j = 0; j < 8; ++j) { v[j] = v[j] - mean; s2 += (v[j][0] * v[j][0] + v[j][1] * v[j][1]) + (v[j][2] * v[j][2] + v[j][3] * v[j][3]); }
        const float rstd = 1.f / sqrtf(wave_sum(s2) * (1.f / D) + LN_EPS);
        u32x2* o8 = (u32x2*)(H + (size_t)r * D) + F.lane;
#pragma unroll
        for (int j = 0; j < 8; ++j) { v[j] = v[j] * rstd * gv[j] + bv[j]; u32x2 w; w.x = pk2(v[j][0], v[j][1]); w.y = pk2(v[j][2], v[j][3]); o8[64 * j] = w; }
        if (QOUT) { unsigned* o4 = (unsigned*)(H8 + (size_t)r * D) + F.lane;
#pragma unroll
            for (int j = 0; j < 8; ++j) o4[64 * j] = (QOUT == 2) ? pk4_i8(v[j][0] * I8S_H, v[j][1] * I8S_H, v[j][2] * I8S_H, v[j][3] * I8S_H) : pk4_f8(v[j][0] * F8S_H3, v[j][1] * F8S_H3, v[j][2] * F8S_H3, v[j][3] * F8S_H3); }
        if (ROUTER) {
            {
                const float* rw = F.in[I_RW];
                float lg[8];
#pragma unroll
                for (int e = 0; e < 8; ++e) lg[e] = 0.f;
#pragma unroll
                for (int j = 0; j < 8; ++j)
#pragma unroll
                    for (int q = 0; q < 4; ++q) { const int c = 4 * F.lane + 256 * j + q; const f32x4 w0 = *(const f32x4*)(rw + (size_t)c * 8), w1 = *(const f32x4*)(rw + (size_t)c * 8 + 4); const float x = v[j][q];
                        lg[0] += x * w0[0]; lg[1] += x * w0[1]; lg[2] += x * w0[2]; lg[3] += x * w0[3]; lg[4] += x * w1[0]; lg[5] += x * w1[1]; lg[6] += x * w1[2]; lg[7] += x * w1[3]; }
#pragma unroll
                for (int e = 0; e < 8; ++e) lg[e] = wave_sum(lg[e]) + F.in[I_RB][e];
                int e0 = 0; float v0 = lg[0];
#pragma unroll
                for (int e = 1; e < 8; ++e) if (lg[e] > v0) { v0 = lg[e]; e0 = e; }
                int e1 = -1; float v1 = -3.0e38f;
#pragma unroll
                for (int e = 0; e < 8; ++e) if (e != e0 && lg[e] > v1) { v1 = lg[e]; e1 = e; }
                const float p1 = __expf(v1 - v0), g0 = 1.f / (1.f + p1), g1 = p1 * g0;
                if (F.lane == 0) {
                    int* TE = (int*)(F.ws + WS_MOE + MO_TOKE); float* TG = (float*)(F.ws + WS_MOE + MO_TOKG); int* TP = (int*)(F.ws + WS_MOE + MO_TOKPOS);
                    const unsigned q0 = __hip_atomic_fetch_add(lcnt + e0, 1u, __ATOMIC_RELAXED, __HIP_MEMORY_SCOPE_WORKGROUP);
                    const unsigned q1 = __hip_atomic_fetch_add(lcnt + e1, 1u, __ATOMIC_RELAXED, __HIP_MEMORY_SCOPE_WORKGROUP);
                    TE[2 * r] = e0; TE[2 * r + 1] = e1; TG[2 * r] = g0; TG[2 * r + 1] = g1; TP[2 * r] = (int)q0; TP[2 * r + 1] = (int)q1;
                }
            }
        }
    }
    if (ROUTER) {
        __syncthreads();
        if (F.tid < 8) lcnt[8 + F.tid] = __hip_atomic_fetch_add(F.ctl + CW_CNT + 64 * F.tid, lcnt[F.tid], __ATOMIC_RELAXED, __HIP_MEMORY_SCOPE_AGENT);
        __syncthreads();
        const int* TE = (const int*)(F.ws + WS_MOE + MO_TOKE); int* TP = (int*)(F.ws + WS_MOE + MO_TOKPOS);
        for (int r = gw; r < M; r += NGW) if (r % LP >= NMETA && r % LP < LR && F.lane < 2) TP[2 * r + F.lane] += (int)lcnt[8 + TE[2 * r + F.lane]];
    }
}
__device__ __forceinline__ void route_phase(Frame& F) {
    int cnt[8], ps[8]; int tot = 0;
#pragma unroll
    for (int e = 0; e < 8; ++e) { cnt[e] = (int)__hip_atomic_load(F.ctl + CW_CNT + 64 * e, __ATOMIC_RELAXED, __HIP_MEMORY_SCOPE_AGENT); ps[e] = tot; tot += (cnt[e] + 255) / 256 * 256; }
    const int* TE = (const int*)(F.ws + WS_MOE + MO_TOKE); const int* TP = (const int*)(F.ws + WS_MOE + MO_TOKPOS);
    int* TS = (int*)(F.ws + WS_MOE + MO_TOKSLOT); int* ST = (int*)(F.ws + WS_MOE + MO_SLOTTOK); int* TL = (int*)(F.ws + WS_MOE + MO_TILEE);
    const int gt = F.bid * NTHREADS + F.tid, NGT = F.G * NTHREADS;
    for (int a = gt; a < 2 * M; a += NGT) { const int r = a >> 1; if (r % LP >= NMETA && r % LP < LR) { const int e = TE[a]; int base = 0;
#pragma unroll
            for (int j = 0; j < 8; ++j) base = (j == e) ? ps[j] : base;
            const int slot = base + TP[a]; TS[a] = slot; ST[slot] = r; } }
    for (int s = gt; s < tot; s += NGT) { int e = 0;
#pragma unroll
        for (int j = 1; j < 8; ++j) e = (s >= ps[j]) ? j : e;
        int pe = 0, ce = 0;
#pragma unroll
        for (int j = 0; j < 8; ++j) { pe = (j == e) ? ps[j] : pe; ce = (j == e) ? cnt[j] : ce; }
        if (s - pe >= ce) ST[s] = NMETA;
        if ((s & 255) == 0) TL[s >> 8] = e; }
    if (gt == 0) TL[300] = tot >> 8;
}
__device__ __forceinline__ void final_phase(Frame& F) {
    const bf16_t* H = (const bf16_t*)(F.ws + WS_H3); const bf16_t* YB = (const bf16_t*)(F.ws + WS_YB);
    const int* TS = (const int*)(F.ws + WS_MOE + MO_TOKSLOT); const float* TG = (const float*)(F.ws + WS_MOE + MO_TOKG);
    const float* gam = F.in[I_LN4G]; const float* bet = F.in[I_LN4B];
    const int gw = F.bid * NWAVES + F.wave, NGW = F.G * NWAVES;
    f32x4 gv[8], bv[8];
#pragma unroll
    for (int j = 0; j < 8; ++j) { gv[j] = *(const f32x4*)(gam + 4 * F.lane + 256 * j); bv[j] = *(const f32x4*)(bet + 4 * F.lane + 256 * j); }
    for (int o = gw; o < NB * SEQ; o += NGW) {
        const int b = o / SEQ, s = o % SEQ, r = b * LP + NMETA + s;
        const int s0 = TS[2 * r], s1 = TS[2 * r + 1]; const float g0 = TG[2 * r], g1 = TG[2 * r + 1];
        const u32x2* hr = (const u32x2*)(H + (size_t)r * D) + F.lane; const u32x2* y0 = (const u32x2*)(YB + (size_t)s0 * D) + F.lane; const u32x2* y1 = (const u32x2*)(YB + (size_t)s1 * D) + F.lane;
        f32x4 v[8]; float sm = 0.f;
#pragma unroll
        for (int j = 0; j < 8; ++j) { const u32x2 hw = hr[64 * j], a = y0[64 * j], c = y1[64 * j];
            v[j][0] = ALPHA * bflo(hw.x) + g0 * bflo(a.x) + g1 * bflo(c.x); v[j][1] = ALPHA * bfhi(hw.x) + g0 * bfhi(a.x) + g1 * bfhi(c.x);
            v[j][2] = ALPHA * bflo(hw.y) + g0 * bflo(a.y) + g1 * bflo(c.y); v[j][3] = ALPHA * bfhi(hw.y) + g0 * bfhi(a.y) + g1 * bfhi(c.y);
            sm += (v[j][0] + v[j][1]) + (v[j][2] + v[j][3]); }
        const float mean = wave_sum(sm) * (1.f / D); float s2 = 0.f;
#pragma unroll
        for (int j = 0; j < 8; ++j) { v[j] = v[j] - mean; s2 += (v[j][0] * v[j][0] + v[j][1] * v[j][1]) + (v[j][2] * v[j][2] + v[j][3] * v[j][3]); }
        const float rstd = 1.f / sqrtf(wave_sum(s2) * (1.f / D) + LN_EPS);
        f32x4* op = (f32x4*)(F.out + (size_t)o * D) + F.lane;
#pragma unroll
        for (int j = 0; j < 8; ++j) op[64 * j] = v[j] * rstd * gv[j] + bv[j];
    }
}
__device__ __forceinline__ int dsa_kend(int q) { return q < NMETA ? NMETA : NMETA + 64 * (1 + (q - NMETA) / 64); }
constexpr int D1_CAP = 512, D1_BUF = 0, D1_HIST = 16 * D1_CAP * 4, D1_BMP = D1_HIST + 1024, D1_CNT = D1_BMP + BMP_PITCH * 4, D1_WAVE = D1_CNT + 64; static_assert(D1_WAVE == D1_WAVE_BYTES && 4 * D1_WAVE + 4 * 4352 <= LDS_MISC, "top-k LDS map");
__device__ __forceinline__ unsigned d1_mono(float f) { const unsigned u = __float_as_uint(f); return (u & 0x80000000u) ? ~u : (u | 0x80000000u); }
template <int CTRL, int ROWMASK> __device__ __forceinline__ int dpp_int(int old, int src) { return __builtin_amdgcn_update_dpp(old, src, CTRL, ROWMASK, 0xf, false); }
__device__ __forceinline__ int wave_scan_add_i(int v) {
    v += dpp_int<0x111, 0xf>(0, v); v += dpp_int<0x112, 0xf>(0, v); v += dpp_int<0x114, 0xf>(0, v); v += dpp_int<0x118, 0xf>(0, v);
    v += dpp_int<0x142, 0xa>(0, v); v += dpp_int<0x143, 0xc>(0, v); return v;
}
__device__ __forceinline__ unsigned d1_refresh(LAS unsigned* buf, LAS unsigned* hist, LAS unsigned* cnt, int qq, int lane) {
    const int n = (int)cnt[qq];
    LAS unsigned* bq = buf + qq * D1_CAP;
    unsigned e[8];
#pragma unroll
    for (int i = 0; i < 8; ++i) e[i] = (lane + 64 * i < n) ? bq[lane + 64 * i] : 0u;
    unsigned prefix = 0u; int need = 256;
#pragma unroll 1
    for (int r = 3; r >= 0; --r) {
        const int shift = 8 * r;
        bool m[8]; unsigned dg[8]; unsigned any_d = 0u; bool uni = true;
#pragma unroll
        for (int i = 0; i < 8; ++i) { m[i] = (e[i] != 0u) && (r == 3 || (e[i] >> (shift + 8)) == (prefix >> (shift + 8))); dg[i] = (e[i] >> shift) & 255u; }
        { unsigned long long bm = 0ull; unsigned first = 0u;
#pragma unroll
          for (int i = 0; i < 8; ++i) { const unsigned long long b_ = __ballot(m[i]); if (bm == 0ull && b_ != 0ull) first = (unsigned)__builtin_amdgcn_readlane((int)dg[i], (int)__builtin_ctzll(b_)); bm |= b_; }
          any_d = first;
#pragma unroll
          for (int i = 0; i < 8; ++i) uni = uni && !__any(m[i] && dg[i] != first); }
        if (uni) { prefix |= any_d << shift; continue; }
        *(LAS u32x4*)(hist + 4 * lane) = (u32x4){0u, 0u, 0u, 0u};
        LDS_WAIT();
#pragma unroll
        for (int i = 0; i < 8; ++i) if (m[i]) __hip_atomic_fetch_add(hist + (255u - dg[i]), 1u, __ATOMIC_RELAXED, __HIP_MEMORY_SCOPE_WORKGROUP);
        LDS_WAIT();
        const u32x4 h4 = *(const LAS u32x4*)(hist + 4 * lane);
        const int s = (int)(h4.x + h4.y + h4.z + h4.w);
        const int S = wave_scan_add_i(s);
        const int above = S - s;
        const bool found = (above < need) && (need <= S);
        int digit = 0, nneed = 0;
        if (found) { int a = above;
            if (a + (int)h4.x >= need) { digit = 255 - 4 * lane; nneed = need - a; }
            else { a += (int)h4.x;
                if (a + (int)h4.y >= need) { digit = 254 - 4 * lane; nneed = need - a; }
                else { a += (int)h4.y;
                    if (a + (int)h4.z >= need) { digit = 253 - 4 * lane; nneed = need - a; }
                    else { a += (int)h4.z; digit = 252 - 4 * lane; nneed = need - a; } } } }
        const unsigned long long fm = __ballot(found);
        const int src = fm ? (int)__builtin_ctzll(fm) : 0;
        digit = __builtin_amdgcn_readlane(digit, src); nneed = __builtin_amdgcn_readlane(nneed, src);
        prefix |= (unsigned)digit << shift; need = nneed;
    }
    const unsigned T = prefix;
    int base = 0;
#pragma unroll
    for (int i = 0; i < 8; ++i) { const bool keep = e[i] >= T && e[i] != 0u; const unsigned long long mk = __ballot(keep);
        const int pos = base + (int)__builtin_popcountll(mk & ((1ull << lane) - 1ull));
        if (keep) bq[pos] = e[i];
        base += (int)__builtin_popcountll(mk); }
    if (lane == 0) cnt[qq] = (unsigned)base;
    LDS_WAIT();
    return T;
}
__device__ __forceinline__ unsigned wave_min_u(unsigned v) {
    const int ni = -1;
    v = min(v, (unsigned)dpp_int<0x111, 0xf>(ni, (int)v)); v = min(v, (unsigned)dpp_int<0x112, 0xf>(ni, (int)v)); v = min(v, (unsigned)dpp_int<0x114, 0xf>(ni, (int)v)); v = min(v, (unsigned)dpp_int<0x118, 0xf>(ni, (int)v));
    v = min(v, (unsigned)dpp_int<0x142, 0xa>(ni, (int)v)); v = min(v, (unsigned)dpp_int<0x143, 0xc>(ni, (int)v));
    return (unsigned)__builtin_amdgcn_readlane((int)v, 63);
}
__device__ __forceinline__ unsigned wave_max_u(unsigned v) {
    v = max(v, (unsigned)dpp_int<0x111, 0xf>(0, (int)v)); v = max(v, (unsigned)dpp_int<0x112, 0xf>(0, (int)v)); v = max(v, (unsigned)dpp_int<0x114, 0xf>(0, (int)v)); v = max(v, (unsigned)dpp_int<0x118, 0xf>(0, (int)v));
    v = max(v, (unsigned)dpp_int<0x142, 0xa>(0, (int)v)); v = max(v, (unsigned)dpp_int<0x143, 0xc>(0, (int)v));
    return (unsigned)__builtin_amdgcn_readlane((int)v, 63);
}
template <bool EXACT>
__device__ __forceinline__ unsigned d1_select(LAS unsigned* buf, LAS unsigned* hist, LAS unsigned* cnt, int qq, int lane) {
    const int n = (int)cnt[qq];
    LAS unsigned* bq = buf + qq * D1_CAP;
    unsigned e[8];
#pragma unroll
    for (int i = 0; i < 8; ++i) e[i] = (lane + 64 * i < n) ? bq[lane + 64 * i] : 0u;
    unsigned lmin = 0xFFFFFFFFu, lmax = 0u;
#pragma unroll
    for (int i = 0; i < 8; ++i) { const unsigned k = e[i] >> 17; lmin = (e[i] != 0u) ? min(lmin, k) : lmin; lmax = (e[i] != 0u) ? max(lmax, k) : lmax; }
    const unsigned kmin = wave_min_u(lmin), kmax = wave_max_u(lmax);
    const float inv = 256.0f / (float)(kmax - kmin + 1u);
    int bin[8];
#pragma unroll
    for (int i = 0; i < 8; ++i) { const int b_ = (int)((float)((e[i] >> 17) - kmin) * inv); bin[i] = b_ > 255 ? 255 : b_; }
    *(LAS u32x4*)(hist + 4 * lane) = (u32x4){0u, 0u, 0u, 0u};
    LDS_WAIT();
#pragma unroll
    for (int i = 0; i < 8; ++i) if (e[i] != 0u) __hip_atomic_fetch_add(hist + (255 - bin[i]), 1u, __ATOMIC_RELAXED, __HIP_MEMORY_SCOPE_WORKGROUP);
    LDS_WAIT();
    const u32x4 h4 = *(const LAS u32x4*)(hist + 4 * lane);
    const int s_ = (int)(h4.x + h4.y + h4.z + h4.w);
    const int S = wave_scan_add_i(s_);
    const int above_l = S - s_;
    const bool found = (above_l < 256) && (256 <= S);
    int bstar = 0, above = 0, cb = 0;
    if (found) { int a = above_l;
        if (a + (int)h4.x >= 256) { bstar = 255 - 4 * lane; above = a; cb = (int)h4.x; }
        else { a += (int)h4.x;
            if (a + (int)h4.y >= 256) { bstar = 254 - 4 * lane; above = a; cb = (int)h4.y; }
            else { a += (int)h4.y;
                if (a + (int)h4.z >= 256) { bstar = 253 - 4 * lane; above = a; cb = (int)h4.z; }
                else { a += (int)h4.z; bstar = 252 - 4 * lane; above = a; cb = (int)h4.w; } } } }
    const unsigned long long fm = __ballot(found);
    const int src = fm ? (int)__builtin_ctzll(fm) : 0;
    bstar = __builtin_amdgcn_readlane(bstar, src); above = __builtin_amdgcn_readlane(above, src); cb = __builtin_amdgcn_readlane(cb, src);
    unsigned T;
    if (!EXACT) {
        if (above + cb > D1_CAP - 128) return d1_refresh(buf, hist, cnt, qq, lane);
        unsigned lk = 0xFFFFFFFFu;
#pragma unroll
        for (int i = 0; i < 8; ++i) lk = (e[i] != 0u && bin[i] >= bstar) ? min(lk, e[i]) : lk;
        T = wave_min_u(lk);
    } else {
        if (cb > 48) return d1_refresh(buf, hist, cnt, qq, lane);
        unsigned cur = 0xFFFFFFFFu;
        for (int it = above; it < 256; ++it) {
            unsigned lm = 0u;
#pragma unroll
            for (int i = 0; i < 8; ++i) lm = (bin[i] == bstar && e[i] < cur) ? max(lm, e[i]) : lm;
            cur = wave_max_u(lm);
        }
        T = cur;
    }
    int base = 0;
#pragma unroll
    for (int i = 0; i < 8; ++i) { const bool keep = e[i] >= T && e[i] != 0u; const unsigned long long mk = __ballot(keep);
        const int pos = base + (int)__builtin_popcountll(mk & ((1ull << lane) - 1ull));
        if (keep) bq[pos] = e[i];
        base += (int)__builtin_popcountll(mk); }
    if (lane == 0) cnt[qq] = (unsigned)base;
    LDS_WAIT();
    return EXACT ? T : T - 1u;
}
#ifndef PROBE_D1
#define PROBE_D1 0
#endif
__device__ __forceinline__ void d1_append(LAS unsigned* buf, LAS unsigned* hist, LAS unsigned* cnt, const unsigned (&pk)[8], const int c, unsigned& thr, const int ql, const int lane, const int rep) {
    if (__any(c > 0) && !(rep && (PROBE_D1 & 1))) {
        unsigned pos = 0u;
        if (c > 0) pos = __hip_atomic_fetch_add(cnt + ql, (unsigned)c, __ATOMIC_RELAXED, __HIP_MEMORY_SCOPE_WORKGROUP);
        unsigned wp = ql * D1_CAP + pos;
#pragma unroll
        for (int i = 0; i < 8; ++i) if (pk[i] > thr) { buf[wp] = pk[i]; ++wp; }
        const bool full = (c > 0) && (pos + (unsigned)c > (unsigned)(D1_CAP - 32));
        unsigned long long fm = __ballot(full); fm = (fm | (fm >> 16) | (fm >> 32) | (fm >> 48)) & 0xFFFFull;
        if (fm) { LDS_WAIT();
            while (fm) { const int qq = (int)__builtin_ctzll(fm); fm &= fm - 1ull;
                if (rep && (PROBE_D1 & 2)) { if (lane == 0) cnt[qq] = 256u; LDS_WAIT(); continue; }
                const unsigned T = d1_select<false>(buf, hist, cnt, qq, lane);
                if (ql == qq) thr = T; } }
    }
}
__device__ __forceinline__ void d1_unit(Frame& F, LAS unsigned char* wl, int b, int qg, int rep) {
    const bf16_t* PA = (const bf16_t*)(F.ws + WS_P); unsigned* BMP = (unsigned*)(F.ws + WS_BMP);
    LAS unsigned* buf = (LAS unsigned*)(wl + D1_BUF); LAS unsigned* hist = (LAS unsigned*)(wl + D1_HIST); LAS unsigned* bmp = (LAS unsigned*)(wl + D1_BMP); LAS unsigned* cnt = (LAS unsigned*)(wl + D1_CNT);
    const int lane = F.lane, ql = lane & 15, g = lane >> 4, q0 = qg * 16, kend = dsa_kend(q0);
    const size_t rowq = (size_t)b * LP + q0 + ql;
    bf16x8 Bq[8][2]; float wq[8];
#pragma unroll
    for (int h = 0; h < 8; ++h) {
#pragma unroll
        for (int ks = 0; ks < 2; ++ks) Bq[h][ks] = *(const bf16x8*)(PA + rowq * NIN_OA + CA_QI + h * 64 + ks * 32 + 8 * g);
        wq[h] = bf2f(PA[rowq * NIN_OA + CA_WI + h]) * (0.35355339059f * 0.125f);
    }
    if (lane < 16) cnt[lane] = 0u;
    LDS_WAIT();
    unsigned thr = 0u;
    const bf16_t* kp = (const bf16_t*)(F.ws + WS_KIC) + ((size_t)b * LP + ql) * 64 + 8 * g;
    const int ngrp = kend / 16, nit = (ngrp + 1) / 2;
    bf16x8 S0[2][2], S1[2][2], S2[2][2];
#define D1_LOADG(dst, it_) do { _Pragma("unroll") for (int j_ = 0; j_ < 2; ++j_) { int gi_ = 2 * (it_) + j_; gi_ = gi_ < ngrp ? gi_ : ngrp - 1; const bf16_t* kn_ = kp + (size_t)gi_ * 16 * 64; dst[j_][0] = *(const bf16x8*)kn_; dst[j_][1] = *(const bf16x8*)(kn_ + 32); } } while (0)
#define D1_BODY(CUR, LD, itv) do { const int it_b = (itv); \
        D1_LOADG(LD, it_b + 2); \
        unsigned pk[8]; int c = 0; \
        _Pragma("unroll") for (int j = 0; j < 2; ++j) { \
            float sc[4] = {0.f, 0.f, 0.f, 0.f}; \
            _Pragma("unroll") for (int h = 0; h < 8; ++h) { f32x4 acc = (f32x4){0.f, 0.f, 0.f, 0.f}; \
                acc = __builtin_amdgcn_mfma_f32_16x16x32_bf16(CUR[j][0], Bq[h][0], acc, 0, 0, 0); \
                acc = __builtin_amdgcn_mfma_f32_16x16x32_bf16(CUR[j][1], Bq[h][1], acc, 0, 0, 0); \
                _Pragma("unroll") for (int i = 0; i < 4; ++i) sc[i] = __builtin_fmaf(wq[h], __int_as_float(max(__float_as_int(acc[i]), 0)), sc[i]); }   \
            const bool gv = (2 * it_b + j) < ngrp; \
            _Pragma("unroll") for (int i = 0; i < 4; ++i) { const unsigned p = (d1_mono(sc[i]) & 0xFFFF8000u) | (unsigned)((2 * it_b + j) * 16 + 4 * g + i); pk[4 * j + i] = gv ? p : 0u; c += (pk[4 * j + i] > thr) ? 1 : 0; } \
        } \
        d1_append(buf, hist, cnt, pk, c, thr, ql, lane, rep); \
    } while (0)
#pragma unroll
    for (int h = 0; h < 8; ++h) asm volatile("" :: "v"(Bq[h][0]), "v"(Bq[h][1]), "v"(wq[h]));
    D1_LOADG(S0, 0); D1_LOADG(S1, 1);
    for (int it = 0; it < nit; it += 3) {
        D1_BODY(S0, S2, it);
        if (it + 1 < nit) D1_BODY(S1, S0, it + 1);
        if (it + 2 < nit) D1_BODY(S2, S1, it + 2);
    }
#undef D1_BODY
#undef D1_LOADG
    LDS_WAIT();
#pragma unroll 1
    for (int qq = 0; qq < 16; ++qq) {
        if ((int)cnt[qq] > 256) (void)d1_select<true>(buf, hist, cnt, qq, lane);
        const int n = (int)cnt[qq];
#pragma unroll
        for (int j = 0; j < 9; ++j) if (lane + 64 * j < BMP_PITCH) bmp[lane + 64 * j] = 0u;
        LDS_WAIT();
#pragma unroll
        for (int i = 0; i < 4; ++i) if (lane + 64 * i < n) { const unsigned idx = buf[qq * D1_CAP + lane + 64 * i] & 0x7FFFu; __hip_atomic_fetch_or(bmp + (idx >> 5), 1u << (idx & 31u), __ATOMIC_RELAXED, __HIP_MEMORY_SCOPE_WORKGROUP); }
        LDS_WAIT();
        unsigned* orow = BMP + ((size_t)b * LP + q0 + qq) * BMP_PITCH;
#pragma unroll
        for (int j = 0; j < 9; ++j) if (lane + 64 * j < BMP_PITCH) orow[lane + 64 * j] = bmp[lane + 64 * j];
        LDS_WAIT();
    }
}
__device__ __forceinline__ void d1_phase(Frame& F, int rep) {
    if (F.wave >= 4) return;
    LAS unsigned char* wl = F.lds + F.wave * D1_WAVE;
    constexpr int NQG = LR / 16;
    const int b = F.bid & 1;
    for (;;) {
        int u = 0;
        if (F.lane == 0) u = (int)__hip_atomic_fetch_add(F.ctl + CW_Q1 + 64 * (b + 2 * rep), 1u, __ATOMIC_RELAXED, __HIP_MEMORY_SCOPE_AGENT);
        u = __builtin_amdgcn_readfirstlane(u);
        if (u >= NQG) break;
        d1_unit(F, wl, b, NQG - 1 - u, rep);
    }
}

constexpr int D2_KS = 0, D2_KROW = 272, D2_VS = 64 * D2_KROW, D2_VROW = 144, D2_BUF = D2_VS + 128 * D2_VROW, D2_LUT = 2 * D2_BUF, D2_LDS = D2_LUT + 260 * 4;
constexpr float D2_SL2 = 0.08838834764831845f * 1.4426950408889634f, D2_L2E = 1.4426950408889634f, D2_NEG = -3.0e38f, D2_THR = 11.5f;
__device__ __forceinline__ int t5_bucket_dev(int rel) {
    const int n = rel < 0 ? -rel : rel; int v;
    if (n < 8) v = n; else { int l = 8 + (int)(log((double)n / 8.0) / log(16.0) * 8.0); v = l < 15 ? l : 15; }
    return (rel > 0 ? 16 : 0) + v;
}
template <bool FAR>
__device__ __forceinline__ void d2_softmax(const f32x4 (&St)[2][4], unsigned (&bw)[2][2], const unsigned (&bwn)[2][2], float (&mrun)[2], float (&lrun)[2], f32x4 (&O)[2][8], bf16x8 (&Pb)[2][2],
                                           const LAS float* lut, const int g, const int key0, const int (&qpos)[2]) {
    const float bfar = lut[128];
#pragma unroll
    for (int s = 0; s < 2; ++s) {
        const int wsh0 = (int)(bw[s][0] >> (4 * g)), wsh1 = (int)(bw[s][1] >> (4 * g));
        float pv[4][4]; float tmax = D2_NEG;
#pragma unroll
        for (int sub = 0; sub < 4; ++sub)
#pragma unroll
            for (int i = 0; i < 4; ++i) {
                float bias = bfar;
                if (!FAR) { const int rel = key0 + 16 * sub + 4 * g + i - qpos[s]; const int n = rel < 0 ? -rel : rel; const int nn = n < 128 ? n : 128; bias = lut[rel > 0 ? 129 + nn : nn]; }
                const float x = St[s][sub][i] * D2_SL2 + bias;
                const int t = __builtin_amdgcn_sbfe((sub >> 1) ? wsh1 : wsh0, 16 * (sub & 1) + i, 1);
                const float xm = __int_as_float((t & __float_as_int(x)) | (~t & __float_as_int(D2_NEG)));
                pv[sub][i] = xm; tmax = fmaxf(tmax, xm); }
        if (__any(tmax > mrun[s] + D2_THR)) {
            float tm = fmaxf(tmax, __shfl_xor(tmax, 16)); tm = fmaxf(tm, __shfl_xor(tm, 32));
            const float mnew = fmaxf(mrun[s], tm), alpha = __builtin_amdgcn_exp2f(mrun[s] - mnew);
            mrun[s] = mnew; lrun[s] *= alpha;
#pragma unroll
            for (int dt = 0; dt < 8; ++dt) O[s][dt] = O[s][dt] * alpha;
        }
        float ps = 0.f; const float mr = mrun[s];
#pragma unroll
        for (int sub = 0; sub < 4; ++sub)
#pragma unroll
            for (int i = 0; i < 4; ++i) { const float p = __builtin_amdgcn_exp2f(pv[sub][i] - mr); pv[sub][i] = p; ps += p; }
        lrun[s] += ps;
#pragma unroll
        for (int kk = 0; kk < 2; ++kk) { u32x4 pw; pw.x = pk2(pv[2 * kk][0], pv[2 * kk][1]); pw.y = pk2(pv[2 * kk][2], pv[2 * kk][3]); pw.z = pk2(pv[2 * kk + 1][0], pv[2 * kk + 1][1]); pw.w = pk2(pv[2 * kk + 1][2], pv[2 * kk + 1][3]);
            Pb[s][kk] = __builtin_bit_cast(bf16x8, pw); }
        bw[s][0] = bwn[s][0]; bw[s][1] = bwn[s][1];
    }
}
#ifndef PROBE_D2
#define PROBE_D2 0
#endif
__device__ __forceinline__ void d2_unit(Frame& F, LAS unsigned char* lds, int b, int jb, int h, int rep) {
    const bf16_t* PA = (const bf16_t*)(F.ws + WS_P); const bf16_t* KVT = (const bf16_t*)(F.ws + WS_KVT); const unsigned* BMP = (const unsigned*)(F.ws + WS_BMP);
    bf16_t* Y = (bf16_t*)(F.ws + WS_Y);
    LAS float* lut = (LAS float*)(lds + D2_LUT);
    const int lane = F.lane, ql = lane & 15, g = lane >> 4, w = F.wave, tid = F.tid;
    const int qbase = jb * 256 + w * 32;
    const int qlast = (jb * 256 + 255 < LR - 1) ? jb * 256 + 255 : LR - 1;
    const int ntile = (dsa_kend(qlast) + 63) / 64;
    const int kr = tid >> 3, ksg = tid & 7, vd = tid >> 2, vst = tid & 3;
    const bf16_t* ksrc = PA + ((size_t)b * LP + kr) * NIN_OA + CA_KD + h * 128 + ksg * 16;
    const bf16_t* vsrc = KVT + (size_t)(RB_VD + h * 128 + vd) * M + (size_t)b * LP + vst * 16;
    const int kdst = D2_KS + kr * D2_KROW + ksg * 32, vdst = D2_VS + vd * D2_VROW + (vst >> 1) * 64 + (vst & 1) * 8;
    u32x4 rk0, rk1, rva, rvc;
#define D2_LOAD(kt_) do { const bf16_t* ks_ = ksrc + (size_t)(kt_) * 64 * NIN_OA; rk0 = *(const u32x4*)ks_; rk1 = *(const u32x4*)(ks_ + 8); const bf16_t* vs_ = vsrc + (kt_) * 64; rva = *(const u32x4*)vs_; rvc = *(const u32x4*)(vs_ + 8); } while (0)
#define D2_STORE(p_) do { LAS unsigned char* kb_ = lds + (p_) * D2_BUF; *(LAS u32x4*)(kb_ + kdst) = rk0; *(LAS u32x4*)(kb_ + kdst + 16) = rk1; \
        *(LAS u32x2*)(kb_ + vdst) = (u32x2){rva.x, rva.y}; *(LAS u32x2*)(kb_ + vdst + 16) = (u32x2){rva.z, rva.w}; *(LAS u32x2*)(kb_ + vdst + 32) = (u32x2){rvc.x, rvc.y}; *(LAS u32x2*)(kb_ + vdst + 48) = (u32x2){rvc.z, rvc.w}; } while (0)
    RAW_BAR();
    D2_LOAD(0);
    if (tid < 258) { const int n = tid < 129 ? tid : tid - 129; const int rel = tid < 129 ? -n : n; lut[tid] = F.in[I_RELB][t5_bucket_dev(rel) * 8 + h] * D2_L2E; }
    int qpos[2]; size_t qrow[2]; bool qok[2];
    bf16x8 Bq[2][4];
#pragma unroll
    for (int s = 0; s < 2; ++s) { qpos[s] = qbase + 16 * s + ql; qok[s] = qpos[s] < LR; qrow[s] = (size_t)b * LP + (qok[s] ? qpos[s] : 0);
#pragma unroll
        for (int ks = 0; ks < 4; ++ks) Bq[s][ks] = *(const bf16x8*)(PA + qrow[s] * NIN_OA + CA_QD + h * 128 + ks * 32 + 8 * g); }
    f32x4 O[2][8]; float mrun[2], lrun[2];
#pragma unroll
    for (int s = 0; s < 2; ++s) { mrun[s] = -1.0e30f; lrun[s] = 0.f;
#pragma unroll
        for (int dt = 0; dt < 8; ++dt) O[s][dt] = (f32x4){0.f, 0.f, 0.f, 0.f}; }
    unsigned bw[2][2], bwn[2][2];
#pragma unroll
    for (int s = 0; s < 2; ++s) { bw[s][0] = qok[s] ? BMP[qrow[s] * BMP_PITCH] : 0u; bw[s][1] = qok[s] ? BMP[qrow[s] * BMP_PITCH + 1] : 0u; bwn[s][0] = 0u; bwn[s][1] = 0u; }
    D2_STORE(0);
#pragma unroll
    for (int s = 0; s < 2; ++s) {
#pragma unroll
        for (int ks = 0; ks < 4; ++ks) asm volatile("" :: "v"(Bq[s][ks]));
        asm volatile("" :: "v"(bw[s][0]), "v"(bw[s][1])); }
    if (ntile > 1) D2_LOAD(1);
    RAW_BAR();
    for (int kt = 0; kt < ntile; ++kt) {
        const int key0 = kt * 64;
        LAS unsigned char* tb = lds + (kt & 1) * D2_BUF;
        if (kt + 1 < ntile && !(rep && (PROBE_D2 & 2))) { D2_STORE((kt + 1) & 1); if (kt + 2 < ntile) D2_LOAD(kt + 2);
#pragma unroll
            for (int s = 0; s < 2; ++s) { bwn[s][0] = qok[s] ? BMP[qrow[s] * BMP_PITCH + 2 * kt + 2] : 0u; bwn[s][1] = qok[s] ? BMP[qrow[s] * BMP_PITCH + 2 * kt + 3] : 0u; } }
        f32x4 St[2][4];
#pragma unroll
        for (int s = 0; s < 2; ++s)
#pragma unroll
            for (int sub = 0; sub < 4; ++sub) St[s][sub] = (f32x4){0.f, 0.f, 0.f, 0.f};
#pragma unroll
        for (int ks = 0; ks < 4; ++ks)
#pragma unroll
            for (int sub = 0; sub < 4; ++sub) { const bf16x8 Ak = *(const LAS bf16x8*)(tb + D2_KS + (16 * sub + ql) * D2_KROW + (32 * ks + 8 * g) * 2);
#pragma unroll
                for (int s = 0; s < 2; ++s) St[s][sub] = __builtin_amdgcn_mfma_f32_16x16x32_bf16(Ak, Bq[s][ks], St[s][sub], 0, 0, 0); }
        const bool far = (key0 + 63 + 129 <= qbase);
        bf16x8 Pb[2][2];
        if (!far) {
            const float bf_ = lut[128];
#pragma unroll
            for (int s = 0; s < 2; ++s)
#pragma unroll
                for (int sub = 0; sub < 4; ++sub)
#pragma unroll
                    for (int i = 0; i < 4; ++i) { const int rel = key0 + 16 * sub + 4 * g + i - qpos[s]; const int n = rel < 0 ? -rel : rel; const int nn = n < 128 ? n : 128;
                        St[s][sub][i] += (lut[rel > 0 ? 129 + nn : nn] - bf_) * (1.0f / D2_SL2); }
        }
        if (rep && (PROBE_D2 & 1)) {
#pragma unroll
            for (int s = 0; s < 2; ++s)
#pragma unroll
                for (int kk = 0; kk < 2; ++kk) { u32x4 pw; pw.x = pk2(St[s][2 * kk][0], St[s][2 * kk][1]); pw.y = pk2(St[s][2 * kk][2], St[s][2 * kk][3]); pw.z = pk2(St[s][2 * kk + 1][0], St[s][2 * kk + 1][1]); pw.w = pk2(St[s][2 * kk + 1][2], St[s][2 * kk + 1][3]); Pb[s][kk] = __builtin_bit_cast(bf16x8, pw); }
        } else
        d2_softmax<true>(St, bw, bwn, mrun, lrun, O, Pb, lut, g, key0, qpos);
#pragma unroll
        for (int kk = 0; kk < 2; ++kk)
#pragma unroll
            for (int dt = 0; dt < 8; ++dt) { const bf16x8 Av = *(const LAS bf16x8*)(tb + D2_VS + (16 * dt + ql) * D2_VROW + kk * 64 + g * 16);
#pragma unroll
                for (int s = 0; s < 2; ++s) O[s][dt] = __builtin_amdgcn_mfma_f32_16x16x32_bf16(Av, Pb[s][kk], O[s][dt], 0, 0, 0); }
        RAW_BAR();
    }
#undef D2_LOAD
#undef D2_STORE
#pragma unroll
    for (int s = 0; s < 2; ++s) {
        float l = lrun[s]; l += __shfl_xor(l, 16); l += __shfl_xor(l, 32);
        const float inv = (qok[s] && l > 0.f) ? 1.0f / l : 0.f;
        if (qpos[s] < LP) { bf16_t* yr = Y + ((size_t)b * LP + qpos[s]) * D + 1024 + h * 128 + 4 * g;
#pragma unroll
            for (int dt = 0; dt < 8; ++dt) { u32x2 o; o.x = pk2(O[s][dt][0] * inv, O[s][dt][1] * inv); o.y = pk2(O[s][dt][2] * inv, O[s][dt][3] * inv); *(u32x2*)(yr + 16 * dt) = o; } }
    }
}
constexpr int D2_NJB = (LP + 255) / 256, D2_NU = NB * D2_NJB * 8;
__device__ __forceinline__ void d2_worker(Frame& F, LAS unsigned char* lds, int rep) {
    LAS int* slot = (LAS int*)(F.lds + LDS_MISC);
    for (;;) {
        __syncthreads();
        if (F.tid == 0) slot[0] = (int)__hip_atomic_fetch_add(F.ctl + CW_Q2 + 64 * rep, 1u, __ATOMIC_RELAXED, __HIP_MEMORY_SCOPE_AGENT);
        __syncthreads();
        const int u = slot[0];
        if (u >= D2_NU) break;
        const int h = u & 7, b = (u >> 3) & 1, jb = D2_NJB - 1 - (u >> 4);
        d2_unit(F, lds, b, jb, h, rep);
    }
}
constexpr int ML_QS = 0, ML_ROW = 528, ML_KS = ML_QS + 64 * ML_ROW, ML_KT = ML_KS + 64 * ML_ROW, ML_TROW = 144, ML_VT = ML_KT + 256 * ML_TROW, ML_VW = ML_VT + 48 * ML_TROW, ML_CB = ML_VW + 48 * ML_TROW,
              ML_SD = ML_CB + 48 * ML_ROW, ML_SC = ML_SD + 64 * ML_TROW, ML_LDS = ML_SC + 2048;
typedef short s16x4 __attribute__((ext_vector_type(4)));
template <int CTRL, int ROWMASK> __device__ __forceinline__ float dpp_f(float old, float src) { return __int_as_float(__builtin_amdgcn_update_dpp(__float_as_int(old), __float_as_int(src), CTRL, ROWMASK, 0xf, false)); }
__device__ __forceinline__ float wave_scan_add(float v) {
    v += dpp_f<0x111, 0xf>(0.f, v); v += dpp_f<0x112, 0xf>(0.f, v); v += dpp_f<0x114, 0xf>(0.f, v); v += dpp_f<0x118, 0xf>(0.f, v);
    v += dpp_f<0x142, 0xa>(0.f, v); v += dpp_f<0x143, 0xc>(0.f, v); return v;
}
__device__ __forceinline__ float wave_scan_max(float v) {
    const float ni = -3.0e38f;
    v = fmaxf(v, dpp_f<0x111, 0xf>(ni, v)); v = fmaxf(v, dpp_f<0x112, 0xf>(ni, v)); v = fmaxf(v, dpp_f<0x114, 0xf>(ni, v)); v = fmaxf(v, dpp_f<0x118, 0xf>(ni, v));
    v = fmaxf(v, dpp_f<0x142, 0xa>(ni, v)); v = fmaxf(v, dpp_f<0x143, 0xc>(ni, v)); return v;
}
__device__ __forceinline__ float readlane_f(float v, int l) { return __int_as_float(__builtin_amdgcn_readlane(__float_as_int(v), l)); }
__device__ __forceinline__ void mlstm_worker(Frame& F, LAS unsigned char* lds, int wg, int noload) {
    const bf16_t* PA = (const bf16_t*)(F.ws + WS_P); const bf16_t* KVT = (const bf16_t*)(F.ws + WS_KVT); bf16_t* Y = (bf16_t*)(F.ws + WS_Y);
    const int b = wg >> 5, h = (wg >> 3) & 3, sl = wg & 7, v0 = sl * 32;
    const int tid = F.tid, lane = F.lane, w = F.wave, ql = lane & 15, g = lane >> 4;
    LAS float* sc = (LAS float*)(lds + ML_SC);
    const float b_i = F.in[I_MBI][h], b_f = F.in[I_MBF][h];
    for (int i = tid; i < (48 * ML_ROW) / 4; i += NTHREADS) ((LAS unsigned*)(lds + ML_CB))[i] = 0u;
    for (int i = tid; i < (48 * ML_TROW) / 4; i += NTHREADS) ((LAS unsigned*)(lds + ML_VT))[i] = 0u;
    __syncthreads();
    if (tid < 32) ((LAS unsigned*)(lds + ML_VT + 32 * ML_TROW))[tid] = 0x3F803F80u;
    if (tid == 0) sc[320] = 0.f;
    f32x4 Cacc[2][3];
#pragma unroll
    for (int a = 0; a < 2; ++a)
#pragma unroll
        for (int c = 0; c < 3; ++c) Cacc[a][c] = (f32x4){0.f, 0.f, 0.f, 0.f};
    u32x4 rq[4], rkt[4], rv; unsigned rli = 0, rlf = 0; u32x2 rog = (u32x2){0u, 0u};
    const int srow = tid >> 3, sseg = tid & 7;
    const int krow = tid >> 1, khalf = tid & 1;
    const int vrow = tid >> 3, vseg = tid & 7;
    const int tt = w & 3, vtA = (w < 4) ? 0 : 1;
    constexpr int NCHUNK = LP / 64;
#define ML_ISSUE(cc) do { \
        const size_t r0_ = (size_t)b * LP + (size_t)(cc) * 64; \
        const bf16_t* qs_ = PA + (r0_ + srow) * NIN_OA + CA_QM + h * 256 + sseg * 32; \
        _Pragma("unroll") for (int j = 0; j < 4; ++j) rq[j] = *(const u32x4*)(qs_ + 8 * j); \
        const bf16_t* kt_ = KVT + (size_t)(RB_KM + h * 256 + krow) * M + r0_ + khalf * 32; \
        _Pragma("unroll") for (int j = 0; j < 4; ++j) rkt[j] = *(const u32x4*)(kt_ + 8 * j); \
        if (tid < 256) rv = *(const u32x4*)(KVT + (size_t)(RB_VM + h * 256 + v0 + vrow) * M + r0_ + vseg * 8); \
        rog = *(const u32x2*)(PA + (r0_ + 16 * tt + ql) * NIN_OA + CA_OM + h * 256 + v0 + 16 * vtA + 4 * g); \
        if (tid < 64) { rli = PA[(r0_ + tid) * NIN_OA + CA_IM + h]; rlf = PA[(r0_ + tid) * NIN_OA + CA_FM + h]; } \
    } while (0)
    ML_ISSUE(0);
    for (int c = 0; c < NCHUNK; ++c) {
        const size_t r0 = (size_t)b * LP + (size_t)c * 64;
#pragma unroll
        for (int j = 0; j < 4; ++j) { *(LAS u32x4*)(lds + ML_QS + srow * ML_ROW + sseg * 64 + 16 * j) = rq[j];
            *(LAS u32x4*)(lds + ML_KT + krow * ML_TROW + khalf * 64 + 16 * j) = rkt[j]; }
        if (tid < 256) *(LAS u32x4*)(lds + ML_VT + vrow * ML_TROW + vseg * 16) = rv;
        const u32x2 ogc = rog;
        if (w == 0) {
            const float mprev = sc[320];
            const float li_ = bf2f(rli) + b_i, f_ = bf2f(rlf) + b_f, lf_ = fminf(f_, 0.f) - __logf(1.0f + __expf(-fabsf(f_)));
            const float bc = wave_scan_add(lf_);
            const float gg = li_ - bc, pm = wave_scan_max(gg);
            const float Mt = fmaxf(mprev, pm);
            const float M63 = readlane_f(Mt, 63), b63 = readlane_f(bc, 63);
            sc[lane] = gg; sc[64 + lane] = Mt; sc[128 + lane] = bc; sc[256 + lane] = __expf(gg - M63) * 0.0625f;
            if (lane == 0) { sc[321] = __expf(mprev - M63); sc[322] = b63 + M63; sc[323] = mprev; }
        }
        if (c + 1 < NCHUNK && !noload) ML_ISSUE(c + 1);
        RAW_BAR();
        {
            const int ss = w >> 1;
            f32x4 S2[2] = {(f32x4){0.f, 0.f, 0.f, 0.f}, (f32x4){0.f, 0.f, 0.f, 0.f}};
            {
                bf16x8 Ak[8], Bq0[8], Bq1[8];
#pragma unroll
                for (int ks = 0; ks < 8; ++ks) {
                    const LAS unsigned char* ta = lds + ML_KT + (32 * ks + 8 * g + (ql >> 2)) * ML_TROW + (16 * ss + 4 * (ql & 3)) * 2;
                    const s16x4 lo = __builtin_amdgcn_ds_read_tr16_b64_v4i16((LAS s16x4*)ta), hi = __builtin_amdgcn_ds_read_tr16_b64_v4i16((LAS s16x4*)(ta + 4 * ML_TROW));
                    Ak[ks] = (bf16x8){lo[0], lo[1], lo[2], lo[3], hi[0], hi[1], hi[2], hi[3]};
                    Bq0[ks] = *(const LAS bf16x8*)(lds + ML_QS + (16 * (2 * (w & 1)) + ql) * ML_ROW + (32 * ks + 8 * g) * 2);
                    Bq1[ks] = *(const LAS bf16x8*)(lds + ML_QS + (16 * (2 * (w & 1) + 1) + ql) * ML_ROW + (32 * ks + 8 * g) * 2); }
#pragma unroll
                for (int ks = 0; ks < 8; ++ks) { S2[0] = __builtin_amdgcn_mfma_f32_16x16x32_bf16(Ak[ks], Bq0[ks], S2[0], 0, 0, 0); S2[1] = __builtin_amdgcn_mfma_f32_16x16x32_bf16(Ak[ks], Bq1[ks], S2[1], 0, 0, 0); }
            }
            const f32x4 gg4 = *(const LAS f32x4*)(sc + 16 * ss + 4 * g);
#pragma unroll
            for (int j = 0; j < 2; ++j) { const int t = 16 * (2 * (w & 1) + j) + ql; const float Mt = sc[64 + t]; float v[4];
#pragma unroll
                for (int i = 0; i < 4; ++i) { const int s_ = 16 * ss + 4 * g + i; const float e = __expf(fminf(gg4[i] - Mt, 0.f)) * 0.0625f; v[i] = (s_ <= t) ? S2[j][i] * e : 0.f; }
                *(LAS u32x2*)(lds + ML_SD + t * ML_TROW + (16 * ss + 4 * g) * 2) = (u32x2){pk2(v[0], v[1]), pk2(v[2], v[3])}; }
            if (tid < 384) { const int v_ = tid >> 3, sg = tid & 7; const u32x4 vv = *(const LAS u32x4*)(lds + ML_VT + v_ * ML_TROW + sg * 16);
                const f32x4 wa = *(const LAS f32x4*)(sc + 256 + 8 * sg), wb = *(const LAS f32x4*)(sc + 256 + 8 * sg + 4);
                u32x4 o; o.x = pk2(bflo(vv.x) * wa[0], bfhi(vv.x) * wa[1]); o.y = pk2(bflo(vv.y) * wa[2], bfhi(vv.y) * wa[3]); o.z = pk2(bflo(vv.z) * wb[0], bfhi(vv.z) * wb[1]); o.w = pk2(bflo(vv.w) * wb[2], bfhi(vv.w) * wb[3]);
                *(LAS u32x4*)(lds + ML_VW + v_ * ML_TROW + sg * 16) = o; }
        }
        RAW_BAR();
        f32x4 N0 = (f32x4){0.f, 0.f, 0.f, 0.f}, N1 = (f32x4){0.f, 0.f, 0.f, 0.f};
        const int t_ = 16 * tt + ql;
        {
#pragma unroll
            for (int hf = 0; hf < 2; ++hf) {
                bf16x8 Bq[4], Ac[4], Ac2[4];
#pragma unroll
                for (int k4 = 0; k4 < 4; ++k4) { const int ks = 4 * hf + k4; Bq[k4] = *(const LAS bf16x8*)(lds + ML_QS + t_ * ML_ROW + (32 * ks + 8 * g) * 2);
                    Ac[k4] = *(const LAS bf16x8*)(lds + ML_CB + (16 * vtA + ql) * ML_ROW + (32 * ks + 8 * g) * 2);
                    if (w < 4) Ac2[k4] = *(const LAS bf16x8*)(lds + ML_CB + (32 + ql) * ML_ROW + (32 * ks + 8 * g) * 2); }
#pragma unroll
                for (int k4 = 0; k4 < 4; ++k4) { N0 = __builtin_amdgcn_mfma_f32_16x16x32_bf16(Ac[k4], Bq[k4], N0, 0, 0, 0);
                    if (w < 4) N1 = __builtin_amdgcn_mfma_f32_16x16x32_bf16(Ac2[k4], Bq[k4], N1, 0, 0, 0); }
            }
            const float wi = __expf(sc[323] - sc[64 + t_]);
            N0 = N0 * wi; N1 = N1 * wi;
#pragma unroll
            for (int ks = 0; ks < 2; ++ks) { const bf16x8 Bs = *(const LAS bf16x8*)(lds + ML_SD + t_ * ML_TROW + (32 * ks + 8 * g) * 2);
                const bf16x8 Av = *(const LAS bf16x8*)(lds + ML_VT + (16 * vtA + ql) * ML_TROW + (32 * ks + 8 * g) * 2);
                N0 = __builtin_amdgcn_mfma_f32_16x16x32_bf16(Av, Bs, N0, 0, 0, 0);
                if (w < 4) { const bf16x8 Av2 = *(const LAS bf16x8*)(lds + ML_VT + (32 + ql) * ML_TROW + (32 * ks + 8 * g) * 2); N1 = __builtin_amdgcn_mfma_f32_16x16x32_bf16(Av2, Bs, N1, 0, 0, 0); } }
            if (w < 4 && g == 0) sc[192 + t_] = N1[0];
        }
        RAW_BAR();
        {
            const float den = sc[192 + t_], mt = sc[128 + t_] + sc[64 + t_];
            const float inv = 1.0f / fmaxf(fabsf(den), __expf(-mt));
            const float o0 = N0[0] * inv * fast_sigmoid(bflo(ogc.x)), o1 = N0[1] * inv * fast_sigmoid(bfhi(ogc.x)), o2 = N0[2] * inv * fast_sigmoid(bflo(ogc.y)), o3 = N0[3] * inv * fast_sigmoid(bfhi(ogc.y));
            *(u32x2*)(Y + (r0 + t_) * D + h * 256 + v0 + 16 * vtA + 4 * g) = (u32x2){pk2(o0, o1), pk2(o2, o3)};
        }
        {
            const float decay = sc[321];
            bf16x8 Bv[3][2];
#pragma unroll
            for (int ks = 0; ks < 2; ++ks)
#pragma unroll
                for (int vt = 0; vt < 3; ++vt) Bv[vt][ks] = *(const LAS bf16x8*)(lds + ML_VW + (16 * vt + ql) * ML_TROW + (32 * ks + 8 * g) * 2);
#pragma unroll
            for (int a = 0; a < 2; ++a) { const int kt = 2 * w + a;
#pragma unroll
                for (int vt = 0; vt < 3; ++vt) Cacc[a][vt] = Cacc[a][vt] * decay;
#pragma unroll
                for (int ks = 0; ks < 2; ++ks) { const bf16x8 Ak = *(const LAS bf16x8*)(lds + ML_KT + (16 * kt + ql) * ML_TROW + (32 * ks + 8 * g) * 2);
#pragma unroll
                    for (int vt = 0; vt < 3; ++vt) Cacc[a][vt] = __builtin_amdgcn_mfma_f32_16x16x32_bf16(Ak, Bv[vt][ks], Cacc[a][vt], 0, 0, 0); }
#pragma unroll
                for (int vt = 0; vt < 3; ++vt) *(LAS u32x2*)(lds + ML_CB + (16 * vt + ql) * ML_ROW + (16 * kt + 4 * g) * 2) = (u32x2){pk2(Cacc[a][vt][0], Cacc[a][vt][1]), pk2(Cacc[a][vt][2], Cacc[a][vt][3])}; }
            if (tid == 0) sc[320] = sc[322];
        }
        RAW_BAR();
    }
#undef ML_ISSUE
}
constexpr int NPHASE = 18;
struct Args { const float* in[35]; float* out; unsigned char* ws; int ph_lo, ph_hi, rep, pad; };
__global__ void __launch_bounds__(NTHREADS, 2) fwd_kernel(Args args) {
    extern __shared__ __attribute__((aligned(16))) unsigned char lds_raw[];
    Frame F;
    F.lds = (LAS unsigned char*)lds_raw;
    F.ws = args.ws; F.ctl = (unsigned*)(args.ws + WS_CTL); F.out = args.out;
#pragma unroll
    for (int i = 0; i < 35; ++i) F.in[i] = args.in[i];
    F.tid = threadIdx.x; F.lane = F.tid & 63; F.wave = __builtin_amdgcn_readfirstlane(F.tid >> 6); F.G = gridDim.x; F.bid = blockIdx.x;
    if (F.tid < 64) ((LAS unsigned*)(F.lds + LDS_MISC))[F.tid] = 0u;
    __syncthreads();
    const int lo = args.ph_lo, hi = args.ph_hi;
    XcdBarrier bar; bar.bar = F.ctl + CW_BAR; bar.x = 0; bar.st = (volatile LAS unsigned*)(F.lds + LDS_MISC + 32);
    if (hi - lo > 1) bar = xcd_barrier_post(F.ctl + CW_BAR, (volatile LAS unsigned*)(F.lds + LDS_MISC + 32));
#define IN(k) (lo <= (k) && (k) < hi)
#define SEAM(k) do { if (IN(k) && IN((k) + 1)) xcd_barrier(bar); } while (0)
    unsigned char* ws = args.ws;
    const int nM = M / 256;

    if (IN(0)) { p0_prologue(F); } SEAM(0);
    if (IN(1)) {
        s5_build_matrices(F);
        pg8::LinProv S; S.so.init(nM, NIN_E / 256, F.G, F.bid); S.Bt = (const char*)(ws + WS_WINE); S.K = D;
        pg8::EpiBf16 E{(bf16_t*)(ws + WS_P), NIN_E};
        pg8::gemm_phase(F.lds, (const char*)(ws + WS_HA), D, S, E); } SEAM(1);
    if (IN(2)) { if (F.bid < 64) { if (!(args.rep && PROBE_ML == 2)) s5_ssd_unit<false>(F, F.bid >> 5, F.bid & 31, 0); } else { if (!(args.rep && PROBE_ML == 1)) conv_phase(F, 64, F.G - 64); } } do { if (IN(2) && IN(4)) xcd_barrier(bar); } while (0);
    if (IN(4)) {
        pg8::LinProv S; S.so.init(nM, D / 256, F.G, F.bid); S.Bt = (const char*)(ws + WS_WOUTE); S.K = D;
        pg8::EpiResBf16 E{(bf16_t*)(ws + WS_PRE), (const bf16_t*)(ws + WS_HA), D, ALPHA};
        pg8::gemm_phase(F.lds, (const char*)(ws + WS_Y), D, S, E); } SEAM(4);
    if (IN(5)) { ln_phase<false, 2>(F, (const bf16_t*)(ws + WS_PRE), (bf16_t*)(ws + WS_HB), F.in[I_LN1G], F.in[I_LN1B], ws + WS_HBF8); } SEAM(5);
    if (IN(6)) {
        pg8::LinProv S; S.so.init(nM, N13 / 256, F.G, F.bid); S.Bt = (const char*)(ws + WS_W13); S.K = D / 2;
#if FFN_DOWN_F8
        pg8::EpiGatedF8 E{ws + WS_P, DFF, 1.f / (I8S_H * I8S_W13), F8S_GH};
        pg8::gemm_phase<pg8::EpiGatedF8, pg8::LinProv, 2>(F.lds, (const char*)(ws + WS_HBF8), D / 2, S, E); } SEAM(6);
#else
        pg8::EpiGatedS E{(bf16_t*)(ws + WS_P), DFF, 1.f / (I8S_H * I8S_W13)};
        pg8::gemm_phase<pg8::EpiGatedS, pg8::LinProv, 2>(F.lds, (const char*)(ws + WS_HBF8), D / 2, S, E); } SEAM(6);
#endif
    if (IN(7)) {
#if FFN_DOWN_F8
        pg8::LinProv S; S.so.init(nM, D / 256, F.G, F.bid); S.Bt = (const char*)(ws + WS_W2); S.K = DFF / 2;
        pg8::EpiResBf16S E{(bf16_t*)(ws + WS_PRE), (const bf16_t*)(ws + WS_HB), D, ALPHA, 1.f / (F8S_GH * F8S_W2)};
        pg8::gemm_phase<pg8::EpiResBf16S, pg8::LinProv, 1>(F.lds, (const char*)(ws + WS_P), DFF / 2, S, E); } SEAM(7);
#else
        pg8::LinProv S; S.so.init(nM, D / 256, F.G, F.bid); S.Bt = (const char*)(ws + WS_W2); S.K = DFF;
        pg8::EpiResBf16 E{(bf16_t*)(ws + WS_PRE), (const bf16_t*)(ws + WS_HB), D, ALPHA};
        pg8::gemm_phase(F.lds, (const char*)(ws + WS_P), DFF, S, E); } SEAM(7);
#endif
    if (IN(8)) { ln_phase<false>(F, (const bf16_t*)(ws + WS_PRE), (bf16_t*)(ws + WS_H2), F.in[I_LN2G], F.in[I_LN2B]); } SEAM(8);
    if (IN(9)) {
        { pg8::LinProv S; S.so.init(nM, NIN_OA / 256, F.G, F.bid); S.Bt = (const char*)(ws + WS_WINOA); S.K = D;
          pg8::EpiBf16 E{(bf16_t*)(ws + WS_P), NIN_OA, (bf16_t*)(ws + WS_KIC), CA_KI / 256};
          pg8::gemm_phase(F.lds, (const char*)(ws + WS_H2), D, S, E); }
        { const int ra = (nM * (NIN_OA / 256)) % F.G, rb = ((NIN_OB / 256) * nM) % F.G; int sh = (ra + 7) & ~7; if (sh + rb > F.G || (F.G & 7)) sh = 0;
          pg8::LinProv S; S.so.init(NIN_OB / 256, nM, F.G, (F.bid + F.G - sh) % F.G); S.Bt = (const char*)(ws + WS_H2); S.K = D;
          pg8::EpiBf16 E{(bf16_t*)(ws + WS_KVT), M};
          pg8::gemm_phase(F.lds, (const char*)(ws + WS_WINOB), D, S, E); } } SEAM(9);
    if (IN(10)) { d1_phase(F, args.rep); if (F.wave >= 4 && !args.rep) convert_experts(F); } SEAM(10);
    #ifndef PROBE_G3
#define PROBE_G3 1
#endif
#ifndef PROBE_ML
#define PROBE_ML 0
#endif
    if (IN(11)) { if (F.bid < 64) { if (!(args.rep && PROBE_ML == 2)) mlstm_worker(F, F.lds, F.bid, args.rep && PROBE_ML == 3); }
        if (!(args.rep && (PROBE_ML == 1 || PROBE_ML == 3))) d2_worker(F, F.lds, args.rep); } SEAM(11);
    if (IN(12)) {
        pg8::LinProv S; S.so.init(2 * SEQ / 256, D / 256, F.G, F.bid); S.Bt = (const char*)(ws + WS_WOUTO); S.K = D; S.frames = 1;
        pg8::EpiResBf16 E{(bf16_t*)(ws + WS_PRE1), (const bf16_t*)(ws + WS_H2), D, ALPHA, 1};
        pg8::gemm_phase(F.lds, (const char*)(ws + WS_Y), D, S, E); } SEAM(12);
    if (IN(13)) { if (!args.rep) ln_phase<true>(F, (const bf16_t*)(ws + WS_PRE1), (bf16_t*)(ws + WS_H3), F.in[I_LN3G], F.in[I_LN3B], ws + WS_H3F8); } SEAM(13);
    if (IN(14)) { route_phase(F); } SEAM(14);
    const int* TL = (const int*)(ws + WS_MOE + MO_TILEE);
#define MOE_UP(tlo, cnt) do { pg8::GatherProv S; S.so.init((cnt), N13 / 256, F.G, F.bid); S.Bt = (const char*)(ws + WS_EW13); S.K = D / 2; S.rowidx = (const int*)(ws + WS_MOE + MO_SLOTTOK); S.tile_e = TL; S.t_lo = (tlo); S.estride = (size_t)N13 * D; \
        pg8::EpiGatedF8 E{ws + WS_GH, DFF, 1.f / (F8S_H3 * F8S_W13), F8S_GH}; pg8::gemm_phase<pg8::EpiGatedF8, pg8::GatherProv, 1>(F.lds, (const char*)(ws + WS_H3F8), D / 2, S, E); } while (0)
#define MOE_DOWN(tlo, cnt) do { pg8::GatherProv S; S.so.init((cnt), D / 256, F.G, F.bid); S.Bt = (const char*)(ws + WS_EW2); S.K = DFF / 2; S.rowidx = nullptr; S.tile_e = TL; S.t_lo = (tlo); S.estride = (size_t)D * DFF; \
        pg8::EpiBf16S E{(bf16_t*)(ws + WS_YB) + (size_t)(tlo) * 256 * D, D, 1.f / (F8S_GH * F8S_W2)}; pg8::gemm_phase<pg8::EpiBf16S, pg8::GatherProv, 1>(F.lds, (const char*)(ws + WS_GH), DFF / 2, S, E); } while (0)
    if (IN(15)) { const int nt = __builtin_amdgcn_readfirstlane(TL[300]); MOE_UP(0, nt); } SEAM(15);
    if (IN(16)) { const int nt = __builtin_amdgcn_readfirstlane(TL[300]); MOE_DOWN(0, nt); } SEAM(16);
    if (IN(17)) { final_phase(F); }
#undef IN
#undef SEAM
}

extern "C" void kernel_launch(void* const* d_in, const int* in_sizes, int n_in, void* d_out, int out_size, void* d_ws, size_t ws_size, hipStream_t stream) {
    static int grid = 0;
    if (grid == 0) {
        int dev = 0, cus = 0;
        if (n_in != 35 || ws_size < WS_END) { fprintf(stderr, "kernel_launch: expected 35 inputs and >= %zu bytes of workspace (got %d, %zu)\n", (size_t)WS_END, n_in, ws_size); grid = -1; return; }
        if (hipGetDevice(&dev) != hipSuccess || hipDeviceGetAttribute(&cus, hipDeviceAttributeMultiprocessorCount, dev) != hipSuccess) { grid = -1; return; }
        if (hipFuncSetAttribute((const void*)fwd_kernel, hipFuncAttributeMaxDynamicSharedMemorySize, LDS_BYTES) != hipSuccess) { fprintf(stderr, "kernel_launch: hipFuncSetAttribute failed\n"); grid = -1; return; }
        int per_cu = 0;
        (void)hipOccupancyMaxActiveBlocksPerMultiprocessor(&per_cu, (const void*)fwd_kernel, NTHREADS, LDS_BYTES);
        (void)hipGetLastError();
        grid = cus;
        if (per_cu < 1) fprintf(stderr, "kernel_launch: occupancy query reports %d\n", per_cu);
    }
    if (grid < 0) return;
    (void)in_sizes; (void)out_size;
    hipMemsetAsync((char*)d_ws + WS_CTL, 0, 65536, stream);
    Args a; memset(&a, 0, sizeof(a));
    for (int i = 0; i < 35; ++i) a.in[i] = (const float*)d_in[i];
    a.out = (float*)d_out; a.ws = (unsigned char*)d_ws;
#if MK_N_LAUNCHES == 1
    a.ph_lo = 0; a.ph_hi = NPHASE;
    hipLaunchKernelGGL(fwd_kernel, dim3(grid), dim3(NTHREADS), LDS_BYTES, stream, a);
#else
#ifndef PROBE_REP
#define PROBE_REP 0
#endif
    for (int p = 0; p < NPHASE; ++p) { a.ph_lo = p; a.ph_hi = p + 1;
        if ((PROBE_REP >> p) & 1) { a.rep = 1; hipLaunchKernelGGL(fwd_kernel, dim3(grid), dim3(NTHREADS), LDS_BYTES, stream, a); }
        a.rep = 0; hipLaunchKernelGGL(fwd_kernel, dim3(grid), dim3(NTHREADS), LDS_BYTES, stream, a); }
#endif
}
```

```cpp
#include <hip/hip_runtime.h>
#include <cstdio>
#include <cstdint>
#include <cstring>

#define LAS __attribute__((address_space(3)))
#define GAS __attribute__((address_space(1)))
typedef unsigned short bf16_t;
typedef short bf16x8 __attribute__((ext_vector_type(8)));
typedef float f32x4 __attribute__((ext_vector_type(4)));
typedef float f32x16 __attribute__((ext_vector_type(16)));
typedef float f32x2 __attribute__((ext_vector_type(2)));
typedef unsigned u32x4 __attribute__((ext_vector_type(4)));
typedef unsigned u32x2 __attribute__((ext_vector_type(2)));

#ifndef MK_N_LAUNCHES
#define MK_N_LAUNCHES 1
#endif

constexpr int D = 2048, NB = 2, SEQ = 16384, NMETA = 16, LR = 16400, LP = 16512, M = NB * LP;
constexpr int DCONV = 1536, DSSM = 512, NIN_E = 5120, DFF = 5632, N13 = 2 * DFF;
constexpr int NIN_OA = 4864, NIN_OB = 3072;
constexpr int CA_QM = 0, CA_OM = 1024, CA_QD = 2048, CA_KD = 3072, CA_QI = 4096, CA_KI = 4608, CA_IM = 4672, CA_FM = 4676, CA_WI = 4680;
constexpr int RB_KM = 0, RB_VM = 1024, RB_VD = 2048;
constexpr float ALPHA = 1.41421356237309515f;
constexpr float LN_EPS = 1e-5f;
constexpr int S5CH = 128, S5NCH = LP / S5CH;
constexpr int NEXP = 8, MOE_CAP_TILES = 265, MOE_CAP = MOE_CAP_TILES * 256;
constexpr int BMP_PITCH = 544;
constexpr int NWAVES = 8, NTHREADS = 512;

constexpr size_t MiB = 1u << 20;
constexpr size_t WS_CTL = 0, CTL_BYTES = 1 * MiB;
constexpr size_t WS_WINE = 1 * MiB, WS_WOUTE = 21 * MiB, WS_W13 = 29 * MiB, WS_W2 = 73 * MiB, WS_WINOA = 95 * MiB, WS_WINOB = 118 * MiB;
constexpr size_t WS_HA = 138 * MiB, WS_HB = 267 * MiB, WS_PRE = 396 * MiB;
constexpr size_t WS_EW13 = 1 * MiB, WS_EW2 = 353 * MiB, WS_YB = 1 * MiB;
constexpr size_t WS_P = 529 * MiB, WS_KVT = 900 * MiB, WS_BMP = 1094 * MiB, WS_Y = 1163 * MiB, WS_PRE1 = 529 * MiB, WS_GH = 529 * MiB;
constexpr size_t WS_H2 = 1292 * MiB, WS_H3 = 1421 * MiB;
constexpr size_t WS_HBF8 = WS_HA;
constexpr size_t WS_H3F8 = 270 * MiB;
constexpr size_t WS_XE = 1550 * MiB;
constexpr size_t WS_S5T = WS_XE + 3584 * 1024;
constexpr size_t WS_MOE = 1555 * MiB;
constexpr size_t WS_KIC = 1558 * MiB;
constexpr size_t WS_WOUTO = 1563 * MiB;
constexpr size_t WS_END = 1571 * MiB;
constexpr size_t MO_TOKE = 0, MO_TOKG = 512 * 1024, MO_TOKPOS = 1024 * 1024, MO_TOKSLOT = 1536 * 1024, MO_SLOTTOK = 2048 * 1024, MO_TILEE = 2560 * 1024;
constexpr int CW_BAR = 0;
constexpr int CW_CNT = 4096;
constexpr int CW_Q2 = 8192;
constexpr int CW_Q1 = 8448;

constexpr int LDS_BYTES = 163840;
constexpr int LDS_MISC = 163840 - 256;
constexpr int D1_WAVE_BYTES = 36032;

#define LDS_WAIT() asm volatile("s_waitcnt lgkmcnt(0)" ::: "memory")
#define VM_WAIT() asm volatile("s_waitcnt vmcnt(0)" ::: "memory")
#define RAW_BAR() do { asm volatile("s_waitcnt lgkmcnt(0)" ::: "memory"); __builtin_amdgcn_s_barrier(); asm volatile("" ::: "memory"); } while (0)
__device__ __forceinline__ float bf2f(unsigned v) { return __uint_as_float(v << 16); }
__device__ __forceinline__ float bflo(unsigned w) { return __uint_as_float(w << 16); }
__device__ __forceinline__ float bfhi(unsigned w) { return __uint_as_float(w & 0xffff0000u); }
__device__ __forceinline__ unsigned f2bf(float f) { unsigned u = __float_as_uint(f); return (u + 0x7fffu + ((u >> 16) & 1u)) >> 16; }
typedef __bf16 bf16x2_t __attribute__((ext_vector_type(2)));
__device__ __forceinline__ unsigned pk4_f8(float a, float b, float c, float d) {
    a = __builtin_amdgcn_fmed3f(a, -448.f, 448.f); b = __builtin_amdgcn_fmed3f(b, -448.f, 448.f); c = __builtin_amdgcn_fmed3f(c, -448.f, 448.f); d = __builtin_amdgcn_fmed3f(d, -448.f, 448.f);
    int w = __builtin_amdgcn_cvt_pk_fp8_f32(a, b, 0, false); w = __builtin_amdgcn_cvt_pk_fp8_f32(c, d, w, true); return (unsigned)w; }
__device__ __forceinline__ unsigned pk4_i8(float a, float b, float c, float d) {
    const int ia = (int)__builtin_rintf(__builtin_amdgcn_fmed3f(a, -127.f, 127.f)), ib = (int)__builtin_rintf(__builtin_amdgcn_fmed3f(b, -127.f, 127.f));
    const int ic = (int)__builtin_rintf(__builtin_amdgcn_fmed3f(c, -127.f, 127.f)), id = (int)__builtin_rintf(__builtin_amdgcn_fmed3f(d, -127.f, 127.f));
    return (unsigned)(ia & 255) | ((unsigned)(ib & 255) << 8) | ((unsigned)(ic & 255) << 16) | ((unsigned)id << 24); }
constexpr float I8S_H = 28.f, I8S_W13 = 1280.f;
#ifndef FFN_DOWN_F8
#define FFN_DOWN_F8 1
#endif
constexpr float F8S_H3 = 8.f, F8S_W13 = 512.f, F8S_GH = 4.f, F8S_W2 = 2048.f;
constexpr float F8S_Y = 4.f, F8S_WOUT = 1024.f;
#ifndef OUT1_F8
#define OUT1_F8 1
#endif
__device__ __forceinline__ unsigned pk2(float lo, float hi) { bf16x2_t v; v[0] = (__bf16)lo; v[1] = (__bf16)hi; return __builtin_bit_cast(unsigned, v); }
template <int CTRL, int ROWMASK> __device__ __forceinline__ float dpp_add_f(float v) { return v + __int_as_float(__builtin_amdgcn_update_dpp(0, __float_as_int(v), CTRL, ROWMASK, 0xf, false)); }
__device__ __forceinline__ float wave_sum(float v) {
    v = dpp_add_f<0x111, 0xf>(v); v = dpp_add_f<0x112, 0xf>(v); v = dpp_add_f<0x114, 0xf>(v); v = dpp_add_f<0x118, 0xf>(v);
    v = dpp_add_f<0x142, 0xa>(v); v = dpp_add_f<0x143, 0xc>(v);
    return __int_as_float(__builtin_amdgcn_readlane(__float_as_int(v), 63));
}
__device__ __forceinline__ float fast_sigmoid(float x) { return __builtin_amdgcn_rcpf(1.0f + __expf(-x)); }

#define XB_TMO      128
#define XB_XCNT(j)  (256  + 64 * (j))
#define XB_XSUB(j)  (1280 + 64 * (j))
#define XB_XGEN(j)  (2304 + 64 * (j))
#define XB_TOP      3328
#define XB_TOPGEN   3392
#define XCD_BAR_WORDS 3456
#define XB_SPIN_CAP (1u << 22)

__device__ __forceinline__ unsigned xb_ld(unsigned* p)              { return __hip_atomic_load(p, __ATOMIC_RELAXED, __HIP_MEMORY_SCOPE_AGENT); }
__device__ __forceinline__ unsigned xb_add(unsigned* p, unsigned v) { return __hip_atomic_fetch_add(p, v, __ATOMIC_RELAXED, __HIP_MEMORY_SCOPE_AGENT); }
__device__ __forceinline__ unsigned xb_xcc_id() { return (unsigned)__builtin_amdgcn_s_getreg((3 << 11) | 20) & 0xFu; }
#define XB_SPIN(cond, bar) do { unsigned _sp = 0; while (cond) { __builtin_amdgcn_s_sleep(1); \
    if ((++_sp & 255u) == 0u) { if (xb_ld(&(bar)[XB_TMO])) break; if (_sp > XB_SPIN_CAP) { atomicAdd(&(bar)[XB_TMO], 1u); break; } } } } while (0)

struct XcdBarrier { unsigned* bar; unsigned x; volatile LAS unsigned* st; };

__device__ __forceinline__ XcdBarrier xcd_barrier_post(unsigned* bar, volatile LAS unsigned* st) {
    XcdBarrier b; b.bar = bar; b.x = xb_xcc_id(); b.st = st;
    if (threadIdx.x == 0) (void)xb_add(&bar[XB_XCNT(b.x)], 1u);
    return b;
}
__device__ __forceinline__ void xcd_barrier_complete(unsigned* bar, unsigned x, unsigned& nloc, unsigned& nx) {
    const unsigned G = gridDim.x * gridDim.y * gridDim.z;
    unsigned sum, cnt, mine, sp = 0u;
    for (;;) {
        sum = 0u; cnt = 0u; mine = 0u;
#pragma unroll
        for (unsigned j = 0; j < 16; ++j) { const unsigned c = xb_ld(&bar[XB_XCNT(j)]); sum += c; cnt += (c > 0u) ? 1u : 0u; mine = (j == x) ? c : mine; }
        if (sum == G) break;
        __builtin_amdgcn_s_sleep(1);
        if ((++sp & 255u) == 0u) { if (xb_ld(&bar[XB_TMO])) break; if (sp > XB_SPIN_CAP) { atomicAdd(&bar[XB_TMO], 1u); break; } }
    }
    nloc = mine > 0u ? mine : 1u; nx = cnt > 0u ? cnt : 1u;
}
__device__ __forceinline__ void xcd_barrier(const XcdBarrier& b) {
    asm volatile("s_waitcnt vmcnt(0)" ::: "memory");
    __syncthreads();
    if (threadIdx.x == 0) {
        unsigned* bar = b.bar;
        __builtin_amdgcn_s_waitcnt(0);
        unsigned nloc = b.st[0], nx = b.st[1];
        if (nloc == 0u) { xcd_barrier_complete(bar, b.x, nloc, nx); b.st[0] = nloc; b.st[1] = nx; }
        const unsigned old = xb_add(&bar[XB_XSUB(b.x)], 1u);
        const unsigned gen = old / nloc;
        if (old + 1u == (gen + 1u) * nloc) {
            __builtin_amdgcn_fence(__ATOMIC_RELEASE, "agent");
            asm volatile("s_waitcnt vmcnt(0)" ::: "memory");
            const unsigned og = xb_add(&bar[XB_TOP], 1u);
            const unsigned tg = og / nx;
            if (og + 1u == (tg + 1u) * nx) xb_add(&bar[XB_TOPGEN], 1u);
            else XB_SPIN(xb_ld(&bar[XB_TOPGEN]) == tg, bar);
            __builtin_amdgcn_fence(__ATOMIC_ACQUIRE, "agent");
            xb_add(&bar[XB_XGEN(b.x)], 1u);
            asm volatile("s_waitcnt vmcnt(0)" ::: "memory");
        } else {
            XB_SPIN(xb_ld(&bar[XB_XGEN(b.x)]) == gen, bar);
            __builtin_amdgcn_fence(__ATOMIC_ACQUIRE, "agent");
            asm volatile("s_waitcnt vmcnt(0)" ::: "memory");
        }
    }
    __syncthreads();
}
#define PROBE_REP 0
#define PROBE_ML 0
#define PROBE_D1 0
#define PROBE_D2 0
#define PROBE_G3 1
namespace pg8 {
constexpr int BM = 256, BK = 64, HALF = 128, HTB = HALF * BK * 2, STAGE_BYTES = 8 * HTB, NXCD = 8, WGM = 8;
__host__ __device__ __forceinline__ int lds_byte(int r, int c) { const int st = (r >> 4) * 2 + (c >> 5), rr = r & 15, cc = c & 31, ob = rr * 64 + cc * 2; return st * 1024 + (ob ^ (((ob >> 9) & 1) << 5)); }
__host__ __device__ __forceinline__ void stage_rc(int b, int& R, int& C) { const int st = b / 1024, sb = b % 1024, swz = sb ^ (((sb >> 9) & 1) << 5); R = (st >> 1) * 16 + swz / 64; C = (st & 1) * 32 + (swz % 64) / 2; }
__host__ __device__ __forceinline__ int perm32(int rho) { const int n = rho >> 4, i = rho & 15; return 8 * (i >> 2) + 4 * n + (i & 3); }

typedef int i32x4v __attribute__((ext_vector_type(4)));
typedef int i32x8v __attribute__((ext_vector_type(8)));
struct Unit { int pm, pn; };
__device__ __forceinline__ int frame_row0(int pm) { return (pm >> 6) * LP + NMETA + (pm & 63) * BM; }
struct StaticOrder {
    int nM, nN, nwg, G, c;
    __device__ void init(int nM_, int nN_, int G_, int c_) { nM = nM_; nN = nN_; nwg = nM * nN; G = G_; c = c_; }
    __device__ bool next(int i, Unit& u) const {
        const long L = (long)i * G + c; if (L >= nwg) return false;
        int wgid = (int)L; { const int q = nwg / NXCD, r = nwg % NXCD, xcd = wgid % NXCD, off = wgid / NXCD; wgid = (xcd < r ? xcd * (q + 1) : r * (q + 1) + (xcd - r) * q) + off; }
        const int nig = WGM * nN, gid = wgid / nig, fm = gid * WGM, gsz = (nM - fm) < WGM ? (nM - fm) : WGM;
        u.pm = fm + ((wgid % nig) % gsz); u.pn = (wgid % nig) / gsz; return true;
    }
};
struct LinProv {
    StaticOrder so; const char* Bt; int K; int probe_same = 0; int frames = 0;
    __device__ __forceinline__ bool next(int i, Unit& u) const { const bool r = so.next(i, u); if (probe_same) { u.pm &= 3; u.pn &= 3; } return r; }
    __device__ __forceinline__ void aoffs(const Unit& u, const int (&RA)[2], const int (&CA)[2], unsigned (&v)[2][2]) const {
#pragma unroll
        for (int h = 0; h < 2; ++h)
#pragma unroll
            for (int i = 0; i < 2; ++i) v[h][i] = (unsigned)(((frames ? frame_row0(u.pm) : u.pm * BM) + h * HALF + RA[i]) * K + CA[i]) * 2u;
    }
    __device__ __forceinline__ const char* bbase(const Unit& u) const { return Bt + (size_t)u.pn * BM * K * 2; }
};
struct GatherProv {
    StaticOrder so; const char* Bt; int K; const int* rowidx; const int* tile_e; int t_lo; size_t estride;
    __device__ __forceinline__ bool next(int i, Unit& u) const { return so.next(i, u); }
    __device__ __forceinline__ void aoffs(const Unit& u, const int (&RA)[2], const int (&CA)[2], unsigned (&v)[2][2]) const {
#pragma unroll
        for (int h = 0; h < 2; ++h)
#pragma unroll
            for (int i = 0; i < 2; ++i) { const int row = rowidx ? rowidx[(t_lo + u.pm) * BM + h * HALF + RA[i]] : (u.pm * BM + h * HALF + RA[i]); v[h][i] = (unsigned)(row * K + CA[i]) * 2u; }
    }
    __device__ __forceinline__ const char* bbase(const Unit& u) const { const int e = __builtin_amdgcn_readfirstlane(tile_e[t_lo + u.pm]); return Bt + (size_t)e * estride + (size_t)u.pn * BM * K * 2; }
};

struct EpiBf16 {
    static constexpr bool PERM = true;
    bf16_t* O; int ldc; bf16_t* X = nullptr; int xpn = -1; int frames = 0;
    __device__ __forceinline__ void operator()(const f32x4 (&acc)[2][2][4][2], const Unit& u, int wr, int wc, int fr, int fq) const {
        const int row0 = (frames ? frame_row0(u.pm) : u.pm * BM) + wr * 64 + fr, col0 = u.pn * BM + wc * 32 + 8 * fq;
        const bool xc = (u.pn == xpn) && (wc < 2);
#pragma unroll
        for (int ai = 0; ai < 2; ++ai)
#pragma unroll
            for (int m = 0; m < 4; ++m) { bf16_t* rowp = O + (size_t)(row0 + ai * HALF + m * 16) * ldc + col0;
#pragma unroll
                for (int bj = 0; bj < 2; ++bj) { const f32x4 v0 = acc[ai][bj][m][0], v1 = acc[ai][bj][m][1];
                    u32x4 w; w.x = pk2(v0[0], v0[1]); w.y = pk2(v0[2], v0[3]); w.z = pk2(v1[0], v1[1]); w.w = pk2(v1[2], v1[3]);
                    *(u32x4*)(rowp + bj * HALF) = w;
                    if (bj == 0 && xc) *(u32x4*)(X + (size_t)(row0 + ai * HALF + m * 16) * 64 + wc * 32 + 8 * fq) = w; } }
    }
};
struct EpiGated {
    static constexpr bool PERM = true;
    bf16_t* O; int ldc; int nostore;
    __device__ __forceinline__ void operator()(const f32x4 (&acc)[2][2][4][2], const Unit& u, int wr, int wc, int fr, int fq) const {
        if (nostore == 1) return;
        if (nostore == 2) {
            const int wv = wr * 4 + wc; char* slab = (char*)O + ((size_t)(u.pm * 44 + u.pn) * 8 + wv) * 8192 + (fq * 16 + fr) * 16;
#pragma unroll
            for (int ai = 0; ai < 2; ++ai)
#pragma unroll
                for (int m = 0; m < 4; ++m) { float r[8];
#pragma unroll
                    for (int n = 0; n < 2; ++n)
#pragma unroll
                        for (int j = 0; j < 4; ++j) { const float a = acc[ai][0][m][n][j], b = acc[ai][1][m][n][j]; r[n * 4 + j] = a * b * __builtin_amdgcn_rcpf(1.0f + __expf(-a)); }
                    u32x4 w; w.x = pk2(r[0], r[1]); w.y = pk2(r[2], r[3]); w.z = pk2(r[4], r[5]); w.w = pk2(r[6], r[7]);
                    *(u32x4*)(slab + (ai * 4 + m) * 1024) = w; }
            return; }
        const int row0 = u.pm * BM + wr * 64 + fr, col0 = u.pn * HALF + wc * 32 + 8 * fq;
#pragma unroll
        for (int ai = 0; ai < 2; ++ai)
#pragma unroll
            for (int m = 0; m < 4; ++m) { bf16_t* rowp = O + (size_t)(row0 + ai * HALF + m * 16) * ldc + col0;
                float r[8];
#pragma unroll
                for (int n = 0; n < 2; ++n)
#pragma unroll
                    for (int j = 0; j < 4; ++j) { const float a = acc[ai][0][m][n][j], b = acc[ai][1][m][n][j]; r[n * 4 + j] = a * b * __builtin_amdgcn_rcpf(1.0f + __expf(-a)); }
                u32x4 w; w.x = pk2(r[0], r[1]); w.y = pk2(r[2], r[3]); w.z = pk2(r[4], r[5]); w.w = pk2(r[6], r[7]);
                *(u32x4*)rowp = w; }
    }
};
struct EpiResBf16S {
    static constexpr bool PERM = true;
    bf16_t* C; const bf16_t* H; int ldc; float alpha, scale; int frames = 0;
    __device__ __forceinline__ void operator()(const f32x4 (&acc)[2][2][4][2], const Unit& u, int wr, int wc, int fr, int fq) const {
        const int row0 = (frames ? frame_row0(u.pm) : u.pm * BM) + wr * 64 + fr, col0 = u.pn * BM + wc * 32 + 8 * fq;
#pragma unroll
        for (int ai = 0; ai < 2; ++ai)
#pragma unroll
            for (int m = 0; m < 4; ++m) { const size_t off = (size_t)(row0 + ai * HALF + m * 16) * ldc + col0;
#pragma unroll
                for (int bj = 0; bj < 2; ++bj) { const u32x4 hv = *(const u32x4*)(H + off + bj * HALF); const f32x4 v0 = acc[ai][bj][m][0] * scale, v1 = acc[ai][bj][m][1] * scale;
                    u32x4 w; w.x = pk2(alpha * bflo(hv.x) + v0[0], alpha * bfhi(hv.x) + v0[1]); w.y = pk2(alpha * bflo(hv.y) + v0[2], alpha * bfhi(hv.y) + v0[3]);
                    w.z = pk2(alpha * bflo(hv.z) + v1[0], alpha * bfhi(hv.z) + v1[1]); w.w = pk2(alpha * bflo(hv.w) + v1[2], alpha * bfhi(hv.w) + v1[3]);
                    *(u32x4*)(C + off + bj * HALF) = w; } }
    }
};
struct EpiBf16S {
    static constexpr bool PERM = true;
    bf16_t* O; int ldc; float scale;
    __device__ __forceinline__ void operator()(const f32x4 (&acc)[2][2][4][2], const Unit& u, int wr, int wc, int fr, int fq) const {
        const int row0 = u.pm * BM + wr * 64 + fr, col0 = u.pn * BM + wc * 32 + 8 * fq;
#pragma unroll
        for (int ai = 0; ai < 2; ++ai)
#pragma unroll
            for (int m = 0; m < 4; ++m) { bf16_t* rowp = O + (size_t)(row0 + ai * HALF + m * 16) * ldc + col0;
#pragma unroll
                for (int bj = 0; bj < 2; ++bj) { const f32x4 v0 = acc[ai][bj][m][0] * scale, v1 = acc[ai][bj][m][1] * scale;
                    u32x4 w; w.x = pk2(v0[0], v0[1]); w.y = pk2(v0[2], v0[3]); w.z = pk2(v1[0], v1[1]); w.w = pk2(v1[2], v1[3]);
                    *(u32x4*)(rowp + bj * HALF) = w; } }
    }
};
struct EpiGatedS {
    static constexpr bool PERM = true;
    bf16_t* O; int ldc; float sin; int frames = 0;
    __device__ __forceinline__ void operator()(const f32x4 (&acc)[2][2][4][2], const Unit& u, int wr, int wc, int fr, int fq) const {
        const int row0 = (frames ? frame_row0(u.pm) : u.pm * BM) + wr * 64 + fr, col0 = u.pn * HALF + wc * 32 + 8 * fq;
#pragma unroll
        for (int ai = 0; ai < 2; ++ai)
#pragma unroll
            for (int m = 0; m < 4; ++m) { bf16_t* rowp = O + (size_t)(row0 + ai * HALF + m * 16) * ldc + col0;
                float r[8];
#pragma unroll
                for (int n = 0; n < 2; ++n)
#pragma unroll
                    for (int j = 0; j < 4; ++j) { const float a = acc[ai][0][m][n][j] * sin, b = acc[ai][1][m][n][j] * sin; r[n * 4 + j] = a * b * __builtin_amdgcn_rcpf(1.0f + __expf(-a)); }
                u32x4 w; w.x = pk2(r[0], r[1]); w.y = pk2(r[2], r[3]); w.z = pk2(r[4], r[5]); w.w = pk2(r[6], r[7]);
                *(u32x4*)rowp = w; }
    }
};
struct EpiGatedF8 {
    static constexpr bool PERM = true;
    unsigned char* O; int ldc; float sin, sout; int frames = 0;
    __device__ __forceinline__ void operator()(const f32x4 (&acc)[2][2][4][2], const Unit& u, int wr, int wc, int fr, int fq) const {
        const int row0 = (frames ? frame_row0(u.pm) : u.pm * BM) + wr * 64 + fr, col0 = u.pn * HALF + wc * 32 + 8 * fq;
        const float sb = sin * sout;
#pragma unroll
        for (int ai = 0; ai < 2; ++ai)
#pragma unroll
            for (int m = 0; m < 4; ++m) { unsigned char* rowp = O + (size_t)(row0 + ai * HALF + m * 16) * ldc + col0;
                float r[8];
#pragma unroll
                for (int n = 0; n < 2; ++n)
#pragma unroll
                    for (int j = 0; j < 4; ++j) { const float a = acc[ai][0][m][n][j] * sin, b = acc[ai][1][m][n][j] * sb; r[n * 4 + j] = a * b * __builtin_amdgcn_rcpf(1.0f + __expf(-a)); }
                u32x2 w; w.x = pk4_f8(r[0], r[1], r[2], r[3]); w.y = pk4_f8(r[4], r[5], r[6], r[7]);
                *(u32x2*)rowp = w; }
    }
};
struct EpiResBf16 {
    static constexpr bool PERM = true;
    bf16_t* C; const bf16_t* H; int ldc; float alpha; int frames = 0;
    __device__ __forceinline__ void operator()(const f32x4 (&acc)[2][2][4][2], const Unit& u, int wr, int wc, int fr, int fq) const {
        const int row0 = (frames ? frame_row0(u.pm) : u.pm * BM) + wr * 64 + fr, col0 = u.pn * BM + wc * 32 + 8 * fq;
#pragma unroll
        for (int ai = 0; ai < 2; ++ai)
#pragma unroll
            for (int m = 0; m < 4; ++m) { const size_t off = (size_t)(row0 + ai * HALF + m * 16) * ldc + col0;
#pragma unroll
                for (int bj = 0; bj < 2; ++bj) { const u32x4 hv = *(const u32x4*)(H + off + bj * HALF); const f32x4 v0 = acc[ai][bj][m][0], v1 = acc[ai][bj][m][1];
                    u32x4 w; w.x = pk2(alpha * bflo(hv.x) + v0[0], alpha * bfhi(hv.x) + v0[1]); w.y = pk2(alpha * bflo(hv.y) + v0[2], alpha * bfhi(hv.y) + v0[3]);
                    w.z = pk2(alpha * bflo(hv.z) + v1[0], alpha * bfhi(hv.z) + v1[1]); w.w = pk2(alpha * bflo(hv.w) + v1[2], alpha * bfhi(hv.w) + v1[3]);
                    *(u32x4*)(C + off + bj * HALF) = w; } }
    }
};


template <int MODE> struct SkOp;
template <> struct SkOp<0> { typedef bf16x8 T; static constexpr int OPB = 16, UN = 8; };
template <> struct SkOp<1> { typedef i32x8v T; static constexpr int OPB = 32, UN = 6; };
template <> struct SkOp<2> { typedef i32x4v T; static constexpr int OPB = 16, UN = 4; };
__device__ __forceinline__ void skmma(f32x4& acc, const bf16x8& b, const bf16x8& a) { acc = __builtin_amdgcn_mfma_f32_16x16x32_bf16(b, a, acc, 0, 0, 0); }
__device__ __forceinline__ void skmma(f32x4& acc, const i32x8v& b, const i32x8v& a) { acc = __builtin_amdgcn_mfma_scale_f32_16x16x128_f8f6f4(b, a, acc, 0, 0, 0, 0, 0, 0); }
__device__ __forceinline__ void skmma(f32x4& acc, const i32x4v& b, const i32x4v& a) { acc = __builtin_bit_cast(f32x4, __builtin_amdgcn_mfma_i32_16x16x64_i8(b, a, __builtin_bit_cast(i32x4v, acc), 0, 0, 0)); }
template <int MODE, int NF, class BRows, class Fin>
__device__ __forceinline__ void skinny_phase(LAS unsigned char* lds, int bid, int G, int wave, int lane, const unsigned char* A, size_t pitch, int kbytes, int nunits, const BRows& brows, const Fin& fin) {
    typedef typename SkOp<MODE>::T T; constexpr int OPB = SkOp<MODE>::OPB, UN = SkOp<MODE>::UN, STEPB = 4 * OPB;
    const int fr = lane & 15, fq = lane >> 4, steps = kbytes / STEPB;
    const unsigned char* a0 = A + (size_t)fr * pitch + fq * OPB; const unsigned char* a1 = A + (size_t)(LP + fr) * pitch + fq * OPB;
    LAS f32x4* red = (LAS f32x4*)lds;
    for (int u = bid; u < nunits; u += G) {
        const unsigned char* bp[NF];
#pragma unroll
        for (int f = 0; f < NF; ++f) bp[f] = brows(u, f) + (size_t)fr * kbytes + fq * OPB;
        f32x4 acc[NF][2];
#pragma unroll
        for (int f = 0; f < NF; ++f) { acc[f][0] = (f32x4){0.f, 0.f, 0.f, 0.f}; acc[f][1] = (f32x4){0.f, 0.f, 0.f, 0.f}; }
        for (int s0 = wave * UN; s0 < steps; s0 += 8 * UN) {
            T av0[UN], av1[UN], bv[NF][UN];
#pragma unroll
            for (int q = 0; q < UN; ++q) { const int s = (s0 + q < steps) ? s0 + q : s0; const size_t off = (size_t)s * STEPB; av0[q] = *(const T*)(a0 + off); av1[q] = *(const T*)(a1 + off);
#pragma unroll
                for (int f = 0; f < NF; ++f) bv[f][q] = *(const T*)(bp[f] + off); }
#pragma unroll
            for (int q = 0; q < UN; ++q) if (s0 + q < steps) {
#pragma unroll
                for (int f = 0; f < NF; ++f) { skmma(acc[f][0], bv[f][q], av0[q]); skmma(acc[f][1], bv[f][q], av1[q]); } }
        }
#pragma unroll
        for (int f = 0; f < NF; ++f)
#pragma unroll
            for (int b = 0; b < 2; ++b) { f32x4 v = acc[f][b];
                if (MODE == 2) {
#pragma unroll
                    for (int j = 0; j < 4; ++j) v[j] = (float)__float_as_int(v[j]); }
                red[(wave * (NF * 2) + f * 2 + b) * 64 + lane] = v; }
        __syncthreads();
        if (wave < NF) {
            f32x4 sum[2];
#pragma unroll
            for (int b = 0; b < 2; ++b) { f32x4 v = red[(wave * 2 + b) * 64 + lane];
#pragma unroll
                for (int w = 1; w < 8; ++w) v += red[(w * (NF * 2) + wave * 2 + b) * 64 + lane];
                sum[b] = v; }
            fin(u * NF + wave, sum, red, fr, fq);
        }
        __syncthreads();
    }
}
struct SkRowsLin { const unsigned char* Bt; int kbytes; int nf; __device__ __forceinline__ const unsigned char* operator()(int u, int f) const { return Bt + (size_t)(u * nf + f) * 16 * kbytes; } };
struct SkRowsGated { const unsigned char* Bt; int kbytes;
    __device__ __forceinline__ const unsigned char* operator()(int u, int f) const { const int j0 = 16 * (u * 2 + (f >> 1)); return Bt + (size_t)((j0 >> 7) * 256 + (j0 & 127) + 128 * (f & 1)) * kbytes; } };
struct SkFinBf16 { bf16_t* O; int ldc;
    __device__ __forceinline__ void operator()(int c, const f32x4 (&s)[2], LAS f32x4*, int fr, int fq) const {
#pragma unroll
        for (int b = 0; b < 2; ++b) *(u32x2*)(O + (size_t)(b * LP + fr) * ldc + 16 * c + 4 * fq) = (u32x2){pk2(s[b][0], s[b][1]), pk2(s[b][2], s[b][3])}; } };
struct SkFinRes { bf16_t* C; const bf16_t* H; int ldc; float alpha, scale;
    __device__ __forceinline__ void operator()(int c, const f32x4 (&s)[2], LAS f32x4*, int fr, int fq) const {
#pragma unroll
        for (int b = 0; b < 2; ++b) { const size_t off = (size_t)(b * LP + fr) * ldc + 16 * c + 4 * fq; const u32x2 hv = *(const u32x2*)(H + off);
            *(u32x2*)(C + off) = (u32x2){pk2(alpha * bflo(hv.x) + scale * s[b][0], alpha * bfhi(hv.x) + scale * s[b][1]), pk2(alpha * bflo(hv.y) + scale * s[b][2], alpha * bfhi(hv.y) + scale * s[b][3])}; } } };
template <bool OUTF8> struct SkFinGated { unsigned char* O; int ldc; float sin, sout;
    __device__ __forceinline__ void operator()(int c, const f32x4 (&s)[2], LAS f32x4* red, int fr, int fq) const {
        if (c & 1) return;
        const int lane = fq * 16 + fr, f1 = (c & 3) + 1;
#pragma unroll
        for (int b = 0; b < 2; ++b) { f32x4 g4 = red[(f1 * 2 + b) * 64 + lane];
#pragma unroll
            for (int w = 1; w < 8; ++w) g4 += red[(w * 8 + f1 * 2 + b) * 64 + lane];
            float r[4];
#pragma unroll
            for (int j = 0; j < 4; ++j) { const float a = s[b][j] * sin, g = g4[j] * sin; r[j] = a * g * __builtin_amdgcn_rcpf(1.0f + __expf(-a)); }
            const size_t off = (size_t)(b * LP + fr) * ldc + 16 * (c >> 1) + 4 * fq;
            if (OUTF8) *(unsigned*)(O + off) = pk4_f8(r[0] * sout, r[1] * sout, r[2] * sout, r[3] * sout);
            else *(u32x2*)((bf16_t*)O + off) = (u32x2){pk2(r[0], r[1]), pk2(r[2], r[3])}; } } };

template <int MODE> struct Frag;
template <> struct Frag<0> { bf16x8 v[2]; };
template <> struct Frag<1> { i32x8v v; };
template <> struct Frag<2> { i32x4v v[2]; };
__device__ __forceinline__ void ldfrag(Frag<0>& f, const LAS unsigned char* p) { f.v[0] = *(const LAS bf16x8*)p; f.v[1] = *(const LAS bf16x8*)(p + 1024); }
__device__ __forceinline__ void ldfrag(Frag<1>& f, const LAS unsigned char* p) { const i32x4v a = *(const LAS i32x4v*)p, b = *(const LAS i32x4v*)(p + 1024); f.v = __builtin_shufflevector(a, b, 0, 1, 2, 3, 4, 5, 6, 7); }
__device__ __forceinline__ void ldfrag(Frag<2>& f, const LAS unsigned char* p) { f.v[0] = *(const LAS i32x4v*)p; f.v[1] = *(const LAS i32x4v*)(p + 1024); }
__device__ __forceinline__ void mmafrag(f32x4& acc, const Frag<0>& b, const Frag<0>& a) { acc = __builtin_amdgcn_mfma_f32_16x16x32_bf16(b.v[0], a.v[0], acc, 0, 0, 0); acc = __builtin_amdgcn_mfma_f32_16x16x32_bf16(b.v[1], a.v[1], acc, 0, 0, 0); }
__device__ __forceinline__ void mmafrag(f32x4& acc, const Frag<1>& b, const Frag<1>& a) { acc = __builtin_amdgcn_mfma_scale_f32_16x16x128_f8f6f4(b.v, a.v, acc, 0, 0, 0, 0, 0, 0); }
__device__ __forceinline__ void mmafrag(f32x4& acc, const Frag<2>& b, const Frag<2>& a) {
    i32x4v c = __builtin_bit_cast(i32x4v, acc); c = __builtin_amdgcn_mfma_i32_16x16x64_i8(b.v[0], a.v[0], c, 0, 0, 0); c = __builtin_amdgcn_mfma_i32_16x16x64_i8(b.v[1], a.v[1], c, 0, 0, 0); acc = __builtin_bit_cast(f32x4, c); }
template <class Epi, class Prov, int MODE = 0>
__device__ __forceinline__ void gemm_phase(LAS unsigned char* lds, const char* Abase, const int K, const Prov& S, const Epi& E) {
    constexpr bool F8 = (MODE == 1);
    const int tid = threadIdx.x, wid = __builtin_amdgcn_readfirstlane(tid >> 6), lane = tid & 63, wr = wid >> 2, wc = wid & 3, fr = lane & 15, fq = lane >> 4;
    const int nt = K / BK;
    int RA[2], CA[2]; unsigned voffB[2];
#pragma unroll
    for (int i = 0; i < 2; ++i) { int R, C; stage_rc(tid * 16 + i * 8192, R, C); const int Rb = Epi::PERM ? ((R & ~31) + perm32(R & 31)) : R;
        RA[i] = R; CA[i] = C; voffB[i] = (unsigned)(Rb * K + C) * 2u; }
    const size_t kstep = (size_t)(BK * 2);
    const size_t hstep = (size_t)HALF * K * 2;
    const unsigned ldsw = (unsigned)wid * 1024u;
    const unsigned ldsb = (unsigned)(size_t)lds + ldsw;
    const int aoff = lds_byte(wr * 64 + fr, fq * 8), boff = lds_byte(wc * 32 + fr, fq * 8);
#define PG8_SA(b, h) (((b) * 2 + (h)) * HTB)
#define PG8_SB(b, h) ((4 + (b) * 2 + (h)) * HTB)
#define PG8_STAGE(bufoff, gbase, voff) do { _Pragma("unroll") for (int _i = 0; _i < 2; ++_i) { \
        if (F8) asm volatile("s_mov_b32 m0, %0\n\ts_nop 0\n\tglobal_load_lds_dwordx4 %1, %2" :: "s"(ldsb + (unsigned)((bufoff) + _i * 8192)), "v"((voff)[_i]), "s"((const char*)(gbase)) : "memory", "m0"); \
        else __builtin_amdgcn_global_load_lds((const unsigned*)((const char*)(gbase) + (voff)[_i]), (LAS unsigned*)(lds + (bufoff) + ldsw + _i * 8192), 16, 0, 0); } } while (0)
#define PG8_LDA(dst, b, h) do { _Pragma("unroll") for (int m = 0; m < 4; ++m) ldfrag(dst[m], lds + PG8_SA(b, h) + aoff + m * 2048); } while (0)
#define PG8_LDB(dst, b, h) do { _Pragma("unroll") for (int n = 0; n < 2; ++n) ldfrag(dst[n], lds + PG8_SB(b, h) + boff + n * 2048); } while (0)
#define PG8_MMA(ai, bj, At, Bt) do { __builtin_amdgcn_s_setprio(1); _Pragma("unroll") for (int m = 0; m < 4; ++m) _Pragma("unroll") for (int n = 0; n < 2; ++n) { \
        if (F8) { f32x4 c_; _Pragma("unroll") for (int j_ = 0; j_ < 4; ++j_) c_[j_] = acc16[ai][bj][m >> 1][8 * (m & 1) + 4 * n + j_]; mmafrag(c_, Bt[n], At[m]); \
                  _Pragma("unroll") for (int j_ = 0; j_ < 4; ++j_) acc16[ai][bj][m >> 1][8 * (m & 1) + 4 * n + j_] = c_[j_]; } \
        else mmafrag(acc[ai][bj][m][n], Bt[n], At[m]); } __builtin_amdgcn_s_setprio(0); } while (0)
#define PG8_WAIT_V(n) asm volatile("s_waitcnt vmcnt(" #n ")" ::: "memory")
#define PG8_WAIT_L(n) asm volatile("s_waitcnt lgkmcnt(" #n ")" ::: "memory")
#define PG8_BAR __builtin_amdgcn_s_barrier()
#define PG8_SCHED __builtin_amdgcn_sched_barrier(0)
    Unit cur, nxt; int ui = 0;
    if (!S.next(0, cur)) return;
    f32x4 acc[2][2][4][2];
    f32x16 acc16[2][2][2];
#pragma unroll
    for (int a = 0; a < 2; ++a)
#pragma unroll
        for (int b = 0; b < 2; ++b)
#pragma unroll
            for (int q = 0; q < 2; ++q)
#pragma unroll
                for (int j = 0; j < 16; ++j) acc16[a][b][q][j] = 0.f;
#pragma unroll
    for (int a = 0; a < 2; ++a)
#pragma unroll
        for (int b = 0; b < 2; ++b)
#pragma unroll
            for (int m = 0; m < 4; ++m)
#pragma unroll
                for (int n = 0; n < 2; ++n) acc[a][b][m][n] = (f32x4){0.f, 0.f, 0.f, 0.f};
    Frag<MODE> At[4], B0[2], B1[2];
    unsigned vAc[2][2], vAn[2][2];
    S.aoffs(cur, RA, CA, vAc);
    const char* cB = S.bbase(cur);
    const char* A0 = Abase;
    PG8_STAGE(PG8_SB(0, 0), cB, voffB); PG8_STAGE(PG8_SA(0, 0), A0, vAc[0]); PG8_STAGE(PG8_SB(0, 1), cB + hstep, voffB); PG8_STAGE(PG8_SA(0, 1), A0, vAc[1]);
    if (wr == 1) PG8_BAR;
    PG8_WAIT_V(4); PG8_BAR;
    PG8_STAGE(PG8_SB(1, 0), cB + kstep, voffB); PG8_STAGE(PG8_SA(1, 0), A0 + kstep, vAc[0]); PG8_STAGE(PG8_SB(1, 1), cB + hstep + kstep, voffB);
    PG8_WAIT_V(6); PG8_BAR;
    for (;;) {
        const bool has_next = S.next(ui + 1, nxt);
        const char* nB = cB;
        if (has_next) { S.aoffs(nxt, RA, CA, vAn); nB = S.bbase(nxt); }
        else {
#pragma unroll
            for (int h = 0; h < 2; ++h)
#pragma unroll
                for (int i = 0; i < 2; ++i) vAn[h][i] = vAc[h][i];
        }
        for (int t = 0; t < nt; t += 2) {
            const bool last = (t == nt - 2);
            const char* a1 = A0 + (size_t)(t + 1) * kstep;
            const char* a2 = last ? A0 : A0 + (size_t)(t + 2) * kstep; const char* b2 = last ? nB : cB + (size_t)(t + 2) * kstep;
            const char* a3 = a2 + kstep; const char* b3 = b2 + kstep;
            unsigned v2[2][2];
#pragma unroll
            for (int h = 0; h < 2; ++h)
#pragma unroll
                for (int i = 0; i < 2; ++i) v2[h][i] = last ? vAn[h][i] : vAc[h][i];
            PG8_LDB(B0, 0, 0); PG8_SCHED; PG8_LDA(At, 0, 0); PG8_STAGE(PG8_SA(1, 1), a1, vAc[1]);
            PG8_WAIT_L(8); PG8_BAR; PG8_WAIT_L(0); PG8_MMA(0, 0, At, B0); PG8_BAR; PG8_SCHED;
            PG8_LDB(B1, 0, 1); PG8_STAGE(PG8_SB(0, 0), b2, voffB);
            PG8_BAR; PG8_WAIT_L(0); PG8_MMA(0, 1, At, B1); PG8_BAR;
            PG8_LDA(At, 0, 1); PG8_STAGE(PG8_SA(0, 0), a2, v2[0]);
            PG8_BAR; PG8_WAIT_L(0); PG8_MMA(1, 0, At, B0); PG8_BAR; PG8_SCHED;
            PG8_STAGE(PG8_SB(0, 1), b2 + hstep, voffB);
            PG8_WAIT_V(6); PG8_BAR; PG8_MMA(1, 1, At, B1); PG8_BAR;
            PG8_LDB(B0, 1, 0); PG8_SCHED; PG8_LDA(At, 1, 0); PG8_STAGE(PG8_SA(0, 1), a2, v2[1]);
            PG8_WAIT_L(8); PG8_BAR; PG8_WAIT_L(0); PG8_MMA(0, 0, At, B0); PG8_BAR; PG8_SCHED;
            PG8_LDB(B1, 1, 1); PG8_STAGE(PG8_SB(1, 0), b3, voffB);
            PG8_BAR; PG8_WAIT_L(0); PG8_MMA(0, 1, At, B1); PG8_BAR;
            PG8_LDA(At, 1, 1); PG8_STAGE(PG8_SA(1, 0), a3, v2[0]);
            PG8_BAR; PG8_WAIT_L(0); PG8_MMA(1, 0, At, B0); PG8_BAR; PG8_SCHED;
            PG8_STAGE(PG8_SB(1, 1), b3 + hstep, voffB);
            PG8_WAIT_V(6); PG8_BAR; PG8_MMA(1, 1, At, B1); PG8_BAR;
        }
        if (F8) {
#pragma unroll
            for (int a = 0; a < 2; ++a)
#pragma unroll
                for (int b = 0; b < 2; ++b)
#pragma unroll
                    for (int m = 0; m < 4; ++m)
#pragma unroll
                        for (int n = 0; n < 2; ++n)
#pragma unroll
                            for (int j = 0; j < 4; ++j) { acc[a][b][m][n][j] = acc16[a][b][m >> 1][8 * (m & 1) + 4 * n + j]; acc16[a][b][m >> 1][8 * (m & 1) + 4 * n + j] = 0.f; }
        }
        if (MODE == 2) {
#pragma unroll
            for (int a = 0; a < 2; ++a)
#pragma unroll
                for (int b = 0; b < 2; ++b)
#pragma unroll
                    for (int m = 0; m < 4; ++m)
#pragma unroll
                        for (int n = 0; n < 2; ++n)
#pragma unroll
                            for (int j = 0; j < 4; ++j) acc[a][b][m][n][j] = (float)__float_as_int(acc[a][b][m][n][j]);
        }
        E(acc, cur, wr, wc, fr, fq);
        if (!has_next) break;
#pragma unroll
        for (int a = 0; a < 2; ++a)
#pragma unroll
            for (int b = 0; b < 2; ++b)
#pragma unroll
                for (int m = 0; m < 4; ++m)
#pragma unroll
                    for (int n = 0; n < 2; ++n) acc[a][b][m][n] = (f32x4){0.f, 0.f, 0.f, 0.f};
        cur = nxt; cB = nB; ++ui;
#pragma unroll
        for (int h = 0; h < 2; ++h)
#pragma unroll
            for (int i = 0; i < 2; ++i) vAc[h][i] = vAn[h][i];
    }
    PG8_WAIT_V(0);
    if (wr == 0) PG8_BAR;
    PG8_BAR;
#undef PG8_SA
#undef PG8_SB
#undef PG8_STAGE
#undef PG8_LDA
#undef PG8_LDB
#undef PG8_MMA
#undef PG8_WAIT_V
#undef PG8_WAIT_L
#undef PG8_BAR
#undef PG8_SCHED
}
}
struct Frame {
    LAS unsigned char* lds;
    unsigned* ctl;
    unsigned char* ws;
    const float* in[35];
    float* out;
    int tid, lane, wave, G, bid;
};
enum { I_X = 0, I_META, I_WINE, I_CONVW, I_ARE, I_AIM, I_LOGDT, I_BRE, I_BIM, I_CRE, I_CIM, I_S5D, I_WGLU, I_WOUTE, I_LN1G, I_LN1B, I_W1, I_W3, I_W2, I_LN2G, I_LN2B,
       I_WINO, I_MBI, I_MBF, I_RELB, I_WOUTO, I_LN3G, I_LN3B, I_RW, I_RB, I_EW1, I_EW3, I_EW2, I_LN4G, I_LN4B };

struct SrcRef { const float* p; int col; float sc; };
template <class F> __device__ __forceinline__ void transpose_item(const F& f, int ldw, bf16_t* dst, int Kd, int k0, int n0, LAS float* scr, int lane) {
    const SrcRef s = f(n0 + (lane & 31));
#pragma unroll 8
    for (int i = 0; i < 32; ++i) { const int kk = 2 * i + (lane >> 5); scr[kk * 33 + (lane & 31)] = s.p[(size_t)(k0 + kk) * ldw + s.col] * s.sc; }
    LDS_WAIT();
    const int c = lane & 7;
#pragma unroll
    for (int j = 0; j < 4; ++j) { const int n = (lane >> 3) + 8 * j; const LAS float* sp = scr + (8 * c) * 33 + n;
        u32x4 o; o.x = pk2(sp[0 * 33], sp[1 * 33]); o.y = pk2(sp[2 * 33], sp[3 * 33]); o.z = pk2(sp[4 * 33], sp[5 * 33]); o.w = pk2(sp[6 * 33], sp[7 * 33]);
        *(u32x4*)(dst + (size_t)(n0 + n) * Kd + k0 + 8 * c) = o; }
    LDS_WAIT();
}
#define PK4(a, b, c, d) (I8 ? pk4_i8(a, b, c, d) : pk4_f8(a, b, c, d))
template <bool I8, class F> __device__ __forceinline__ void transpose_item_f8(const F& f, int ldw, unsigned char* dst, int Kd, int k0, int n0, float scale, LAS float* scr, int lane) {
    const SrcRef s = f(n0 + (lane & 31));
#pragma unroll 8
    for (int i = 0; i < 32; ++i) { const int kk = 2 * i + (lane >> 5); scr[kk * 33 + (lane & 31)] = s.p[(size_t)(k0 + kk) * ldw + s.col] * (s.sc * scale); }
    LDS_WAIT();
    const int c = lane & 3;
#pragma unroll
    for (int j = 0; j < 2; ++j) { const int n = (lane >> 2) + 16 * j; const LAS float* sp = scr + (16 * c) * 33 + n;
        u32x4 o; o.x = PK4(sp[0 * 33], sp[1 * 33], sp[2 * 33], sp[3 * 33]); o.y = PK4(sp[4 * 33], sp[5 * 33], sp[6 * 33], sp[7 * 33]);
        o.z = PK4(sp[8 * 33], sp[9 * 33], sp[10 * 33], sp[11 * 33]); o.w = PK4(sp[12 * 33], sp[13 * 33], sp[14 * 33], sp[15 * 33]);
        *(u32x4*)(dst + (size_t)(n0 + n) * Kd + k0 + 16 * c) = o; }
    LDS_WAIT();
}
#undef PK4
struct MapIdent { const float* w; __device__ __forceinline__ SrcRef operator()(int n) const { return SrcRef{w, n, 1.f}; } };
struct MapGated { const float* w1; const float* w3; __device__ __forceinline__ SrcRef operator()(int n) const { const int t = n >> 8, r = n & 255; return r < 128 ? SrcRef{w1, t * 128 + r, 1.f} : SrcRef{w3, t * 128 + r - 128, 1.f}; } };
struct MapOddA { const float* w; __device__ __forceinline__ SrcRef operator()(int n) const {
    int c;
    if (n < 1024) c = n;
    else if (n < 2048) c = 3072 + (n - 1024);
    else if (n < 3072) c = 4104 + (n - 2048);
    else if (n < 4096) c = 5128 + (n - 3072);
    else if (n < 4608) c = 7176 + (n - 4096);
    else if (n < 4672) c = 7688 + (n - 4608);
    else if (n < 4676) c = 4096 + (n - 4672);
    else if (n < 4680) c = 4100 + (n - 4676);
    else if (n < 4688) c = 7752 + (n - 4680);
    else return SrcRef{w, 0, 0.f};
    return SrcRef{w, c, 1.f}; } };
struct MapOddB { const float* w; __device__ __forceinline__ SrcRef operator()(int n) const {
    int c;
    if (n < 1024) c = 1024 + n;
    else if (n < 2048) c = 2048 + (n - 1024);
    else c = 6152 + (n - 2048);
    return SrcRef{w, c, 1.f}; } };

__device__ __forceinline__ void p0_prologue(Frame& F) {
    LAS float* scr = (LAS float*)(F.lds + F.wave * 16384);
    const int gw = F.bid * NWAVES + F.wave, NGW = F.G * NWAVES;
    bf16_t* WINE = (bf16_t*)(F.ws + WS_WINE); bf16_t* WOUTE = (bf16_t*)(F.ws + WS_WOUTE);
    bf16_t* WINOA = (bf16_t*)(F.ws + WS_WINOA); bf16_t* WINOB = (bf16_t*)(F.ws + WS_WINOB); bf16_t* WOUTO = (bf16_t*)(F.ws + WS_WOUTO);
    constexpr int I1 = (NIN_E / 32) * (D / 64), I2 = (D / 32) * (D / 64), I3 = (N13 / 32) * (D / 64), I4 = (D / 32) * (DFF / 64), I5 = (NIN_OA / 32) * (D / 64), I6 = (NIN_OB / 32) * (D / 64), I7 = I2;
    constexpr int NITEMS = I1 + I2 + I3 + I4 + I5 + I6 + I7;
    for (int it = gw; it < NITEMS; it += NGW) {
        int r = it;
        if (r < I1) { const int nb = NIN_E / 32; transpose_item(MapIdent{F.in[I_WINE]}, NIN_E, WINE, D, (r / nb) * 64, (r % nb) * 32, scr, F.lane); continue; } r -= I1;
        if (r < I2) { const int nb = D / 32; transpose_item(MapIdent{F.in[I_WOUTE]}, D, WOUTE, D, (r / nb) * 64, (r % nb) * 32, scr, F.lane); continue; } r -= I2;
        if (r < I3) { const int nb = N13 / 32; transpose_item_f8<true>(MapGated{F.in[I_W1], F.in[I_W3]}, DFF, F.ws + WS_W13, D, (r / nb) * 64, (r % nb) * 32, I8S_W13, scr, F.lane); continue; } r -= I3;
        if (r < I4) { const int nb = D / 32;
#if FFN_DOWN_F8
            transpose_item_f8<false>(MapIdent{F.in[I_W2]}, D, F.ws + WS_W2, DFF, (r / nb) * 64, (r % nb) * 32, F8S_W2, scr, F.lane);
#else
            transpose_item(MapIdent{F.in[I_W2]}, D, (bf16_t*)(F.ws + WS_W2), DFF, (r / nb) * 64, (r % nb) * 32, scr, F.lane);
#endif
            continue; } r -= I4;
        if (r < I5) { const int nb = NIN_OA / 32; transpose_item(MapOddA{F.in[I_WINO]}, 7760, WINOA, D, (r / nb) * 64, (r % nb) * 32, scr, F.lane); continue; } r -= I5;
        if (r < I6) { const int nb = NIN_OB / 32; transpose_item(MapOddB{F.in[I_WINO]}, 7760, WINOB, D, (r / nb) * 64, (r % nb) * 32, scr, F.lane); continue; } r -= I6;
#if OUT1_F8
        { const int nb = D / 32; transpose_item_f8<false>(MapIdent{F.in[I_WOUTO]}, D, F.ws + WS_WOUTO, D, (r / nb) * 64, (r % nb) * 32, F8S_WOUT, scr, F.lane); }
#else
        { const int nb = D / 32; transpose_item(MapIdent{F.in[I_WOUTO]}, D, WOUTO, D, (r / nb) * 64, (r % nb) * 32, scr, F.lane); }
#endif
    }
    bf16_t* HA = (bf16_t*)(F.ws + WS_HA);
    const size_t gt = (size_t)F.bid * NTHREADS + F.tid, NGT = (size_t)F.G * NTHREADS;
    for (size_t e = gt; e < (size_t)M * (D / 8); e += NGT) {
        const int r = (int)(e / (D / 8)), c = (int)(e % (D / 8)) * 8, b = r / LP, pos = r % LP;
        u32x4 o = (u32x4){0u, 0u, 0u, 0u};
        if (pos < LR) { const float* src = pos < NMETA ? F.in[I_META] + (size_t)pos * D + c : F.in[I_X] + ((size_t)b * SEQ + (pos - NMETA)) * D + c;
            const f32x4 v0 = *(const f32x4*)src, v1 = *(const f32x4*)(src + 4);
            o.x = pk2(v0[0], v0[1]); o.y = pk2(v0[2], v0[3]); o.z = pk2(v1[0], v1[1]); o.w = pk2(v1[2], v1[3]); }
        *(u32x4*)(HA + (size_t)r * D + c) = o;
    }
    if (gt < 2048) {
        const int gp = (int)gt, g = gp >> 6;
        const double are = F.in[I_ARE][gp], aim = F.in[I_AIM][gp], dt = exp((double)F.in[I_LOGDT][g]);
        const double er = exp(dt * are), abr = er * cos(dt * aim), abi = er * sin(dt * aim);
        const double erp = exp(S5CH * dt * are), apr = erp * cos(S5CH * dt * aim), api = erp * sin(S5CH * dt * aim);
        const double nr = abr - 1.0, ni = abi, den = are * are + aim * aim;
        const double qr = (nr * are + ni * aim) / den, qi = (ni * are - nr * aim) / den;
        float* T = (float*)(F.ws + WS_S5T);
        T[gp * 2 + 0] = (float)abr; T[gp * 2 + 1] = (float)abi;
        T[4096 + gp * 2 + 0] = (float)apr; T[4096 + gp * 2 + 1] = (float)api;
        float* BB = T + 8192 + gp * 32;
        for (int c = 0; c < 16; ++c) { const double br = F.in[I_BRE][gp * 16 + c], bi = F.in[I_BIM][gp * 16 + c];
            BB[2 * c + 0] = (float)(qr * br - qi * bi); BB[2 * c + 1] = (float)(qr * bi + qi * br); }
        float* PW = T + 73728 + gp * 18;
        double pr = 1.0, pi = 0.0;
        for (int tau = 0; tau <= 8; ++tau) { PW[2 * tau] = (float)pr; PW[2 * tau + 1] = (float)pi; const double nr2 = pr * abr - pi * abi, ni2 = pr * abi + pi * abr; pr = nr2; pi = ni2; }
    }
}

template <class F> __device__ __forceinline__ void transpose_item32(const F& f, int ldw, bf16_t* dst, int Kd, int k0, int n0, LAS float* scr, int lane) {
    const SrcRef s = f(n0 + (lane & 31));
#pragma unroll 8
    for (int i = 0; i < 16; ++i) { const int kk = 2 * i + (lane >> 5); scr[kk * 33 + (lane & 31)] = s.p[(size_t)(k0 + kk) * ldw + s.col] * s.sc; }
    LDS_WAIT();
    const int c = lane & 3;
#pragma unroll
    for (int j = 0; j < 2; ++j) { const int n = (lane >> 2) + 16 * j; const LAS float* sp = scr + (8 * c) * 33 + n;
        u32x4 o; o.x = pk2(sp[0 * 33], sp[1 * 33]); o.y = pk2(sp[2 * 33], sp[3 * 33]); o.z = pk2(sp[4 * 33], sp[5 * 33]); o.w = pk2(sp[6 * 33], sp[7 * 33]);
        *(u32x4*)(dst + (size_t)(n0 + n) * Kd + k0 + 8 * c) = o; }
    LDS_WAIT();
}
template <class F> __device__ __forceinline__ void transpose_item32_f8(const F& f, int ldw, unsigned char* dst, int Kd, int k0, int n0, float scale, LAS float* scr, int lane) {
    const SrcRef s = f(n0 + (lane & 31));
#pragma unroll 8
    for (int i = 0; i < 16; ++i) { const int kk = 2 * i + (lane >> 5); scr[kk * 33 + (lane & 31)] = s.p[(size_t)(k0 + kk) * ldw + s.col] * (s.sc * scale); }
    LDS_WAIT();
    const int c = lane & 1, n = lane >> 1; const LAS float* sp = scr + (16 * c) * 33 + n;
    u32x4 o; o.x = pk4_f8(sp[0 * 33], sp[1 * 33], sp[2 * 33], sp[3 * 33]); o.y = pk4_f8(sp[4 * 33], sp[5 * 33], sp[6 * 33], sp[7 * 33]);
    o.z = pk4_f8(sp[8 * 33], sp[9 * 33], sp[10 * 33], sp[11 * 33]); o.w = pk4_f8(sp[12 * 33], sp[13 * 33], sp[14 * 33], sp[15 * 33]);
    *(u32x4*)(dst + (size_t)(n0 + n) * Kd + k0 + 16 * c) = o;
    LDS_WAIT();
}
__device__ __forceinline__ void convert_experts(Frame& F) {
    LAS float* scr = (LAS float*)(F.lds + 4 * D1_WAVE_BYTES + (F.wave - 4) * 4352);
    const int gw = F.bid * 4 + (F.wave - 4), NGW = F.G * 4;
    constexpr int J1 = (N13 / 32) * (D / 32), J2 = (D / 32) * (DFF / 32);
    for (int it = gw; it < NEXP * (J1 + J2); it += NGW) {
        const int e = it / (J1 + J2); int r = it % (J1 + J2);
        if (r < J1) { const int nb = N13 / 32; transpose_item32_f8(MapGated{F.in[I_EW1] + (size_t)e * D * DFF, F.in[I_EW3] + (size_t)e * D * DFF}, DFF, F.ws + WS_EW13 + (size_t)e * N13 * D, D, (r / nb) * 32, (r % nb) * 32, F8S_W13, scr, F.lane); }
        else { r -= J1; const int nb = D / 32; transpose_item32_f8(MapIdent{F.in[I_EW2] + (size_t)e * DFF * D}, D, F.ws + WS_EW2 + (size_t)e * D * DFF, DFF, (r / nb) * 32, (r % nb) * 32, F8S_W2, scr, F.lane); }
    }
}

__device__ __forceinline__ void cvt8(const u32x4 w, float (&f)[8]) { f[0] = bflo(w.x); f[1] = bfhi(w.x); f[2] = bflo(w.y); f[3] = bfhi(w.y); f[4] = bflo(w.z); f[5] = bfhi(w.z); f[6] = bflo(w.w); f[7] = bfhi(w.w); }
__device__ __forceinline__ void conv_phase(Frame& F, int wg0, int nwg) {
    const bf16_t* P = (const bf16_t*)(F.ws + WS_P); bf16_t* Y = (bf16_t*)(F.ws + WS_Y);
    const float* cw = F.in[I_CONVW];
    constexpr int STRIP = 16, NSTRIP = LP / STRIP, NCG = DCONV / 8;
    const int gt = (F.bid - wg0) * NTHREADS + F.tid, NGT = nwg * NTHREADS;
    for (int it = gt; it < NB * NSTRIP * NCG; it += NGT) {
        const int cg = it % NCG, sp = (it / NCG) % NSTRIP, b = it / (NCG * NSTRIP), c = cg * 8, p0 = sp * STRIP;
        float w0[8], w1[8], w2[8];
#pragma unroll
        for (int j = 0; j < 8; ++j) { w0[j] = cw[c + j]; w1[j] = cw[DCONV + c + j]; w2[j] = cw[2 * DCONV + c + j]; }
        float z1[8], z2[8];
#pragma unroll
        for (int j = 0; j < 8; ++j) { z1[j] = 0.f; z2[j] = 0.f; }
        for (int d = 2; d >= 1; --d) { const int pos = p0 - d; if (pos >= 0) { const bf16_t* row = P + (size_t)(b * LP + pos) * NIN_E;
                float cgv[8], xv[8]; cvt8(*(const u32x4*)(row + DCONV + c), cgv); cvt8(*(const u32x4*)(row + 2 * DCONV + c), xv);
#pragma unroll
                for (int j = 0; j < 8; ++j) { if (d == 2) z2[j] = cgv[j] * xv[j]; else z1[j] = cgv[j] * xv[j]; } } }
        for (int s4 = 0; s4 < STRIP; s4 += 4) {
            u32x4 rb[4], rc[4], rx[4];
#pragma unroll
            for (int q = 0; q < 4; ++q) { const bf16_t* row = P + (size_t)(b * LP + p0 + s4 + q) * NIN_E; rb[q] = *(const u32x4*)(row + c); rc[q] = *(const u32x4*)(row + DCONV + c); rx[q] = *(const u32x4*)(row + 2 * DCONV + c); }
#pragma unroll
            for (int q = 0; q < 4; ++q) { const int pos = p0 + s4 + q;
                float bg[8], cgv[8], xv[8]; cvt8(rb[q], bg); cvt8(rc[q], cgv); cvt8(rx[q], xv);
                float o[8];
#pragma unroll
                for (int j = 0; j < 8; ++j) { const float z0 = cgv[j] * xv[j]; o[j] = bg[j] * (w0[j] * z2[j] + w1[j] * z1[j] + w2[j] * z0); z2[j] = z1[j]; z1[j] = z0; }
                u32x4 w; w.x = pk2(o[0], o[1]); w.y = pk2(o[2], o[3]); w.z = pk2(o[4], o[5]); w.w = pk2(o[6], o[7]);
                *(u32x4*)(Y + (size_t)(b * LP + pos) * D + c) = w; } }
    }
}
constexpr size_t WS_MS5 = WS_XE;
__device__ __forceinline__ void s5_build_matrices(Frame& F) {
    const float* T = (const float*)(F.ws + WS_S5T); bf16_t* MS = (bf16_t*)(F.ws + WS_MS5);
    const int gt = F.bid * NTHREADS + F.tid, NGT = F.G * NTHREADS;
    for (int e = gt; e < 32 * 3 * 16384; e += NGT) {
        const int k = e & 127, r = (e >> 7) & 127, m = (e >> 14) % 3, g = e / (3 * 16384);
        const float* PW = T + 73728 + (size_t)g * 64 * 18; const float* BB = T + 8192 + (size_t)g * 64 * 32;
        float v = 0.f;
        if (m == 0) { const int t = r >> 4, c = r & 15, s = k >> 4, c2 = k & 15;
            if (s <= t) { const int tau = t - s; const float* cre = F.in[I_CRE] + ((size_t)g * 16 + c) * 64; const float* cim = F.in[I_CIM] + ((size_t)g * 16 + c) * 64;
                for (int p = 0; p < 64; ++p) { const float ar = PW[p * 18 + 2 * tau], ai = PW[p * 18 + 2 * tau + 1], br = BB[p * 32 + 2 * c2], bi = BB[p * 32 + 2 * c2 + 1];
                    const float abr_ = ar * br - ai * bi, abi_ = ar * bi + ai * br; v += cre[p] * abr_ - cim[p] * abi_; }
                if (tau == 0 && c == c2) v += F.in[I_S5D][g * 16 + c]; } }
        else if (m == 1) { const int p = r >> 1, ri = r & 1, s = k >> 4, c2 = k & 15; const int tau = 7 - s;
            const float ar = PW[p * 18 + 2 * tau], ai = PW[p * 18 + 2 * tau + 1], br = BB[p * 32 + 2 * c2], bi = BB[p * 32 + 2 * c2 + 1];
            v = ri ? (ar * bi + ai * br) : (ar * br - ai * bi); }
        else { const int t = r >> 4, c = r & 15, p = k >> 1, ri = k & 1; const int tau = t + 1;
            const float ar = PW[p * 18 + 2 * tau], ai = PW[p * 18 + 2 * tau + 1], cr = F.in[I_CRE][((size_t)g * 16 + c) * 64 + p], ci = F.in[I_CIM][((size_t)g * 16 + c) * 64 + p];
            v = ri ? -(cr * ai + ci * ar) : (cr * ar - ci * ai); }
        MS[e] = (bf16_t)f2bf(v);
    }
}
template <int CTRL> __device__ __forceinline__ float dpp_row_f(float old, float src) { return __int_as_float(__builtin_amdgcn_update_dpp(__float_as_int(old), __float_as_int(src), CTRL, 0xf, 0xf, false)); }
constexpr int S5X_ROW = 272, S5X_BUF = 16 * S5X_ROW;
template <bool SPLIT>
__device__ __forceinline__ void s5_ssd_unit(Frame& F, int b, int g, int half) {
    const bf16_t* P = (const bf16_t*)(F.ws + WS_P); bf16_t* Y = (bf16_t*)(F.ws + WS_Y);
    const float* T = (const float*)(F.ws + WS_S5T); const bf16_t* MS = (const bf16_t*)(F.ws + WS_MS5) + (size_t)g * 3 * 16384;
    const int lane = F.lane, w = F.wave, ql = lane & 15, gq = lane >> 4;
    bf16x8 A1[4], A2[4], A3[4];
#pragma unroll
    for (int ks = 0; ks < 4; ++ks) { const int off = (16 * w + ql) * 128 + 32 * ks + 8 * gq;
        A1[ks] = *(const bf16x8*)(MS + off); A2[ks] = *(const bf16x8*)(MS + 16384 + off); A3[ks] = *(const bf16x8*)(MS + 32768 + off); }
    float m1r[2], m1i[2], m2r[2], m2i[2], m4r[2], m4i[2], m8r[2], m8i[2];
#pragma unroll
    for (int j = 0; j < 2; ++j) { const float* PW = T + 73728 + ((size_t)g * 64 + 8 * w + 2 * gq + j) * 18 + 16;
        m1r[j] = PW[0]; m1i[j] = PW[1]; m2r[j] = m1r[j] * m1r[j] - m1i[j] * m1i[j]; m2i[j] = 2.f * m1r[j] * m1i[j];
        m4r[j] = m2r[j] * m2r[j] - m2i[j] * m2i[j]; m4i[j] = 2.f * m2r[j] * m2i[j]; m8r[j] = m4r[j] * m4r[j] - m4i[j] * m4i[j]; m8i[j] = 2.f * m4r[j] * m4i[j]; }
    bf16x8 Awg; { const float* wg = F.in[I_WGLU] + (size_t)g * 256 + ql * 16 + 4 * gq; u32x4 t_; t_.x = pk2(wg[0], wg[1]); t_.y = pk2(wg[2], wg[3]); t_.z = 0u; t_.w = 0u; Awg = __builtin_bit_cast(bf16x8, t_); }
    float cr[2] = {0.f, 0.f}, ci[2] = {0.f, 0.f};
    const size_t rowb = (size_t)b * LP;
    const bf16_t* ubase = P + (rowb + 8 * ql + (gq >> 1)) * NIN_E + 3 * DCONV + g * 16 + 8 * (gq & 1);
    bf16x8 Bu[4], Bn[4];
    constexpr int NCH = LP / 128, CSPLIT = 65;
    if (half) {
#pragma unroll
        for (int ks = 0; ks < 4; ++ks) Bu[ks] = *(const bf16x8*)(ubase + (size_t)(2 * ks) * NIN_E);
        for (int ch = 0; ch < CSPLIT; ++ch) {
            if (ch + 1 < CSPLIT) {
#pragma unroll
                for (int ks = 0; ks < 4; ++ks) Bn[ks] = *(const bf16x8*)(ubase + ((size_t)(ch + 1) * 128 + 2 * ks) * NIN_E); }
            f32x4 IN = (f32x4){0.f, 0.f, 0.f, 0.f};
#pragma unroll
            for (int ks = 0; ks < 4; ++ks) IN = __builtin_amdgcn_mfma_f32_16x16x32_bf16(A2[ks], Bu[ks], IN, 0, 0, 0);
            float er[2] = {IN[0], IN[2]}, ei[2] = {IN[1], IN[3]};
#pragma unroll
            for (int j = 0; j < 2; ++j) {
                if (ql == 0) { er[j] += m1r[j] * cr[j] - m1i[j] * ci[j]; ei[j] += m1r[j] * ci[j] + m1i[j] * cr[j]; }
                { const float tr = dpp_row_f<0x111>(0.f, er[j]), ti = dpp_row_f<0x111>(0.f, ei[j]); er[j] += m1r[j] * tr - m1i[j] * ti; ei[j] += m1r[j] * ti + m1i[j] * tr; }
                { const float tr = dpp_row_f<0x112>(0.f, er[j]), ti = dpp_row_f<0x112>(0.f, ei[j]); er[j] += m2r[j] * tr - m2i[j] * ti; ei[j] += m2r[j] * ti + m2i[j] * tr; }
                { const float tr = dpp_row_f<0x114>(0.f, er[j]), ti = dpp_row_f<0x114>(0.f, ei[j]); er[j] += m4r[j] * tr - m4i[j] * ti; ei[j] += m4r[j] * ti + m4i[j] * tr; }
                { const float tr = dpp_row_f<0x118>(0.f, er[j]), ti = dpp_row_f<0x118>(0.f, ei[j]); er[j] += m8r[j] * tr - m8i[j] * ti; ei[j] += m8r[j] * ti + m8i[j] * tr; }
                cr[j] = __shfl(er[j], (lane & 48) | 15); ci[j] = __shfl(ei[j], (lane & 48) | 15);
            }
#pragma unroll
            for (int ks = 0; ks < 4; ++ks) Bu[ks] = Bn[ks];
        }
    }
    const int ch0 = half ? CSPLIT : 0, ch1 = (half || !SPLIT) ? NCH : CSPLIT;
#pragma unroll
    for (int ks = 0; ks < 4; ++ks) Bu[ks] = *(const bf16x8*)(ubase + ((size_t)ch0 * 128 + 2 * ks) * NIN_E);
    for (int ch = ch0; ch < ch1; ++ch) {
        if (ch + 1 < ch1) {
#pragma unroll
            for (int ks = 0; ks < 4; ++ks) Bn[ks] = *(const bf16x8*)(ubase + ((size_t)(ch + 1) * 128 + 2 * ks) * NIN_E); }
        f32x4 IN = (f32x4){0.f, 0.f, 0.f, 0.f};
#pragma unroll
        for (int ks = 0; ks < 4; ++ks) IN = __builtin_amdgcn_mfma_f32_16x16x32_bf16(A2[ks], Bu[ks], IN, 0, 0, 0);
        float er[2] = {IN[0], IN[2]}, ei[2] = {IN[1], IN[3]}, xr[2], xi[2];
#pragma unroll
        for (int j = 0; j < 2; ++j) {
            if (ql == 0) { er[j] += m1r[j] * cr[j] - m1i[j] * ci[j]; ei[j] += m1r[j] * ci[j] + m1i[j] * cr[j]; }
            { const float tr = dpp_row_f<0x111>(0.f, er[j]), ti = dpp_row_f<0x111>(0.f, ei[j]); er[j] += m1r[j] * tr - m1i[j] * ti; ei[j] += m1r[j] * ti + m1i[j] * tr; }
            { const float tr = dpp_row_f<0x112>(0.f, er[j]), ti = dpp_row_f<0x112>(0.f, ei[j]); er[j] += m2r[j] * tr - m2i[j] * ti; ei[j] += m2r[j] * ti + m2i[j] * tr; }
            { const float tr = dpp_row_f<0x114>(0.f, er[j]), ti = dpp_row_f<0x114>(0.f, ei[j]); er[j] += m4r[j] * tr - m4i[j] * ti; ei[j] += m4r[j] * ti + m4i[j] * tr; }
            { const float tr = dpp_row_f<0x118>(0.f, er[j]), ti = dpp_row_f<0x118>(0.f, ei[j]); er[j] += m8r[j] * tr - m8i[j] * ti; ei[j] += m8r[j] * ti + m8i[j] * tr; }
            xr[j] = dpp_row_f<0x111>(cr[j], er[j]); xi[j] = dpp_row_f<0x111>(ci[j], ei[j]);
            cr[j] = __shfl(er[j], (lane & 48) | 15); ci[j] = __shfl(ei[j], (lane & 48) | 15);
        }
        LAS unsigned char* xb = F.lds + (ch & 1) * S5X_BUF;
        *(LAS u32x2*)(xb + ql * S5X_ROW + (16 * w + 4 * gq) * 2) = (u32x2){pk2(xr[0], xi[0]), pk2(xr[1], xi[1])};
        RAW_BAR();
        f32x4 Yt = (f32x4){0.f, 0.f, 0.f, 0.f};
#pragma unroll
        for (int ks = 0; ks < 4; ++ks) Yt = __builtin_amdgcn_mfma_f32_16x16x32_bf16(A1[ks], Bu[ks], Yt, 0, 0, 0);
#pragma unroll
        for (int ks = 0; ks < 4; ++ks) { const bf16x8 Bx = *(const LAS bf16x8*)(xb + ql * S5X_ROW + (32 * ks + 8 * gq) * 2); Yt = __builtin_amdgcn_mfma_f32_16x16x32_bf16(A3[ks], Bx, Yt, 0, 0, 0); }
        float y[4];
#pragma unroll
        for (int i = 0; i < 4; ++i) { const float v = Yt[i]; y[i] = v * fast_sigmoid(1.5957691216f * (v + 0.044715f * v * v * v)); }
        u32x4 by; by.x = pk2(y[0], y[1]); by.y = pk2(y[2], y[3]); by.z = 0u; by.w = 0u;
        const f32x4 Z = __builtin_amdgcn_mfma_f32_16x16x32_bf16(Awg, __builtin_bit_cast(bf16x8, by), (f32x4){0.f, 0.f, 0.f, 0.f}, 0, 0, 0);
        u32x2 o; o.x = pk2(y[0] * fast_sigmoid(Z[0]), y[1] * fast_sigmoid(Z[1])); o.y = pk2(y[2] * fast_sigmoid(Z[2]), y[3] * fast_sigmoid(Z[3]));
        *(u32x2*)(Y + (rowb + (size_t)ch * 128 + 8 * ql + w) * D + DCONV + g * 16 + 4 * gq) = o;
#pragma unroll
        for (int ks = 0; ks < 4; ++ks) Bu[ks] = Bn[ks];
    }
}

template <bool ROUTER, int QOUT = (ROUTER ? 1 : 0)>
__device__ __forceinline__ void ln_phase(Frame& F, const bf16_t* PRE, bf16_t* H, const float* gam, const float* bet, unsigned char* H8 = nullptr) {
    const int gw = F.bid * NWAVES + F.wave, NGW = F.G * NWAVES;
    LAS unsigned* lcnt = (LAS unsigned*)(F.lds + LDS_MISC + 64);
    if (ROUTER) { if (F.tid < 16) lcnt[F.tid] = 0u; __syncthreads(); }
    f32x4 gv[8], bv[8];
#pragma unroll
    for (int j = 0; j < 8; ++j) { gv[j] = *(const f32x4*)(gam + 4 * F.lane + 256 * j); bv[j] = *(const f32x4*)(bet + 4 * F.lane + 256 * j); }
    for (int r = gw; r < M; r += NGW) {
        if (ROUTER && !(r % LP >= NMETA && r % LP < LR)) continue;
        if (!ROUTER && r % LP >= LR) {
            u32x2* o8 = (u32x2*)(H + (size_t)r * D) + F.lane;
#pragma unroll
            for (int j = 0; j < 8; ++j) o8[64 * j] = (u32x2){0u, 0u};
            if (QOUT) { unsigned* o4 = (unsigned*)(H8 + (size_t)r * D) + F.lane;
#pragma unroll
                for (int j = 0; j < 8; ++j) o4[64 * j] = 0u; }
            continue; }
        const u32x2* xr = (const u32x2*)(PRE + (size_t)r * D) + F.lane;
        f32x4 v[8]; float s = 0.f;
#pragma unroll
        for (int j = 0; j < 8; ++j) { const u32x2 x = xr[64 * j]; v[j] = (f32x4){bflo(x.x), bfhi(x.x), bflo(x.y), bfhi(x.y)}; s += (v[j][0] + v[j][1]) + (v[j][2] + v[j][3]); }
        const float mean = wave_sum(s) * (1.f / D); float s2 = 0.f;
#pragma unroll
        for (int j = 0; j < 8; ++j) { v[j] = v[j] - mean; s2 += (v[j][0] * v[j][0] + v[j][1] * v[j][1]) + (v[j][2] * v[j][2] + v[j][3] * v[j][3]); }
        const float rstd = 1.f / sqrtf(wave_sum(s2) * (1.f / D) + LN_EPS);
        u32x2* o8 = (u32x2*)(H + (size_t)r * D) + F.lane;
#pragma unroll
        for (int j = 0; j < 8; ++j) { v[j] = v[j] * rstd * gv[j] + bv[j]; u32x2 w; w.x = pk2(v[j][0], v[j][1]); w.y = pk2(v[j][2], v[j][3]); o8[64 * j] = w; }
        if (QOUT) { unsigned* o4 = (unsigned*)(H8 + (size_t)r * D) + F.lane;
#pragma unroll
            for (int j = 0; j < 8; ++j) o4[64 * j] = (QOUT == 2) ? pk4_i8(v[j][0] * I8S_H, v[j][1] * I8S_H, v[j][2] * I8S_H, v[j][3] * I8S_H) : pk4_f8(v[j][0] * F8S_H3, v[j][1] * F8S_H3, v[j][2] * F8S_H3, v[j][3] * F8S_H3); }
        if (ROUTER) {
            {
                const float* rw = F.in[I_RW];
                float lg[8];
#pragma unroll
                for (int e = 0; e < 8; ++e) lg[e] = 0.f;
#pragma unroll
                for (int j = 0; j < 8; ++j)
#pragma unroll
                    for (int q = 0; q < 4; ++q) { const int c = 4 * F.lane + 256 * j + q; const f32x4 w0 = *(const f32x4*)(rw + (size_t)c * 8), w1 = *(const f32x4*)(rw + (size_t)c * 8 + 4); const float x = v[j][q];
                        lg[0] += x * w0[0]; lg[1] += x * w0[1]; lg[2] += x * w0[2]; lg[3] += x * w0[3]; lg[4] += x * w1[0]; lg[5] += x * w1[1]; lg[6] += x * w1[2]; lg[7] += x * w1[3]; }
#pragma unroll
                for (int e = 0; e < 8; ++e) lg[e] = wave_sum(lg[e]) + F.in[I_RB][e];
                int e0 = 0; float v0 = lg[0];
#pragma unroll
                for (int e = 1; e < 8; ++e) if (lg[e] > v0) { v0 = lg[e]; e0 = e; }
                int e1 = -1; float v1 = -3.0e38f;
#pragma unroll
                for (int e = 0; e < 8; ++e) if (e != e0 && lg[e] > v1) { v1 = lg[e]; e1 = e; }
                const float p1 = __expf(v1 - v0), g0 = 1.f / (1.f + p1), g1 = p1 * g0;
                if (F.lane == 0) {
                    int* TE = (int*)(F.ws + WS_MOE + MO_TOKE); float* TG = (float*)(F.ws + WS_MOE + MO_TOKG); int* TP = (int*)(F.ws + WS_MOE + MO_TOKPOS);
                    const unsigned q0 = __hip_atomic_fetch_add(lcnt + e0, 1u, __ATOMIC_RELAXED, __HIP_MEMORY_SCOPE_WORKGROUP);
                    const unsigned q1 = __hip_atomic_fetch_add(lcnt + e1, 1u, __ATOMIC_RELAXED, __HIP_MEMORY_SCOPE_WORKGROUP);
                    TE[2 * r] = e0; TE[2 * r + 1] = e1; TG[2 * r] = g0; TG[2 * r + 1] = g1; TP[2 * r] = (int)q0; TP[2 * r + 1] = (int)q1;
                }
            }
        }
    }
    if (ROUTER) {
        __syncthreads();
        if (F.tid < 8) lcnt[8 + F.tid] = __hip_atomic_fetch_add(F.ctl + CW_CNT + 64 * F.tid, lcnt[F.tid], __ATOMIC_RELAXED, __HIP_MEMORY_SCOPE_AGENT);
        __syncthreads();
        const int* TE = (const int*)(F.ws + WS_MOE + MO_TOKE); int* TP = (int*)(F.ws + WS_MOE + MO_TOKPOS);
        for (int r = gw; r < M; r += NGW) if (r % LP >= NMETA && r % LP < LR && F.lane < 2) TP[2 * r + F.lane] += (int)lcnt[8 + TE[2 * r + F.lane]];
    }
}
__device__ __forceinline__ void route_phase(Frame& F) {
    int cnt[8], ps[8]; int tot = 0;
#pragma unroll
    for (int e = 0; e < 8; ++e) { cnt[e] = (int)__hip_atomic_load(F.ctl + CW_CNT + 64 * e, __ATOMIC_RELAXED, __HIP_MEMORY_SCOPE_AGENT); ps[e] = tot; tot += (cnt[e] + 255) / 256 * 256; }
    const int* TE = (const int*)(F.ws + WS_MOE + MO_TOKE); const int* TP = (const int*)(F.ws + WS_MOE + MO_TOKPOS);
    int* TS = (int*)(F.ws + WS_MOE + MO_TOKSLOT); int* ST = (int*)(F.ws + WS_MOE + MO_SLOTTOK); int* TL = (int*)(F.ws + WS_MOE + MO_TILEE);
    const int gt = F.bid * NTHREADS + F.tid, NGT = F.G * NTHREADS;
    for (int a = gt; a < 2 * M; a += NGT) { const int r = a >> 1; if (r % LP >= NMETA && r % LP < LR) { const int e = TE[a]; int base = 0;
#pragma unroll
            for (int j = 0; j < 8; ++j) base = (j == e) ? ps[j] : base;
            const int slot = base + TP[a]; TS[a] = slot; ST[slot] = r; } }
    for (int s = gt; s < tot; s += NGT) { int e = 0;
#pragma unroll
        for (int j = 1; j < 8; ++j) e = (s >= ps[j]) ? j : e;
        int pe = 0, ce = 0;
#pragma unroll
        for (int j = 0; j < 8; ++j) { pe = (j == e) ? ps[j] : pe; ce = (j == e) ? cnt[j] : ce; }
        if (s - pe >= ce) ST[s] = NMETA;
        if ((s & 255) == 0) TL[s >> 8] = e; }
    if (gt == 0) TL[300] = tot >> 8;
}
__device__ __forceinline__ void final_phase(Frame& F) {
    const bf16_t* H = (const bf16_t*)(F.ws + WS_H3); const bf16_t* YB = (const bf16_t*)(F.ws + WS_YB);
    const int* TS = (const int*)(F.ws + WS_MOE + MO_TOKSLOT); const float* TG = (const float*)(F.ws + WS_MOE + MO_TOKG);
    const float* gam = F.in[I_LN4G]; const float* bet = F.in[I_LN4B];
    const int gw = F.bid * NWAVES + F.wave, NGW = F.G * NWAVES;
    f32x4 gv[8], bv[8];
#pragma unroll
    for (int j = 0; j < 8; ++j) { gv[j] = *(const f32x4*)(gam + 4 * F.lane + 256 * j); bv[j] = *(const f32x4*)(bet + 4 * F.lane + 256 * j); }
    for (int o = gw; o < NB * SEQ; o += NGW) {
        const int b = o / SEQ, s = o % SEQ, r = b * LP + NMETA + s;
        const int s0 = TS[2 * r], s1 = TS[2 * r + 1]; const float g0 = TG[2 * r], g1 = TG[2 * r + 1];
        const u32x2* hr = (const u32x2*)(H + (size_t)r * D) + F.lane; const u32x2* y0 = (const u32x2*)(YB + (size_t)s0 * D) + F.lane; const u32x2* y1 = (const u32x2*)(YB + (size_t)s1 * D) + F.lane;
        f32x4 v[8]; float sm = 0.f;
#pragma unroll
        for (int j = 0; j < 8; ++j) { const u32x2 hw = hr[64 * j], a = y0[64 * j], c = y1[64 * j];
            v[j][0] = ALPHA * bflo(hw.x) + g0 * bflo(a.x) + g1 * bflo(c.x); v[j][1] = ALPHA * bfhi(hw.x) + g0 * bfhi(a.x) + g1 * bfhi(c.x);
            v[j][2] = ALPHA * bflo(hw.y) + g0 * bflo(a.y) + g1 * bflo(c.y); v[j][3] = ALPHA * bfhi(hw.y) + g0 * bfhi(a.y) + g1 * bfhi(c.y);
            sm += (v[j][0] + v[j][1]) + (v[j][2] + v[j][3]); }
        const float mean = wave_sum(sm) * (1.f / D); float s2 = 0.f;
#pragma unroll
        for (int j = 0; j < 8; ++j) { v[j] = v[j] - mean; s2 += (v[j][0] * v[j][0] + v[j][1] * v[j][1]) + (v[j][2] * v[j][2] + v[j][3] * v[j][3]); }
        const float rstd = 1.f / sqrtf(wave_sum(s2) * (1.f / D) + LN_EPS);
        f32x4* op = (f32x4*)(F.out + (size_t)o * D) + F.lane;
#pragma unroll
        for (int j = 0; j < 8; ++j) op[64 * j] = v[j] * rstd * gv[j] + bv[j];
    }
}
__device__ __forceinline__ int dsa_kend(int q) { return q < NMETA ? NMETA : NMETA + 64 * (1 + (q - NMETA) / 64); }
constexpr int D1_CAP = 512, D1_BUF = 0, D1_HIST = 16 * D1_CAP * 4, D1_BMP = D1_HIST + 1024, D1_CNT = D1_BMP + BMP_PITCH * 4, D1_WAVE = D1_CNT + 64; static_assert(D1_WAVE == D1_WAVE_BYTES && 4 * D1_WAVE + 4 * 4352 <= LDS_MISC, "top-k LDS map");
__device__ __forceinline__ unsigned d1_mono(float f) { const unsigned u = __float_as_uint(f); return (u & 0x80000000u) ? ~u : (u | 0x80000000u); }
template <int CTRL, int ROWMASK> __device__ __forceinline__ int dpp_int(int old, int src) { return __builtin_amdgcn_update_dpp(old, src, CTRL, ROWMASK, 0xf, false); }
__device__ __forceinline__ int wave_scan_add_i(int v) {
    v += dpp_int<0x111, 0xf>(0, v); v += dpp_int<0x112, 0xf>(0, v); v += dpp_int<0x114, 0xf>(0, v); v += dpp_int<0x118, 0xf>(0, v);
    v += dpp_int<0x142, 0xa>(0, v); v += dpp_int<0x143, 0xc>(0, v); return v;
}
__device__ __forceinline__ unsigned d1_refresh(LAS unsigned* buf, LAS unsigned* hist, LAS unsigned* cnt, int qq, int lane) {
    const int n = (int)cnt[qq];
    LAS unsigned* bq = buf + qq * D1_CAP;
    unsigned e[8];
#pragma unroll
    for (int i = 0; i < 8; ++i) e[i] = (lane + 64 * i < n) ? bq[lane + 64 * i] : 0u;
    unsigned prefix = 0u; int need = 256;
#pragma unroll 1
    for (int r = 3; r >= 0; --r) {
        const int shift = 8 * r;
        bool m[8]; unsigned dg[8]; unsigned any_d = 0u; bool uni = true;
#pragma unroll
        for (int i = 0; i < 8; ++i) { m[i] = (e[i] != 0u) && (r == 3 || (e[i] >> (shift + 8)) == (prefix >> (shift + 8))); dg[i] = (e[i] >> shift) & 255u; }
        { unsigned long long bm = 0ull; unsigned first = 0u;
#pragma unroll
          for (int i = 0; i < 8; ++i) { const unsigned long long b_ = __ballot(m[i]); if (bm == 0ull && b_ != 0ull) first = (unsigned)__builtin_amdgcn_readlane((int)dg[i], (int)__builtin_ctzll(b_)); bm |= b_; }
          any_d = first;
#pragma unroll
          for (int i = 0; i < 8; ++i) uni = uni && !__any(m[i] && dg[i] != first); }
        if (uni) { prefix |= any_d << shift; continue; }
        *(LAS u32x4*)(hist + 4 * lane) = (u32x4){0u, 0u, 0u, 0u};
        LDS_WAIT();
#pragma unroll
        for (int i = 0; i < 8; ++i) if (m[i]) __hip_atomic_fetch_add(hist + (255u - dg[i]), 1u, __ATOMIC_RELAXED, __HIP_MEMORY_SCOPE_WORKGROUP);
        LDS_WAIT();
        const u32x4 h4 = *(const LAS u32x4*)(hist + 4 * lane);
        const int s = (int)(h4.x + h4.y + h4.z + h4.w);
        const int S = wave_scan_add_i(s);
        const int above = S - s;
        const bool found = (above < need) && (need <= S);
        int digit = 0, nneed = 0;
        if (found) { int a = above;
            if (a + (int)h4.x >= need) { digit = 255 - 4 * lane; nneed = need - a; }
            else { a += (int)h4.x;
                if (a + (int)h4.y >= need) { digit = 254 - 4 * lane; nneed = need - a; }
                else { a += (int)h4.y;
                    if (a + (int)h4.z >= need) { digit = 253 - 4 * lane; nneed = need - a; }
                    else { a += (int)h4.z; digit = 252 - 4 * lane; nneed = need - a; } } } }
        const unsigned long long fm = __ballot(found);
        const int src = fm ? (int)__builtin_ctzll(fm) : 0;
        digit = __builtin_amdgcn_readlane(digit, src); nneed = __builtin_amdgcn_readlane(nneed, src);
        prefix |= (unsigned)digit << shift; need = nneed;
    }
    const unsigned T = prefix;
    int base = 0;
#pragma unroll
    for (int i = 0; i < 8; ++i) { const bool keep = e[i] >= T && e[i] != 0u; const unsigned long long mk = __ballot(keep);
        const int pos = base + (int)__builtin_popcountll(mk & ((1ull << lane) - 1ull));
        if (keep) bq[pos] = e[i];
        base += (int)__builtin_popcountll(mk); }
    if (lane == 0) cnt[qq] = (unsigned)base;
    LDS_WAIT();
    return T;
}
__device__ __forceinline__ unsigned wave_min_u(unsigned v) {
    const int ni = -1;
    v = min(v, (unsigned)dpp_int<0x111, 0xf>(ni, (int)v)); v = min(v, (unsigned)dpp_int<0x112, 0xf>(ni, (int)v)); v = min(v, (unsigned)dpp_int<0x114, 0xf>(ni, (int)v)); v = min(v, (unsigned)dpp_int<0x118, 0xf>(ni, (int)v));
    v = min(v, (unsigned)dpp_int<0x142, 0xa>(ni, (int)v)); v = min(v, (unsigned)dpp_int<0x143, 0xc>(ni, (int)v));
    return (unsigned)__builtin_amdgcn_readlane((int)v, 63);
}
__device__ __forceinline__ unsigned wave_max_u(unsigned v) {
    v = max(v, (unsigned)dpp_int<0x111, 0xf>(0, (int)v)); v = max(v, (unsigned)dpp_int<0x112, 0xf>(0, (int)v)); v = max(v, (unsigned)dpp_int<0x114, 0xf>(0, (int)v)); v = max(v, (unsigned)dpp_int<0x118, 0xf>(0, (int)v));
    v = max(v, (unsigned)dpp_int<0x142, 0xa>(0, (int)v)); v = max(v, (unsigned)dpp_int<0x143, 0xc>(0, (int)v));
    return (unsigned)__builtin_amdgcn_readlane((int)v, 63);
}
template <bool EXACT>
__device__ __forceinline__ unsigned d1_select(LAS unsigned* buf, LAS unsigned* hist, LAS unsigned* cnt, int qq, int lane) {
    const int n = (int)cnt[qq];
    LAS unsigned* bq = buf + qq * D1_CAP;
    unsigned e[8];
#pragma unroll
    for (int i = 0; i < 8; ++i) e[i] = (lane + 64 * i < n) ? bq[lane + 64 * i] : 0u;
    unsigned lmin = 0xFFFFFFFFu, lmax = 0u;
#pragma unroll
    for (int i = 0; i < 8; ++i) { const unsigned k = e[i] >> 17; lmin = (e[i] != 0u) ? min(lmin, k) : lmin; lmax = (e[i] != 0u) ? max(lmax, k) : lmax; }
    const unsigned kmin = wave_min_u(lmin), kmax = wave_max_u(lmax);
    const float inv = 256.0f / (float)(kmax - kmin + 1u);
    int bin[8];
#pragma unroll
    for (int i = 0; i < 8; ++i) { const int b_ = (int)((float)((e[i] >> 17) - kmin) * inv); bin[i] = b_ > 255 ? 255 : b_; }
    *(LAS u32x4*)(hist + 4 * lane) = (u32x4){0u, 0u, 0u, 0u};
    LDS_WAIT();
#pragma unroll
    for (int i = 0; i < 8; ++i) if (e[i] != 0u) __hip_atomic_fetch_add(hist + (255 - bin[i]), 1u, __ATOMIC_RELAXED, __HIP_MEMORY_SCOPE_WORKGROUP);
    LDS_WAIT();
    const u32x4 h4 = *(const LAS u32x4*)(hist + 4 * lane);
    const int s_ = (int)(h4.x + h4.y + h4.z + h4.w);
    const int S = wave_scan_add_i(s_);
    const int above_l = S - s_;
    const bool found = (above_l < 256) && (256 <= S);
    int bstar = 0, above = 0, cb = 0;
    if (found) { int a = above_l;
        if (a + (int)h4.x >= 256) { bstar = 255 - 4 * lane; above = a; cb = (int)h4.x; }
        else { a += (int)h4.x;
            if (a + (int)h4.y >= 256) { bstar = 254 - 4 * lane; above = a; cb = (int)h4.y; }
            else { a += (int)h4.y;
                if (a + (int)h4.z >= 256) { bstar = 253 - 4 * lane; above = a; cb = (int)h4.z; }
                else { a += (int)h4.z; bstar = 252 - 4 * lane; above = a; cb = (int)h4.w; } } } }
    const unsigned long long fm = __ballot(found);
    const int src = fm ? (int)__builtin_ctzll(fm) : 0;
    bstar = __builtin_amdgcn_readlane(bstar, src); above = __builtin_amdgcn_readlane(above, src); cb = __builtin_amdgcn_readlane(cb, src);
    unsigned T;
    if (!EXACT) {
        if (above + cb > D1_CAP - 128) return d1_refresh(buf, hist, cnt, qq, lane);
        unsigned lk = 0xFFFFFFFFu;
#pragma unroll
        for (int i = 0; i < 8; ++i) lk = (e[i] != 0u && bin[i] >= bstar) ? min(lk, e[i]) : lk;
        T = wave_min_u(lk);
    } else {
        if (cb > 48) return d1_refresh(buf, hist, cnt, qq, lane);
        unsigned cur = 0xFFFFFFFFu;
        for (int it = above; it < 256; ++it) {
            unsigned lm = 0u;
#pragma unroll
            for (int i = 0; i < 8; ++i) lm = (bin[i] == bstar && e[i] < cur) ? max(lm, e[i]) : lm;
            cur = wave_max_u(lm);
        }
        T = cur;
    }
    int base = 0;
#pragma unroll
    for (int i = 0; i < 8; ++i) { const bool keep = e[i] >= T && e[i] != 0u; const unsigned long long mk = __ballot(keep);
        const int pos = base + (int)__builtin_popcountll(mk & ((1ull << lane) - 1ull));
        if (keep) bq[pos] = e[i];
        base += (int)__builtin_popcountll(mk); }
    if (lane == 0) cnt[qq] = (unsigned)base;
    LDS_WAIT();
    return EXACT ? T : T - 1u;
}
#ifndef PROBE_D1
#define PROBE_D1 0
#endif
__device__ __forceinline__ void d1_append(LAS unsigned* buf, LAS unsigned* hist, LAS unsigned* cnt, const unsigned (&pk)[8], const int c, unsigned& thr, const int ql, const int lane, const int rep) {
    if (__any(c > 0) && !(rep && (PROBE_D1 & 1))) {
        unsigned pos = 0u;
        if (c > 0) pos = __hip_atomic_fetch_add(cnt + ql, (unsigned)c, __ATOMIC_RELAXED, __HIP_MEMORY_SCOPE_WORKGROUP);
        unsigned wp = ql * D1_CAP + pos;
#pragma unroll
        for (int i = 0; i < 8; ++i) if (pk[i] > thr) { buf[wp] = pk[i]; ++wp; }
        const bool full = (c > 0) && (pos + (unsigned)c > (unsigned)(D1_CAP - 32));
        unsigned long long fm = __ballot(full); fm = (fm | (fm >> 16) | (fm >> 32) | (fm >> 48)) & 0xFFFFull;
        if (fm) { LDS_WAIT();
            while (fm) { const int qq = (int)__builtin_ctzll(fm); fm &= fm - 1ull;
                if (rep && (PROBE_D1 & 2)) { if (lane == 0) cnt[qq] = 256u; LDS_WAIT(); continue; }
                const unsigned T = d1_select<false>(buf, hist, cnt, qq, lane);
                if (ql == qq) thr = T; } }
    }
}
__device__ __forceinline__ void d1_unit(Frame& F, LAS unsigned char* wl, int b, int qg, int rep) {
    const bf16_t* PA = (const bf16_t*)(F.ws + WS_P); unsigned* BMP = (unsigned*)(F.ws + WS_BMP);
    LAS unsigned* buf = (LAS unsigned*)(wl + D1_BUF); LAS unsigned* hist = (LAS unsigned*)(wl + D1_HIST); LAS unsigned* bmp = (LAS unsigned*)(wl + D1_BMP); LAS unsigned* cnt = (LAS unsigned*)(wl + D1_CNT);
    const int lane = F.lane, ql = lane & 15, g = lane >> 4, q0 = qg * 16, kend = dsa_kend(q0);
    const size_t rowq = (size_t)b * LP + q0 + ql;
    bf16x8 Bq[8][2]; float wq[8];
#pragma unroll
    for (int h = 0; h < 8; ++h) {
#pragma unroll
        for (int ks = 0; ks < 2; ++ks) Bq[h][ks] = *(const bf16x8*)(PA + rowq * NIN_OA + CA_QI + h * 64 + ks * 32 + 8 * g);
        wq[h] = bf2f(PA[rowq * NIN_OA + CA_WI + h]) * (0.35355339059f * 0.125f);
    }
    if (lane < 16) cnt[lane] = 0u;
    LDS_WAIT();
    unsigned thr = 0u;
    const bf16_t* kp = (const bf16_t*)(F.ws + WS_KIC) + ((size_t)b * LP + ql) * 64 + 8 * g;
    const int ngrp = kend / 16, nit = (ngrp + 1) / 2;
    bf16x8 S0[2][2], S1[2][2], S2[2][2];
#define D1_LOADG(dst, it_) do { _Pragma("unroll") for (int j_ = 0; j_ < 2; ++j_) { int gi_ = 2 * (it_) + j_; gi_ = gi_ < ngrp ? gi_ : ngrp - 1; const bf16_t* kn_ = kp + (size_t)gi_ * 16 * 64; dst[j_][0] = *(const bf16x8*)kn_; dst[j_][1] = *(const bf16x8*)(kn_ + 32); } } while (0)
#define D1_BODY(CUR, LD, itv) do { const int it_b = (itv); \
        D1_LOADG(LD, it_b + 2); \
        unsigned pk[8]; int c = 0; \
        _Pragma("unroll") for (int j = 0; j < 2; ++j) { \
            float sc[4] = {0.f, 0.f, 0.f, 0.f}; \
            _Pragma("unroll") for (int h = 0; h < 8; ++h) { f32x4 acc = (f32x4){0.f, 0.f, 0.f, 0.f}; \
                acc = __builtin_amdgcn_mfma_f32_16x16x32_bf16(CUR[j][0], Bq[h][0], acc, 0, 0, 0); \
                acc = __builtin_amdgcn_mfma_f32_16x16x32_bf16(CUR[j][1], Bq[h][1], acc, 0, 0, 0); \
                _Pragma("unroll") for (int i = 0; i < 4; ++i) sc[i] = __builtin_fmaf(wq[h], __int_as_float(max(__float_as_int(acc[i]), 0)), sc[i]); }   \
            const bool gv = (2 * it_b + j) < ngrp; \
            _Pragma("unroll") for (int i = 0; i < 4; ++i) { const unsigned p = (d1_mono(sc[i]) & 0xFFFF8000u) | (unsigned)((2 * it_b + j) * 16 + 4 * g + i); pk[4 * j + i] = gv ? p : 0u; c += (pk[4 * j + i] > thr) ? 1 : 0; } \
        } \
        d1_append(buf, hist, cnt, pk, c, thr, ql, lane, rep); \
    } while (0)
#pragma unroll
    for (int h = 0; h < 8; ++h) asm volatile("" :: "v"(Bq[h][0]), "v"(Bq[h][1]), "v"(wq[h]));
    D1_LOADG(S0, 0); D1_LOADG(S1, 1);
    for (int it = 0; it < nit; it += 3) {
        D1_BODY(S0, S2, it);
        if (it + 1 < nit) D1_BODY(S1, S0, it + 1);
        if (it + 2 < nit) D1_BODY(S2, S1, it + 2);
    }
#undef D1_BODY
#undef D1_LOADG
    LDS_WAIT();
#pragma unroll 1
    for (int qq = 0; qq < 16; ++qq) {
        if ((int)cnt[qq] > 256) (void)d1_select<true>(buf, hist, cnt, qq, lane);
        const int n = (int)cnt[qq];
#pragma unroll
        for (int j = 0; j < 9; ++j) if (lane + 64 * j < BMP_PITCH) bmp[lane + 64 * j] = 0u;
        LDS_WAIT();
#pragma unroll
        for (int i = 0; i < 4; ++i) if (lane + 64 * i < n) { const unsigned idx = buf[qq * D1_CAP + lane + 64 * i] & 0x7FFFu; __hip_atomic_fetch_or(bmp + (idx >> 5), 1u << (idx & 31u), __ATOMIC_RELAXED, __HIP_MEMORY_SCOPE_WORKGROUP); }
        LDS_WAIT();
        unsigned* orow = BMP + ((size_t)b * LP + q0 + qq) * BMP_PITCH;
#pragma unroll
        for (int j = 0; j < 9; ++j) if (lane + 64 * j < BMP_PITCH) orow[lane + 64 * j] = bmp[lane + 64 * j];
        LDS_WAIT();
    }
}
__device__ __forceinline__ void d1_phase(Frame& F, int rep) {
    if (F.wave >= 4) return;
    LAS unsigned char* wl = F.lds + F.wave * D1_WAVE;
    constexpr int NQG = LR / 16;
    const int b = F.bid & 1;
    for (;;) {
        int u = 0;
        if (F.lane == 0) u = (int)__hip_atomic_fetch_add(F.ctl + CW_Q1 + 64 * (b + 2 * rep), 1u, __ATOMIC_RELAXED, __HIP_MEMORY_SCOPE_AGENT);
        u = __builtin_amdgcn_readfirstlane(u);
        if (u >= NQG) break;
        d1_unit(F, wl, b, NQG - 1 - u, rep);
    }
}

constexpr int D2_KS = 0, D2_KROW = 272, D2_VS = 64 * D2_KROW, D2_VROW = 144, D2_BUF = D2_VS + 128 * D2_VROW, D2_LUT = 2 * D2_BUF, D2_LDS = D2_LUT + 260 * 4;
constexpr float D2_SL2 = 0.08838834764831845f * 1.4426950408889634f, D2_L2E = 1.4426950408889634f, D2_NEG = -3.0e38f, D2_THR = 11.5f;
__device__ __forceinline__ int t5_bucket_dev(int rel) {
    const int n = rel < 0 ? -rel : rel; int v;
    if (n < 8) v = n; else { int l = 8 + (int)(log((double)n / 8.0) / log(16.0) * 8.0); v = l < 15 ? l : 15; }
    return (rel > 0 ? 16 : 0) + v;
}
template <bool FAR>
__device__ __forceinline__ void d2_softmax(const f32x4 (&St)[2][4], unsigned (&bw)[2][2], const unsigned (&bwn)[2][2], float (&mrun)[2], float (&lrun)[2], f32x4 (&O)[2][8], bf16x8 (&Pb)[2][2],
                                           const LAS float* lut, const int g, const int key0, const int (&qpos)[2]) {
    const float bfar = lut[128];
#pragma unroll
    for (int s = 0; s < 2; ++s) {
        const int wsh0 = (int)(bw[s][0] >> (4 * g)), wsh1 = (int)(bw[s][1] >> (4 * g));
        float pv[4][4]; float tmax = D2_NEG;
#pragma unroll
        for (int sub = 0; sub < 4; ++sub)
#pragma unroll
            for (int i = 0; i < 4; ++i) {
                float bias = bfar;
                if (!FAR) { const int rel = key0 + 16 * sub + 4 * g + i - qpos[s]; const int n = rel < 0 ? -rel : rel; const int nn = n < 128 ? n : 128; bias = lut[rel > 0 ? 129 + nn : nn]; }
                const float x = St[s][sub][i] * D2_SL2 + bias;
                const int t = __builtin_amdgcn_sbfe((sub >> 1) ? wsh1 : wsh0, 16 * (sub & 1) + i, 1);
                const float xm = __int_as_float((t & __float_as_int(x)) | (~t & __float_as_int(D2_NEG)));
                pv[sub][i] = xm; tmax = fmaxf(tmax, xm); }
        if (__any(tmax > mrun[s] + D2_THR)) {
            float tm = fmaxf(tmax, __shfl_xor(tmax, 16)); tm = fmaxf(tm, __shfl_xor(tm, 32));
            const float mnew = fmaxf(mrun[s], tm), alpha = __builtin_amdgcn_exp2f(mrun[s] - mnew);
            mrun[s] = mnew; lrun[s] *= alpha;
#pragma unroll
            for (int dt = 0; dt < 8; ++dt) O[s][dt] = O[s][dt] * alpha;
        }
        float ps = 0.f; const float mr = mrun[s];
#pragma unroll
        for (int sub = 0; sub < 4; ++sub)
#pragma unroll
            for (int i = 0; i < 4; ++i) { const float p = __builtin_amdgcn_exp2f(pv[sub][i] - mr); pv[sub][i] = p; ps += p; }
        lrun[s] += ps;
#pragma unroll
        for (int kk = 0; kk < 2; ++kk) { u32x4 pw; pw.x = pk2(pv[2 * kk][0], pv[2 * kk][1]); pw.y = pk2(pv[2 * kk][2], pv[2 * kk][3]); pw.z = pk2(pv[2 * kk + 1][0], pv[2 * kk + 1][1]); pw.w = pk2(pv[2 * kk + 1][2], pv[2 * kk + 1][3]);
            Pb[s][kk] = __builtin_bit_cast(bf16x8, pw); }
        bw[s][0] = bwn[s][0]; bw[s][1] = bwn[s][1];
    }
}
#ifndef PROBE_D2
#define PROBE_D2 0
#endif
__device__ __forceinline__ void d2_unit(Frame& F, LAS unsigned char* lds, int b, int jb, int h, int rep) {
    const bf16_t* PA = (const bf16_t*)(F.ws + WS_P); const bf16_t* KVT = (const bf16_t*)(F.ws + WS_KVT); const unsigned* BMP = (const unsigned*)(F.ws + WS_BMP);
    bf16_t* Y = (bf16_t*)(F.ws + WS_Y);
    LAS float* lut = (LAS float*)(lds + D2_LUT);
    const int lane = F.lane, ql = lane & 15, g = lane >> 4, w = F.wave, tid = F.tid;
    const int qbase = jb * 256 + w * 32;
    const int qlast = (jb * 256 + 255 < LR - 1) ? jb * 256 + 255 : LR - 1;
    const int ntile = (dsa_kend(qlast) + 63) / 64;
    const int kr = tid >> 3, ksg = tid & 7, vd = tid >> 2, vst = tid & 3;
    const bf16_t* ksrc = PA + ((size_t)b * LP + kr) * NIN_OA + CA_KD + h * 128 + ksg * 16;
    const bf16_t* vsrc = KVT + (size_t)(RB_VD + h * 128 + vd) * M + (size_t)b * LP + vst * 16;
    const int kdst = D2_KS + kr * D2_KROW + ksg * 32, vdst = D2_VS + vd * D2_VROW + (vst >> 1) * 64 + (vst & 1) * 8;
    u32x4 rk0, rk1, rva, rvc;
#define D2_LOAD(kt_) do { const bf16_t* ks_ = ksrc + (size_t)(kt_) * 64 * NIN_OA; rk0 = *(const u32x4*)ks_; rk1 = *(const u32x4*)(ks_ + 8); const bf16_t* vs_ = vsrc + (kt_) * 64; rva = *(const u32x4*)vs_; rvc = *(const u32x4*)(vs_ + 8); } while (0)
#define D2_STORE(p_) do { LAS unsigned char* kb_ = lds + (p_) * D2_BUF; *(LAS u32x4*)(kb_ + kdst) = rk0; *(LAS u32x4*)(kb_ + kdst + 16) = rk1; \
        *(LAS u32x2*)(kb_ + vdst) = (u32x2){rva.x, rva.y}; *(LAS u32x2*)(kb_ + vdst + 16) = (u32x2){rva.z, rva.w}; *(LAS u32x2*)(kb_ + vdst + 32) = (u32x2){rvc.x, rvc.y}; *(LAS u32x2*)(kb_ + vdst + 48) = (u32x2){rvc.z, rvc.w}; } while (0)
    RAW_BAR();
    D2_LOAD(0);
    if (tid < 258) { const int n = tid < 129 ? tid : tid - 129; const int rel = tid < 129 ? -n : n; lut[tid] = F.in[I_RELB][t5_bucket_dev(rel) * 8 + h] * D2_L2E; }
    int qpos[2]; size_t qrow[2]; bool qok[2];
    bf16x8 Bq[2][4];
#pragma unroll
    for (int s = 0; s < 2; ++s) { qpos[s] = qbase + 16 * s + ql; qok[s] = qpos[s] < LR; qrow[s] = (size_t)b * LP + (qok[s] ? qpos[s] : 0);
#pragma unroll
        for (int ks = 0; ks < 4; ++ks) Bq[s][ks] = *(const bf16x8*)(PA + qrow[s] * NIN_OA + CA_QD + h * 128 + ks * 32 + 8 * g); }
    f32x4 O[2][8]; float mrun[2], lrun[2];
#pragma unroll
    for (int s = 0; s < 2; ++s) { mrun[s] = -1.0e30f; lrun[s] = 0.f;
#pragma unroll
        for (int dt = 0; dt < 8; ++dt) O[s][dt] = (f32x4){0.f, 0.f, 0.f, 0.f}; }
    unsigned bw[2][2], bwn[2][2];
#pragma unroll
    for (int s = 0; s < 2; ++s) { bw[s][0] = qok[s] ? BMP[qrow[s] * BMP_PITCH] : 0u; bw[s][1] = qok[s] ? BMP[qrow[s] * BMP_PITCH + 1] : 0u; bwn[s][0] = 0u; bwn[s][1] = 0u; }
    D2_STORE(0);
#pragma unroll
    for (int s = 0; s < 2; ++s) {
#pragma unroll
        for (int ks = 0; ks < 4; ++ks) asm volatile("" :: "v"(Bq[s][ks]));
        asm volatile("" :: "v"(bw[s][0]), "v"(bw[s][1])); }
    if (ntile > 1) D2_LOAD(1);
    RAW_BAR();
    for (int kt = 0; kt < ntile; ++kt) {
        const int key0 = kt * 64;
        LAS unsigned char* tb = lds + (kt & 1) * D2_BUF;
        if (kt + 1 < ntile && !(rep && (PROBE_D2 & 2))) { D2_STORE((kt + 1) & 1); if (kt + 2 < ntile) D2_LOAD(kt + 2);
#pragma unroll
            for (int s = 0; s < 2; ++s) { bwn[s][0] = qok[s] ? BMP[qrow[s] * BMP_PITCH + 2 * kt + 2] : 0u; bwn[s][1] = qok[s] ? BMP[qrow[s] * BMP_PITCH + 2 * kt + 3] : 0u; } }
        f32x4 St[2][4];
#pragma unroll
        for (int s = 0; s < 2; ++s)
#pragma unroll
            for (int sub = 0; sub < 4; ++sub) St[s][sub] = (f32x4){0.f, 0.f, 0.f, 0.f};
#pragma unroll
        for (int ks = 0; ks < 4; ++ks)
#pragma unroll
            for (int sub = 0; sub < 4; ++sub) { const bf16x8 Ak = *(const LAS bf16x8*)(tb + D2_KS + (16 * sub + ql) * D2_KROW + (32 * ks + 8 * g) * 2);
#pragma unroll
                for (int s = 0; s < 2; ++s) St[s][sub] = __builtin_amdgcn_mfma_f32_16x16x32_bf16(Ak, Bq[s][ks], St[s][sub], 0, 0, 0); }
        const bool far = (key0 + 63 + 129 <= qbase);
        bf16x8 Pb[2][2];
        if (!far) {
            const float bf_ = lut[128];
#pragma unroll
            for (int s = 0; s < 2; ++s)
#pragma unroll
                for (int sub = 0; sub < 4; ++sub)
#pragma unroll
                    for (int i = 0; i < 4; ++i) { const int rel = key0 + 16 * sub + 4 * g + i - qpos[s]; const int n = rel < 0 ? -rel : rel; const int nn = n < 128 ? n : 128;
                        St[s][sub][i] += (lut[rel > 0 ? 129 + nn : nn] - bf_) * (1.0f / D2_SL2); }
        }
        if (rep && (PROBE_D2 & 1)) {
#pragma unroll
            for (int s = 0; s < 2; ++s)
#pragma unroll
                for (int kk = 0; kk < 2; ++kk) { u32x4 pw; pw.x = pk2(St[s][2 * kk][0], St[s][2 * kk][1]); pw.y = pk2(St[s][2 * kk][2], St[s][2 * kk][3]); pw.z = pk2(St[s][2 * kk + 1][0], St[s][2 * kk + 1][1]); pw.w = pk2(St[s][2 * kk + 1][2], St[s][2 * kk + 1][3]); Pb[s][kk] = __builtin_bit_cast(bf16x8, pw); }
        } else
        d2_softmax<true>(St, bw, bwn, mrun, lrun, O, Pb, lut, g, key0, qpos);
#pragma unroll
        for (int kk = 0; kk < 2; ++kk)
#pragma unroll
            for (int dt = 0; dt < 8; ++dt) { const bf16x8 Av = *(const LAS bf16x8*)(tb + D2_VS + (16 * dt + ql) * D2_VROW + kk * 64 + g * 16);
#pragma unroll
                for (int s = 0; s < 2; ++s) O[s][dt] = __builtin_amdgcn_mfma_f32_16x16x32_bf16(Av, Pb[s][kk], O[s][dt], 0, 0, 0); }
        RAW_BAR();
    }
#undef D2_LOAD
#undef D2_STORE
#pragma unroll
    for (int s = 0; s < 2; ++s) {
        float l = lrun[s]; l += __shfl_xor(l, 16); l += __shfl_xor(l, 32);
        const float inv = (qok[s] && l > 0.f) ? 1.0f / l : 0.f;
#if OUT1_F8
        if (qpos[s] < LP) { unsigned char* yr = (unsigned char*)Y + ((size_t)b * LP + qpos[s]) * D + 1024 + h * 128 + 4 * g; const float i8 = inv * F8S_Y;
#pragma unroll
            for (int dt = 0; dt < 8; ++dt) *(unsigned*)(yr + 16 * dt) = pk4_f8(O[s][dt][0] * i8, O[s][dt][1] * i8, O[s][dt][2] * i8, O[s][dt][3] * i8); }
#else
        if (qpos[s] < LP) { bf16_t* yr = Y + ((size_t)b * LP + qpos[s]) * D + 1024 + h * 128 + 4 * g;
#pragma unroll
            for (int dt = 0; dt < 8; ++dt) { u32x2 o; o.x = pk2(O[s][dt][0] * inv, O[s][dt][1] * inv); o.y = pk2(O[s][dt][2] * inv, O[s][dt][3] * inv); *(u32x2*)(yr + 16 * dt) = o; } }
#endif
    }
}
constexpr int D2_NJB = (LP + 255) / 256, D2_NU = NB * D2_NJB * 8;
__device__ __forceinline__ void d2_worker(Frame& F, LAS unsigned char* lds, int rep) {
    LAS int* slot = (LAS int*)(F.lds + LDS_MISC);
    for (;;) {
        __syncthreads();
        if (F.tid == 0) slot[0] = (int)__hip_atomic_fetch_add(F.ctl + CW_Q2 + 64 * rep, 1u, __ATOMIC_RELAXED, __HIP_MEMORY_SCOPE_AGENT);
        __syncthreads();
        const int u = slot[0];
        if (u >= D2_NU) break;
        const int h = u & 7, b = (u >> 3) & 1, jb = D2_NJB - 1 - (u >> 4);
        d2_unit(F, lds, b, jb, h, rep);
    }
}
constexpr int ML_QS = 0, ML_ROW = 528, ML_KS = ML_QS + 64 * ML_ROW, ML_KT = ML_KS + 64 * ML_ROW, ML_TROW = 144, ML_VT = ML_KT + 256 * ML_TROW, ML_VW = ML_VT + 48 * ML_TROW, ML_CB = ML_VW + 48 * ML_TROW,
              ML_SD = ML_CB + 48 * ML_ROW, ML_SC = ML_SD + 64 * ML_TROW, ML_LDS = ML_SC + 2048;
typedef short s16x4 __attribute__((ext_vector_type(4)));
template <int CTRL, int ROWMASK> __device__ __forceinline__ float dpp_f(float old, float src) { return __int_as_float(__builtin_amdgcn_update_dpp(__float_as_int(old), __float_as_int(src), CTRL, ROWMASK, 0xf, false)); }
__device__ __forceinline__ float wave_scan_add(float v) {
    v += dpp_f<0x111, 0xf>(0.f, v); v += dpp_f<0x112, 0xf>(0.f, v); v += dpp_f<0x114, 0xf>(0.f, v); v += dpp_f<0x118, 0xf>(0.f, v);
    v += dpp_f<0x142, 0xa>(0.f, v); v += dpp_f<0x143, 0xc>(0.f, v); return v;
}
__device__ __forceinline__ float wave_scan_max(float v) {
    const float ni = -3.0e38f;
    v = fmaxf(v, dpp_f<0x111, 0xf>(ni, v)); v = fmaxf(v, dpp_f<0x112, 0xf>(ni, v)); v = fmaxf(v, dpp_f<0x114, 0xf>(ni, v)); v = fmaxf(v, dpp_f<0x118, 0xf>(ni, v));
    v = fmaxf(v, dpp_f<0x142, 0xa>(ni, v)); v = fmaxf(v, dpp_f<0x143, 0xc>(ni, v)); return v;
}
__device__ __forceinline__ float readlane_f(float v, int l) { return __int_as_float(__builtin_amdgcn_readlane(__float_as_int(v), l)); }
__device__ __forceinline__ void mlstm_worker(Frame& F, LAS unsigned char* lds, int wg, int noload) {
    const bf16_t* PA = (const bf16_t*)(F.ws + WS_P); const bf16_t* KVT = (const bf16_t*)(F.ws + WS_KVT); bf16_t* Y = (bf16_t*)(F.ws + WS_Y);
    const int b = wg >> 5, h = (wg >> 3) & 3, sl = wg & 7, v0 = sl * 32;
    const int tid = F.tid, lane = F.lane, w = F.wave, ql = lane & 15, g = lane >> 4;
    LAS float* sc = (LAS float*)(lds + ML_SC);
    const float b_i = F.in[I_MBI][h], b_f = F.in[I_MBF][h];
    for (int i = tid; i < (48 * ML_ROW) / 4; i += NTHREADS) ((LAS unsigned*)(lds + ML_CB))[i] = 0u;
    for (int i = tid; i < (48 * ML_TROW) / 4; i += NTHREADS) ((LAS unsigned*)(lds + ML_VT))[i] = 0u;
    __syncthreads();
    if (tid < 32) ((LAS unsigned*)(lds + ML_VT + 32 * ML_TROW))[tid] = 0x3F803F80u;
    if (tid == 0) sc[320] = 0.f;
    f32x4 Cacc[2][3];
#pragma unroll
    for (int a = 0; a < 2; ++a)
#pragma unroll
        for (int c = 0; c < 3; ++c) Cacc[a][c] = (f32x4){0.f, 0.f, 0.f, 0.f};
    u32x4 rq[4], rkt[4], rv; unsigned rli = 0, rlf = 0; u32x2 rog = (u32x2){0u, 0u};
    const int srow = tid >> 3, sseg = tid & 7;
    const int krow = tid >> 1, khalf = tid & 1;
    const int vrow = tid >> 3, vseg = tid & 7;
    const int tt = w & 3, vtA = (w < 4) ? 0 : 1;
    constexpr int NCHUNK = LP / 64;
#define ML_ISSUE(cc) do { \
        const size_t r0_ = (size_t)b * LP + (size_t)(cc) * 64; \
        const bf16_t* qs_ = PA + (r0_ + srow) * NIN_OA + CA_QM + h * 256 + sseg * 32; \
        _Pragma("unroll") for (int j = 0; j < 4; ++j) rq[j] = *(const u32x4*)(qs_ + 8 * j); \
        const bf16_t* kt_ = KVT + (size_t)(RB_KM + h * 256 + krow) * M + r0_ + khalf * 32; \
        _Pragma("unroll") for (int j = 0; j < 4; ++j) rkt[j] = *(const u32x4*)(kt_ + 8 * j); \
        if (tid < 256) rv = *(const u32x4*)(KVT + (size_t)(RB_VM + h * 256 + v0 + vrow) * M + r0_ + vseg * 8); \
        rog = *(const u32x2*)(PA + (r0_ + 16 * tt + ql) * NIN_OA + CA_OM + h * 256 + v0 + 16 * vtA + 4 * g); \
        if (tid < 64) { rli = PA[(r0_ + tid) * NIN_OA + CA_IM + h]; rlf = PA[(r0_ + tid) * NIN_OA + CA_FM + h]; } \
    } while (0)
    ML_ISSUE(0);
    for (int c = 0; c < NCHUNK; ++c) {
        const size_t r0 = (size_t)b * LP + (size_t)c * 64;
#pragma unroll
        for (int j = 0; j < 4; ++j) { *(LAS u32x4*)(lds + ML_QS + srow * ML_ROW + sseg * 64 + 16 * j) = rq[j];
            *(LAS u32x4*)(lds + ML_KT + krow * ML_TROW + khalf * 64 + 16 * j) = rkt[j]; }
        if (tid < 256) *(LAS u32x4*)(lds + ML_VT + vrow * ML_TROW + vseg * 16) = rv;
        const u32x2 ogc = rog;
        if (w == 0) {
            const float mprev = sc[320];
            const float li_ = bf2f(rli) + b_i, f_ = bf2f(rlf) + b_f, lf_ = fminf(f_, 0.f) - __logf(1.0f + __expf(-fabsf(f_)));
            const float bc = wave_scan_add(lf_);
            const float gg = li_ - bc, pm = wave_scan_max(gg);
            const float Mt = fmaxf(mprev, pm);
            const float M63 = readlane_f(Mt, 63), b63 = readlane_f(bc, 63);
            sc[lane] = gg; sc[64 + lane] = Mt; sc[128 + lane] = bc; sc[256 + lane] = __expf(gg - M63) * 0.0625f;
            if (lane == 0) { sc[321] = __expf(mprev - M63); sc[322] = b63 + M63; sc[323] = mprev; }
        }
        if (c + 1 < NCHUNK && !noload) ML_ISSUE(c + 1);
        RAW_BAR();
        {
            const int ss = w >> 1;
            f32x4 S2[2] = {(f32x4){0.f, 0.f, 0.f, 0.f}, (f32x4){0.f, 0.f, 0.f, 0.f}};
            {
                bf16x8 Ak[8], Bq0[8], Bq1[8];
#pragma unroll
                for (int ks = 0; ks < 8; ++ks) {
                    const LAS unsigned char* ta = lds + ML_KT + (32 * ks + 8 * g + (ql >> 2)) * ML_TROW + (16 * ss + 4 * (ql & 3)) * 2;
                    const s16x4 lo = __builtin_amdgcn_ds_read_tr16_b64_v4i16((LAS s16x4*)ta), hi = __builtin_amdgcn_ds_read_tr16_b64_v4i16((LAS s16x4*)(ta + 4 * ML_TROW));
                    Ak[ks] = (bf16x8){lo[0], lo[1], lo[2], lo[3], hi[0], hi[1], hi[2], hi[3]};
                    Bq0[ks] = *(const LAS bf16x8*)(lds + ML_QS + (16 * (2 * (w & 1)) + ql) * ML_ROW + (32 * ks + 8 * g) * 2);
                    Bq1[ks] = *(const LAS bf16x8*)(lds + ML_QS + (16 * (2 * (w & 1) + 1) + ql) * ML_ROW + (32 * ks + 8 * g) * 2); }
#pragma unroll
                for (int ks = 0; ks < 8; ++ks) { S2[0] = __builtin_amdgcn_mfma_f32_16x16x32_bf16(Ak[ks], Bq0[ks], S2[0], 0, 0, 0); S2[1] = __builtin_amdgcn_mfma_f32_16x16x32_bf16(Ak[ks], Bq1[ks], S2[1], 0, 0, 0); }
            }
            const f32x4 gg4 = *(const LAS f32x4*)(sc + 16 * ss + 4 * g);
#pragma unroll
            for (int j = 0; j < 2; ++j) { const int t = 16 * (2 * (w & 1) + j) + ql; const float Mt = sc[64 + t]; float v[4];
#pragma unroll
                for (int i = 0; i < 4; ++i) { const int s_ = 16 * ss + 4 * g + i; const float e = __expf(fminf(gg4[i] - Mt, 0.f)) * 0.0625f; v[i] = (s_ <= t) ? S2[j][i] * e : 0.f; }
                *(LAS u32x2*)(lds + ML_SD + t * ML_TROW + (16 * ss + 4 * g) * 2) = (u32x2){pk2(v[0], v[1]), pk2(v[2], v[3])}; }
            if (tid < 384) { const int v_ = tid >> 3, sg = tid & 7; const u32x4 vv = *(const LAS u32x4*)(lds + ML_VT + v_ * ML_TROW + sg * 16);
                const f32x4 wa = *(const LAS f32x4*)(sc + 256 + 8 * sg), wb = *(const LAS f32x4*)(sc + 256 + 8 * sg + 4);
                u32x4 o; o.x = pk2(bflo(vv.x) * wa[0], bfhi(vv.x) * wa[1]); o.y = pk2(bflo(vv.y) * wa[2], bfhi(vv.y) * wa[3]); o.z = pk2(bflo(vv.z) * wb[0], bfhi(vv.z) * wb[1]); o.w = pk2(bflo(vv.w) * wb[2], bfhi(vv.w) * wb[3]);
                *(LAS u32x4*)(lds + ML_VW + v_ * ML_TROW + sg * 16) = o; }
        }
        RAW_BAR();
        f32x4 N0 = (f32x4){0.f, 0.f, 0.f, 0.f}, N1 = (f32x4){0.f, 0.f, 0.f, 0.f};
        const int t_ = 16 * tt + ql;
        {
#pragma unroll
            for (int hf = 0; hf < 2; ++hf) {
                bf16x8 Bq[4], Ac[4], Ac2[4];
#pragma unroll
                for (int k4 = 0; k4 < 4; ++k4) { const int ks = 4 * hf + k4; Bq[k4] = *(const LAS bf16x8*)(lds + ML_QS + t_ * ML_ROW + (32 * ks + 8 * g) * 2);
                    Ac[k4] = *(const LAS bf16x8*)(lds + ML_CB + (16 * vtA + ql) * ML_ROW + (32 * ks + 8 * g) * 2);
                    if (w < 4) Ac2[k4] = *(const LAS bf16x8*)(lds + ML_CB + (32 + ql) * ML_ROW + (32 * ks + 8 * g) * 2); }
#pragma unroll
                for (int k4 = 0; k4 < 4; ++k4) { N0 = __builtin_amdgcn_mfma_f32_16x16x32_bf16(Ac[k4], Bq[k4], N0, 0, 0, 0);
                    if (w < 4) N1 = __builtin_amdgcn_mfma_f32_16x16x32_bf16(Ac2[k4], Bq[k4], N1, 0, 0, 0); }
            }
            const float wi = __expf(sc[323] - sc[64 + t_]);
            N0 = N0 * wi; N1 = N1 * wi;
#pragma unroll
            for (int ks = 0; ks < 2; ++ks) { const bf16x8 Bs = *(const LAS bf16x8*)(lds + ML_SD + t_ * ML_TROW + (32 * ks + 8 * g) * 2);
                const bf16x8 Av = *(const LAS bf16x8*)(lds + ML_VT + (16 * vtA + ql) * ML_TROW + (32 * ks + 8 * g) * 2);
                N0 = __builtin_amdgcn_mfma_f32_16x16x32_bf16(Av, Bs, N0, 0, 0, 0);
                if (w < 4) { const bf16x8 Av2 = *(const LAS bf16x8*)(lds + ML_VT + (32 + ql) * ML_TROW + (32 * ks + 8 * g) * 2); N1 = __builtin_amdgcn_mfma_f32_16x16x32_bf16(Av2, Bs, N1, 0, 0, 0); } }
            if (w < 4 && g == 0) sc[192 + t_] = N1[0];
        }
        RAW_BAR();
        {
            const float den = sc[192 + t_], mt = sc[128 + t_] + sc[64 + t_];
            const float inv = 1.0f / fmaxf(fabsf(den), __expf(-mt));
            const float o0 = N0[0] * inv * fast_sigmoid(bflo(ogc.x)), o1 = N0[1] * inv * fast_sigmoid(bfhi(ogc.x)), o2 = N0[2] * inv * fast_sigmoid(bflo(ogc.y)), o3 = N0[3] * inv * fast_sigmoid(bfhi(ogc.y));
#if OUT1_F8
            *(unsigned*)((unsigned char*)Y + (r0 + t_) * D + h * 256 + v0 + 16 * vtA + 4 * g) = pk4_f8(o0 * F8S_Y, o1 * F8S_Y, o2 * F8S_Y, o3 * F8S_Y);
#else
            *(u32x2*)(Y + (r0 + t_) * D + h * 256 + v0 + 16 * vtA + 4 * g) = (u32x2){pk2(o0, o1), pk2(o2, o3)};
#endif
        }
        {
            const float decay = sc[321];
            bf16x8 Bv[3][2];
#pragma unroll
            for (int ks = 0; ks < 2; ++ks)
#pragma unroll
                for (int vt = 0; vt < 3; ++vt) Bv[vt][ks] = *(const LAS bf16x8*)(lds + ML_VW + (16 * vt + ql) * ML_TROW + (32 * ks + 8 * g) * 2);
#pragma unroll
            for (int a = 0; a < 2; ++a) { const int kt = 2 * w + a;
#pragma unroll
                for (int vt = 0; vt < 3; ++vt) Cacc[a][vt] = Cacc[a][vt] * decay;
#pragma unroll
                for (int ks = 0; ks < 2; ++ks) { const bf16x8 Ak = *(const LAS bf16x8*)(lds + ML_KT + (16 * kt + ql) * ML_TROW + (32 * ks + 8 * g) * 2);
#pragma unroll
                    for (int vt = 0; vt < 3; ++vt) Cacc[a][vt] = __builtin_amdgcn_mfma_f32_16x16x32_bf16(Ak, Bv[vt][ks], Cacc[a][vt], 0, 0, 0); }
#pragma unroll
                for (int vt = 0; vt < 3; ++vt) *(LAS u32x2*)(lds + ML_CB + (16 * vt + ql) * ML_ROW + (16 * kt + 4 * g) * 2) = (u32x2){pk2(Cacc[a][vt][0], Cacc[a][vt][1]), pk2(Cacc[a][vt][2], Cacc[a][vt][3])}; }
            if (tid == 0) sc[320] = sc[322];
        }
        RAW_BAR();
    }
#undef ML_ISSUE
}
constexpr int NPHASE = 18;
struct Args { const float* in[35]; float* out; unsigned char* ws; int ph_lo, ph_hi, rep, pad; };
__global__ void __launch_bounds__(NTHREADS, 2) fwd_kernel(Args args) {
    extern __shared__ __attribute__((aligned(16))) unsigned char lds_raw[];
    Frame F;
    F.lds = (LAS unsigned char*)lds_raw;
    F.ws = args.ws; F.ctl = (unsigned*)(args.ws + WS_CTL); F.out = args.out;
#pragma unroll
    for (int i = 0; i < 35; ++i) F.in[i] = args.in[i];
    F.tid = threadIdx.x; F.lane = F.tid & 63; F.wave = __builtin_amdgcn_readfirstlane(F.tid >> 6); F.G = gridDim.x; F.bid = blockIdx.x;
    if (F.tid < 64) ((LAS unsigned*)(F.lds + LDS_MISC))[F.tid] = 0u;
    __syncthreads();
    const int lo = args.ph_lo, hi = args.ph_hi;
    XcdBarrier bar; bar.bar = F.ctl + CW_BAR; bar.x = 0; bar.st = (volatile LAS unsigned*)(F.lds + LDS_MISC + 32);
    if (hi - lo > 1) bar = xcd_barrier_post(F.ctl + CW_BAR, (volatile LAS unsigned*)(F.lds + LDS_MISC + 32));
#define IN(k) (lo <= (k) && (k) < hi)
#define SEAM(k) do { if (IN(k) && IN((k) + 1)) xcd_barrier(bar); } while (0)
    unsigned char* ws = args.ws;
    const int nM = M / 256, nF = 2 * SEQ / 256;

    if (IN(0)) { p0_prologue(F); } SEAM(0);
    if (IN(1)) {
        s5_build_matrices(F);
        pg8::skinny_phase<0, 2>(F.lds, F.bid, F.G, F.wave, F.lane, ws + WS_HA, (size_t)D * 2, D * 2, NIN_E / 32, pg8::SkRowsLin{ws + WS_WINE, D * 2, 2}, pg8::SkFinBf16{(bf16_t*)(ws + WS_P), NIN_E});
        pg8::LinProv S; S.so.init(nF, NIN_E / 256, F.G, F.bid); S.Bt = (const char*)(ws + WS_WINE); S.K = D; S.frames = 1;
        pg8::EpiBf16 E{(bf16_t*)(ws + WS_P), NIN_E}; E.frames = 1;
        pg8::gemm_phase(F.lds, (const char*)(ws + WS_HA), D, S, E); } SEAM(1);
    if (IN(2)) { if (F.bid < 64) { if (!(args.rep && PROBE_ML == 2)) s5_ssd_unit<false>(F, F.bid >> 5, F.bid & 31, 0); } else { if (!(args.rep && PROBE_ML == 1)) conv_phase(F, 64, F.G - 64); } } do { if (IN(2) && IN(4)) xcd_barrier(bar); } while (0);
    if (IN(4)) {
        pg8::skinny_phase<0, 1>(F.lds, F.bid, F.G, F.wave, F.lane, ws + WS_Y, (size_t)D * 2, D * 2, D / 16, pg8::SkRowsLin{ws + WS_WOUTE, D * 2, 1}, pg8::SkFinRes{(bf16_t*)(ws + WS_PRE), (const bf16_t*)(ws + WS_HA), D, ALPHA, 1.f});
        pg8::LinProv S; S.so.init(nF, D / 256, F.G, F.bid); S.Bt = (const char*)(ws + WS_WOUTE); S.K = D; S.frames = 1;
        pg8::EpiResBf16 E{(bf16_t*)(ws + WS_PRE), (const bf16_t*)(ws + WS_HA), D, ALPHA, 1};
        pg8::gemm_phase(F.lds, (const char*)(ws + WS_Y), D, S, E); } SEAM(4);
    if (IN(5)) { ln_phase<false, 2>(F, (const bf16_t*)(ws + WS_PRE), (bf16_t*)(ws + WS_HB), F.in[I_LN1G], F.in[I_LN1B], ws + WS_HBF8); } SEAM(5);
    if (IN(6)) {
        pg8::skinny_phase<2, 4>(F.lds, F.bid, F.G, F.wave, F.lane, ws + WS_HBF8, (size_t)D, D, DFF / 32, pg8::SkRowsGated{ws + WS_W13, D}, pg8::SkFinGated<FFN_DOWN_F8 != 0>{ws + WS_P, DFF, 1.f / (I8S_H * I8S_W13), F8S_GH});
        pg8::LinProv S; S.so.init(nF, N13 / 256, F.G, F.bid); S.Bt = (const char*)(ws + WS_W13); S.K = D / 2; S.frames = 1;
#if FFN_DOWN_F8
        pg8::EpiGatedF8 E{ws + WS_P, DFF, 1.f / (I8S_H * I8S_W13), F8S_GH, 1};
        pg8::gemm_phase<pg8::EpiGatedF8, pg8::LinProv, 2>(F.lds, (const char*)(ws + WS_HBF8), D / 2, S, E); } SEAM(6);
#else
        pg8::EpiGatedS E{(bf16_t*)(ws + WS_P), DFF, 1.f / (I8S_H * I8S_W13), 1};
        pg8::gemm_phase<pg8::EpiGatedS, pg8::LinProv, 2>(F.lds, (const char*)(ws + WS_HBF8), D / 2, S, E); } SEAM(6);
#endif
    if (IN(7)) {
#if FFN_DOWN_F8
        pg8::skinny_phase<1, 1>(F.lds, F.bid, F.G, F.wave, F.lane, ws + WS_P, (size_t)DFF, DFF, D / 16, pg8::SkRowsLin{ws + WS_W2, DFF, 1}, pg8::SkFinRes{(bf16_t*)(ws + WS_PRE), (const bf16_t*)(ws + WS_HB), D, ALPHA, 1.f / (F8S_GH * F8S_W2)});
        pg8::LinProv S; S.so.init(nF, D / 256, F.G, F.bid); S.Bt = (const char*)(ws + WS_W2); S.K = DFF / 2; S.frames = 1;
        pg8::EpiResBf16S E{(bf16_t*)(ws + WS_PRE), (const bf16_t*)(ws + WS_HB), D, ALPHA, 1.f / (F8S_GH * F8S_W2), 1};
        pg8::gemm_phase<pg8::EpiResBf16S, pg8::LinProv, 1>(F.lds, (const char*)(ws + WS_P), DFF / 2, S, E); } SEAM(7);
#else
        pg8::skinny_phase<0, 1>(F.lds, F.bid, F.G, F.wave, F.lane, ws + WS_P, (size_t)DFF * 2, DFF * 2, D / 16, pg8::SkRowsLin{ws + WS_W2, DFF * 2, 1}, pg8::SkFinRes{(bf16_t*)(ws + WS_PRE), (const bf16_t*)(ws + WS_HB), D, ALPHA, 1.f});
        pg8::LinProv S; S.so.init(nF, D / 256, F.G, F.bid); S.Bt = (const char*)(ws + WS_W2); S.K = DFF; S.frames = 1;
        pg8::EpiResBf16 E{(bf16_t*)(ws + WS_PRE), (const bf16_t*)(ws + WS_HB), D, ALPHA, 1};
        pg8::gemm_phase(F.lds, (const char*)(ws + WS_P), DFF, S, E); } SEAM(7);
#endif
    if (IN(8)) { ln_phase<false>(F, (const bf16_t*)(ws + WS_PRE), (bf16_t*)(ws + WS_H2), F.in[I_LN2G], F.in[I_LN2B]); } SEAM(8);
    if (IN(9)) {
        { pg8::LinProv S; S.so.init(nM, NIN_OA / 256, F.G, F.bid); S.Bt = (const char*)(ws + WS_WINOA); S.K = D;
          pg8::EpiBf16 E{(bf16_t*)(ws + WS_P), NIN_OA, (bf16_t*)(ws + WS_KIC), CA_KI / 256};
          pg8::gemm_phase(F.lds, (const char*)(ws + WS_H2), D, S, E); }
        { const int ra = (nM * (NIN_OA / 256)) % F.G, rb = ((NIN_OB / 256) * nM) % F.G; int sh = (ra + 7) & ~7; if (sh + rb > F.G || (F.G & 7)) sh = 0;
          pg8::LinProv S; S.so.init(NIN_OB / 256, nM, F.G, (F.bid + F.G - sh) % F.G); S.Bt = (const char*)(ws + WS_H2); S.K = D;
          pg8::EpiBf16 E{(bf16_t*)(ws + WS_KVT), M};
          pg8::gemm_phase(F.lds, (const char*)(ws + WS_WINOB), D, S, E); } } SEAM(9);
    if (IN(10)) { d1_phase(F, args.rep); if (F.wave >= 4 && !args.rep) convert_experts(F); } SEAM(10);
    #ifndef PROBE_G3
#define PROBE_G3 1
#endif
#ifndef PROBE_ML
#define PROBE_ML 0
#endif
    if (IN(11)) { if (F.bid < 64) { if (!(args.rep && PROBE_ML == 2)) mlstm_worker(F, F.lds, F.bid, args.rep && PROBE_ML == 3); }
        if (!(args.rep && (PROBE_ML == 1 || PROBE_ML == 3))) d2_worker(F, F.lds, args.rep); } SEAM(11);
    if (IN(12)) {
#if OUT1_F8
        pg8::LinProv S; S.so.init(nF, D / 256, F.G, F.bid); S.Bt = (const char*)(ws + WS_WOUTO); S.K = D / 2; S.frames = 1;
        pg8::EpiResBf16S E{(bf16_t*)(ws + WS_PRE1), (const bf16_t*)(ws + WS_H2), D, ALPHA, 1.f / (F8S_Y * F8S_WOUT), 1};
        pg8::gemm_phase<pg8::EpiResBf16S, pg8::LinProv, 1>(F.lds, (const char*)(ws + WS_Y), D / 2, S, E); } SEAM(12);
#else
        pg8::LinProv S; S.so.init(nF, D / 256, F.G, F.bid); S.Bt = (const char*)(ws + WS_WOUTO); S.K = D; S.frames = 1;
        pg8::EpiResBf16 E{(bf16_t*)(ws + WS_PRE1), (const bf16_t*)(ws + WS_H2), D, ALPHA, 1};
        pg8::gemm_phase(F.lds, (const char*)(ws + WS_Y), D, S, E); } SEAM(12);
#endif
    if (IN(13)) { if (!args.rep) ln_phase<true>(F, (const bf16_t*)(ws + WS_PRE1), (bf16_t*)(ws + WS_H3), F.in[I_LN3G], F.in[I_LN3B], ws + WS_H3F8); } SEAM(13);
    if (IN(14)) { route_phase(F); } SEAM(14);
    const int* TL = (const int*)(ws + WS_MOE + MO_TILEE);
#define MOE_UP(tlo, cnt) do { pg8::GatherProv S; S.so.init((cnt), N13 / 256, F.G, F.bid); S.Bt = (const char*)(ws + WS_EW13); S.K = D / 2; S.rowidx = (const int*)(ws + WS_MOE + MO_SLOTTOK); S.tile_e = TL; S.t_lo = (tlo); S.estride = (size_t)N13 * D; \
        pg8::EpiGatedF8 E{ws + WS_GH, DFF, 1.f / (F8S_H3 * F8S_W13), F8S_GH}; pg8::gemm_phase<pg8::EpiGatedF8, pg8::GatherProv, 1>(F.lds, (const char*)(ws + WS_H3F8), D / 2, S, E); } while (0)
#define MOE_DOWN(tlo, cnt) do { pg8::GatherProv S; S.so.init((cnt), D / 256, F.G, F.bid); S.Bt = (const char*)(ws + WS_EW2); S.K = DFF / 2; S.rowidx = nullptr; S.tile_e = TL; S.t_lo = (tlo); S.estride = (size_t)D * DFF; \
        pg8::EpiBf16S E{(bf16_t*)(ws + WS_YB) + (size_t)(tlo) * 256 * D, D, 1.f / (F8S_GH * F8S_W2)}; pg8::gemm_phase<pg8::EpiBf16S, pg8::GatherProv, 1>(F.lds, (const char*)(ws + WS_GH), DFF / 2, S, E); } while (0)
    if (IN(15)) { const int nt = __builtin_amdgcn_readfirstlane(TL[300]); MOE_UP(0, nt); } SEAM(15);
    if (IN(16)) { const int nt = __builtin_amdgcn_readfirstlane(TL[300]); MOE_DOWN(0, nt); } SEAM(16);
    if (IN(17)) { final_phase(F); }
#undef IN
#undef SEAM
}

extern "C" void kernel_launch(void* const* d_in, const int* in_sizes, int n_in, void* d_out, int out_size, void* d_ws, size_t ws_size, hipStream_t stream) {
    static int grid = 0;
    if (grid == 0) {
        int dev = 0, cus = 0;
        if (n_in != 35 || ws_size < WS_END) { fprintf(stderr, "kernel_launch: expected 35 inputs and >= %zu bytes of workspace (got %d, %zu)\n", (size_t)WS_END, n_in, ws_size); grid = -1; return; }
        if (hipGetDevice(&dev) != hipSuccess || hipDeviceGetAttribute(&cus, hipDeviceAttributeMultiprocessorCount, dev) != hipSuccess) { grid = -1; return; }
        if (hipFuncSetAttribute((const void*)fwd_kernel, hipFuncAttributeMaxDynamicSharedMemorySize, LDS_BYTES) != hipSuccess) { fprintf(stderr, "kernel_launch: hipFuncSetAttribute failed\n"); grid = -1; return; }
        int per_cu = 0;
        (void)hipOccupancyMaxActiveBlocksPerMultiprocessor(&per_cu, (const void*)fwd_kernel, NTHREADS, LDS_BYTES);
        (void)hipGetLastError();
        grid = cus;
        if (per_cu < 1) fprintf(stderr, "kernel_launch: occupancy query reports %d\n", per_cu);
    }
    if (grid < 0) return;
    (void)in_sizes; (void)out_size;
    hipMemsetAsync((char*)d_ws + WS_CTL, 0, 65536, stream);
    Args a; memset(&a, 0, sizeof(a));
    for (int i = 0; i < 35; ++i) a.in[i] = (const float*)d_in[i];
    a.out = (float*)d_out; a.ws = (unsigned char*)d_ws;
#if MK_N_LAUNCHES == 1
    a.ph_lo = 0; a.ph_hi = NPHASE;
    hipLaunchKernelGGL(fwd_kernel, dim3(grid), dim3(NTHREADS), LDS_BYTES, stream, a);
#else
#ifndef PROBE_REP
#define PROBE_REP 0
#endif
    for (int p = 0; p < NPHASE; ++p) { a.ph_lo = p; a.ph_hi = p + 1;
        if ((PROBE_REP >> p) & 1) { a.rep = 1; hipLaunchKernelGGL(fwd_kernel, dim3(grid), dim3(NTHREADS), LDS_BYTES, stream, a); }
        a.rep = 0; hipLaunchKernelGGL(fwd_kernel, dim3(grid), dim3(NTHREADS), LDS_BYTES, stream, a); }
#endif
}
```

```cpp
#include <hip/hip_runtime.h>
#include <cstdio>
#include <cstdint>
#include <cstring>

#define LAS __attribute__((address_space(3)))
#define GAS __attribute__((address_space(1)))
typedef unsigned short bf16_t;
typedef short bf16x8 __attribute__((ext_vector_type(8)));
typedef float f32x4 __attribute__((ext_vector_type(4)));
typedef float f32x16 __attribute__((ext_vector_type(16)));
typedef float f32x2 __attribute__((ext_vector_type(2)));
typedef unsigned u32x4 __attribute__((ext_vector_type(4)));
typedef unsigned u32x2 __attribute__((ext_vector_type(2)));

#ifndef MK_N_LAUNCHES
#define MK_N_LAUNCHES 1
#endif

constexpr int D = 2048, NB = 2, SEQ = 16384, NMETA = 16, LR = 16400, LP = 16512, M = NB * LP;
constexpr int DCONV = 1536, DSSM = 512, NIN_E = 5120, DFF = 5632, N13 = 2 * DFF;
constexpr int NIN_OA = 5120, NIN_OB = 3072;
constexpr int CA_QM = 0, CA_IM = 1024, CA_FM = 1028, CA_WI = 1032, CA_OM = 4096;
constexpr int NA_BF = 1280;
constexpr int T8P = 2560, T8_QI = 0, T8_QD = 512, T8_KD = 1536;
constexpr int RB_KM = 0, RB_VM = 1024, RB_VD = 2048;
constexpr float ALPHA = 1.41421356237309515f;
constexpr float LN_EPS = 1e-5f;
constexpr int S5CH = 128, S5NCH = LP / S5CH;
constexpr int NEXP = 8, MOE_CAP_TILES = 265, MOE_CAP = MOE_CAP_TILES * 256;
constexpr int BMP_PITCH = 544;
constexpr int NWAVES = 8, NTHREADS = 512;

constexpr size_t MiB = 1u << 20;
constexpr size_t WS_CTL = 0, CTL_BYTES = 1 * MiB;
constexpr size_t WS_WINE = 1 * MiB, WS_WOUTE = 21 * MiB, WS_W13 = 29 * MiB, WS_W2 = 73 * MiB, WS_WINOA = 95 * MiB, WS_WINOB = 118 * MiB;
constexpr size_t WS_HA = 138 * MiB, WS_HB = 267 * MiB, WS_PRE = 396 * MiB;
constexpr size_t WS_EW13 = 1 * MiB, WS_EW2 = 353 * MiB, WS_YB = 1 * MiB;
constexpr size_t WS_P = 529 * MiB, WS_KVT = 900 * MiB, WS_BMP = 1094 * MiB, WS_Y = 1163 * MiB, WS_PRE1 = 529 * MiB, WS_GH = 529 * MiB;
constexpr size_t WS_H2 = 1292 * MiB, WS_H3 = 1421 * MiB;
constexpr size_t WS_WINOA8 = 104 * MiB, WS_WINOB8 = 130 * MiB;
constexpr size_t WS_H2I8 = WS_HB;
constexpr size_t WS_HBF8 = WS_HA;
constexpr size_t WS_H3F8 = 270 * MiB;
constexpr size_t WS_XE = 1550 * MiB;
constexpr size_t WS_S5T = WS_XE + 3584 * 1024;
constexpr size_t WS_MOE = 1555 * MiB;
constexpr size_t WS_KIC = 1558 * MiB;
constexpr size_t WS_WOUTO = 1563 * MiB;
constexpr size_t WS_END = 1571 * MiB;
constexpr size_t MO_TOKE = 0, MO_TOKG = 512 * 1024, MO_TOKPOS = 1024 * 1024, MO_TOKSLOT = 1536 * 1024, MO_SLOTTOK = 2048 * 1024, MO_TILEE = 2560 * 1024;
constexpr int CW_BAR = 0;
constexpr int CW_CNT = 4096;
constexpr int CW_Q2 = 8192;
constexpr int CW_Q1 = 8448;

constexpr int LDS_BYTES = 163840;
constexpr int LDS_MISC = 163840 - 256;
constexpr int D1_WAVE_BYTES = 36032;

#define LDS_WAIT() asm volatile("s_waitcnt lgkmcnt(0)" ::: "memory")
#define VM_WAIT() asm volatile("s_waitcnt vmcnt(0)" ::: "memory")
#define RAW_BAR() do { asm volatile("s_waitcnt lgkmcnt(0)" ::: "memory"); __builtin_amdgcn_s_barrier(); asm volatile("" ::: "memory"); } while (0)
#ifndef H16
#define H16 1
#endif
typedef _Float16 f16x2_t __attribute__((ext_vector_type(2)));
typedef _Float16 f16x8_t __attribute__((ext_vector_type(8)));
#if H16
__device__ __forceinline__ float bf2f(unsigned v) { return (float)__builtin_bit_cast(_Float16, (unsigned short)v); }
__device__ __forceinline__ float bflo(unsigned w) { return (float)__builtin_bit_cast(f16x2_t, w)[0]; }
__device__ __forceinline__ float bfhi(unsigned w) { return (float)__builtin_bit_cast(f16x2_t, w)[1]; }
__device__ __forceinline__ unsigned f2bf(float f) { return (unsigned)__builtin_bit_cast(unsigned short, (_Float16)f); }
constexpr unsigned ONE16X2 = 0x3C003C00u;
#else
__device__ __forceinline__ float bf2f(unsigned v) { return __uint_as_float(v << 16); }
__device__ __forceinline__ float bflo(unsigned w) { return __uint_as_float(w << 16); }
__device__ __forceinline__ float bfhi(unsigned w) { return __uint_as_float(w & 0xffff0000u); }
__device__ __forceinline__ unsigned f2bf(float f) { unsigned u = __float_as_uint(f); return (u + 0x7fffu + ((u >> 16) & 1u)) >> 16; }
constexpr unsigned ONE16X2 = 0x3F803F80u;
#endif
typedef __bf16 bf16x2_t __attribute__((ext_vector_type(2)));
__device__ __forceinline__ float bf2f_b(unsigned v) { return __uint_as_float(v << 16); }
__device__ __forceinline__ float bflo_b(unsigned w) { return __uint_as_float(w << 16); }
__device__ __forceinline__ float bfhi_b(unsigned w) { return __uint_as_float(w & 0xffff0000u); }
__device__ __forceinline__ unsigned pk2_b(float lo, float hi) { bf16x2_t v; v[0] = (__bf16)lo; v[1] = (__bf16)hi; return __builtin_bit_cast(unsigned, v); }
__device__ __forceinline__ unsigned pk4_bf8(float a, float b, float c, float d) { int w = __builtin_amdgcn_cvt_pk_bf8_f32(a, b, 0, false); w = __builtin_amdgcn_cvt_pk_bf8_f32(c, d, w, true); return (unsigned)w; }
__device__ __forceinline__ unsigned pk4_f8(float a, float b, float c, float d) {
    a = __builtin_amdgcn_fmed3f(a, -448.f, 448.f); b = __builtin_amdgcn_fmed3f(b, -448.f, 448.f); c = __builtin_amdgcn_fmed3f(c, -448.f, 448.f); d = __builtin_amdgcn_fmed3f(d, -448.f, 448.f);
    int w = __builtin_amdgcn_cvt_pk_fp8_f32(a, b, 0, false); w = __builtin_amdgcn_cvt_pk_fp8_f32(c, d, w, true); return (unsigned)w; }
__device__ __forceinline__ unsigned pk4_i8(float a, float b, float c, float d) {
    const int ia = (int)__builtin_rintf(__builtin_amdgcn_fmed3f(a, -127.f, 127.f)), ib = (int)__builtin_rintf(__builtin_amdgcn_fmed3f(b, -127.f, 127.f));
    const int ic = (int)__builtin_rintf(__builtin_amdgcn_fmed3f(c, -127.f, 127.f)), id = (int)__builtin_rintf(__builtin_amdgcn_fmed3f(d, -127.f, 127.f));
    return (unsigned)(ia & 255) | ((unsigned)(ib & 255) << 8) | ((unsigned)(ic & 255) << 16) | ((unsigned)id << 24); }
constexpr float I8S_H = 28.f, I8S_W13 = 1280.f;
#ifndef FFN_DOWN_F8
#define FFN_DOWN_F8 1
#endif
constexpr float F8S_H3 = 8.f, F8S_W13 = 512.f, F8S_GH = 4.f, F8S_W2 = 2048.f;
constexpr float F8S_V = 8.f;
constexpr size_t WS_VT8 = 856 * MiB;
constexpr float F8S_QK = 8.f;
constexpr size_t WS_QK8 = 448 * MiB;
constexpr float F8S_YB = 64.f;
constexpr float F8S_Y = 4.f, F8S_WOUT = 1024.f;
#ifndef OUT1_F8
#define OUT1_F8 1
#endif
template <class TA, class TB> __device__ __forceinline__ f32x4 MFMA16_b(const TA& a, const TB& b, const f32x4 c, int, int, int) { return __builtin_amdgcn_mfma_f32_16x16x32_bf16(__builtin_bit_cast(bf16x8, a), __builtin_bit_cast(bf16x8, b), c, 0, 0, 0); }
#if H16
__device__ __forceinline__ unsigned pk2(float lo, float hi) { f16x2_t v; v[0] = (_Float16)lo; v[1] = (_Float16)hi; return __builtin_bit_cast(unsigned, v); }
template <class TA, class TB> __device__ __forceinline__ f32x4 MFMA16(const TA& a, const TB& b, const f32x4 c, int, int, int) { return __builtin_amdgcn_mfma_f32_16x16x32_f16(__builtin_bit_cast(f16x8_t, a), __builtin_bit_cast(f16x8_t, b), c, 0, 0, 0); }
#else
__device__ __forceinline__ unsigned pk2(float lo, float hi) { bf16x2_t v; v[0] = (__bf16)lo; v[1] = (__bf16)hi; return __builtin_bit_cast(unsigned, v); }
template <class TA, class TB> __device__ __forceinline__ f32x4 MFMA16(const TA& a, const TB& b, const f32x4 c, int, int, int) { return __builtin_amdgcn_mfma_f32_16x16x32_bf16(__builtin_bit_cast(bf16x8, a), __builtin_bit_cast(bf16x8, b), c, 0, 0, 0); }
#endif
template <int CTRL, int ROWMASK> __device__ __forceinline__ float dpp_add_f(float v) { return v + __int_as_float(__builtin_amdgcn_update_dpp(0, __float_as_int(v), CTRL, ROWMASK, 0xf, false)); }
__device__ __forceinline__ float wave_sum(float v) {
    v = dpp_add_f<0x111, 0xf>(v); v = dpp_add_f<0x112, 0xf>(v); v = dpp_add_f<0x114, 0xf>(v); v = dpp_add_f<0x118, 0xf>(v);
    v = dpp_add_f<0x142, 0xa>(v); v = dpp_add_f<0x143, 0xc>(v);
    return __int_as_float(__builtin_amdgcn_readlane(__float_as_int(v), 63));
}
__device__ __forceinline__ float fast_sigmoid(float x) { return __builtin_amdgcn_rcpf(1.0f + __expf(-x)); }

#define XB_TMO      128
#define XB_XCNT(j)  (256  + 64 * (j))
#define XB_XSUB(j)  (1280 + 64 * (j))
#define XB_XGEN(j)  (2304 + 64 * (j))
#define XB_TOP      3328
#define XB_TOPGEN   3392
#define XCD_BAR_WORDS 3456
#define XB_SPIN_CAP (1u << 22)

__device__ __forceinline__ unsigned xb_ld(unsigned* p)              { return __hip_atomic_load(p, __ATOMIC_RELAXED, __HIP_MEMORY_SCOPE_AGENT); }
__device__ __forceinline__ unsigned xb_add(unsigned* p, unsigned v) { return __hip_atomic_fetch_add(p, v, __ATOMIC_RELAXED, __HIP_MEMORY_SCOPE_AGENT); }
__device__ __forceinline__ unsigned xb_xcc_id() { return (unsigned)__builtin_amdgcn_s_getreg((3 << 11) | 20) & 0xFu; }
#define XB_SPIN(cond, bar) do { unsigned _sp = 0; while (cond) { __builtin_amdgcn_s_sleep(1); \
    if ((++_sp & 255u) == 0u) { if (xb_ld(&(bar)[XB_TMO])) break; if (_sp > XB_SPIN_CAP) { atomicAdd(&(bar)[XB_TMO], 1u); break; } } } } while (0)

struct XcdBarrier { unsigned* bar; unsigned x; volatile LAS unsigned* st; };

__device__ __forceinline__ XcdBarrier xcd_barrier_post(unsigned* bar, volatile LAS unsigned* st) {
    XcdBarrier b; b.bar = bar; b.x = xb_xcc_id(); b.st = st;
    if (threadIdx.x == 0) (void)xb_add(&bar[XB_XCNT(b.x)], 1u);
    return b;
}
__device__ __forceinline__ void xcd_barrier_complete(unsigned* bar, unsigned x, unsigned& nloc, unsigned& nx) {
    const unsigned G = gridDim.x * gridDim.y * gridDim.z;
    unsigned sum, cnt, mine, sp = 0u;
    for (;;) {
        sum = 0u; cnt = 0u; mine = 0u;
#pragma unroll
        for (unsigned j = 0; j < 16; ++j) { const unsigned c = xb_ld(&bar[XB_XCNT(j)]); sum += c; cnt += (c > 0u) ? 1u : 0u; mine = (j == x) ? c : mine; }
        if (sum == G) break;
        __builtin_amdgcn_s_sleep(1);
        if ((++sp & 255u) == 0u) { if (xb_ld(&bar[XB_TMO])) break; if (sp > XB_SPIN_CAP) { atomicAdd(&bar[XB_TMO], 1u); break; } }
    }
    nloc = mine > 0u ? mine : 1u; nx = cnt > 0u ? cnt : 1u;
}
__device__ __forceinline__ void xcd_barrier(const XcdBarrier& b) {
    asm volatile("s_waitcnt vmcnt(0)" ::: "memory");
    __syncthreads();
    if (threadIdx.x == 0) {
        unsigned* bar = b.bar;
        __builtin_amdgcn_s_waitcnt(0);
        unsigned nloc = b.st[0], nx = b.st[1];
        if (nloc == 0u) { xcd_barrier_complete(bar, b.x, nloc, nx); b.st[0] = nloc; b.st[1] = nx; }
        const unsigned old = xb_add(&bar[XB_XSUB(b.x)], 1u);
        const unsigned gen = old / nloc;
        if (old + 1u == (gen + 1u) * nloc) {
            __builtin_amdgcn_fence(__ATOMIC_RELEASE, "agent");
            asm volatile("s_waitcnt vmcnt(0)" ::: "memory");
            const unsigned og = xb_add(&bar[XB_TOP], 1u);
            const unsigned tg = og / nx;
            if (og + 1u == (tg + 1u) * nx) xb_add(&bar[XB_TOPGEN], 1u);
            else XB_SPIN(xb_ld(&bar[XB_TOPGEN]) == tg, bar);
            __builtin_amdgcn_fence(__ATOMIC_ACQUIRE, "agent");
            xb_add(&bar[XB_XGEN(b.x)], 1u);
            asm volatile("s_waitcnt vmcnt(0)" ::: "memory");
        } else {
            XB_SPIN(xb_ld(&bar[XB_XGEN(b.x)]) == gen, bar);
            __builtin_amdgcn_fence(__ATOMIC_ACQUIRE, "agent");
            asm volatile("s_waitcnt vmcnt(0)" ::: "memory");
        }
    }
    __syncthreads();
}
#define PROBE_REP 0
#define PROBE_ML 0
#define PROBE_D1 0
#define PROBE_D2 0
#define PROBE_G3 1
namespace pg8 {
constexpr int BM = 256, BK = 64, HALF = 128, HTB = HALF * BK * 2, STAGE_BYTES = 8 * HTB, NXCD = 8, WGM = 8;
__host__ __device__ __forceinline__ int lds_byte(int r, int c) { const int st = (r >> 4) * 2 + (c >> 5), rr = r & 15, cc = c & 31, ob = rr * 64 + cc * 2; return st * 1024 + (ob ^ (((ob >> 9) & 1) << 5)); }
__host__ __device__ __forceinline__ void stage_rc(int b, int& R, int& C) { const int st = b / 1024, sb = b % 1024, swz = sb ^ (((sb >> 9) & 1) << 5); R = (st >> 1) * 16 + swz / 64; C = (st & 1) * 32 + (swz % 64) / 2; }
__host__ __device__ __forceinline__ int perm32(int rho) { const int n = rho >> 4, i = rho & 15; return 8 * (i >> 2) + 4 * n + (i & 3); }

typedef int i32x4v __attribute__((ext_vector_type(4)));
typedef int i32x8v __attribute__((ext_vector_type(8)));
struct Unit { int pm, pn; };
__device__ __forceinline__ int frame_row0(int pm) { return (pm >> 6) * LP + NMETA + (pm & 63) * BM; }
struct StaticOrder {
    int nM, nN, nwg, G, c;
    __device__ void init(int nM_, int nN_, int G_, int c_) { nM = nM_; nN = nN_; nwg = nM * nN; G = G_; c = c_; }
    __device__ bool next(int i, Unit& u) const {
        const long L = (long)i * G + c; if (L >= nwg) return false;
        int wgid = (int)L; { const int q = nwg / NXCD, r = nwg % NXCD, xcd = wgid % NXCD, off = wgid / NXCD; wgid = (xcd < r ? xcd * (q + 1) : r * (q + 1) + (xcd - r) * q) + off; }
        const int nig = WGM * nN, gid = wgid / nig, fm = gid * WGM, gsz = (nM - fm) < WGM ? (nM - fm) : WGM;
        u.pm = fm + ((wgid % nig) % gsz); u.pn = (wgid % nig) / gsz; return true;
    }
};
struct LinProv {
    StaticOrder so; const char* Bt; int K; int probe_same = 0; int frames = 0;
    __device__ __forceinline__ bool next(int i, Unit& u) const { const bool r = so.next(i, u); if (probe_same) { u.pm &= 3; u.pn &= 3; } return r; }
    __device__ __forceinline__ void aoffs(const Unit& u, const int (&RA)[2], const int (&CA)[2], unsigned (&v)[2][2]) const {
#pragma unroll
        for (int h = 0; h < 2; ++h)
#pragma unroll
            for (int i = 0; i < 2; ++i) v[h][i] = (unsigned)(((frames ? frame_row0(u.pm) : u.pm * BM) + h * HALF + RA[i]) * K + CA[i]) * 2u;
    }
    __device__ __forceinline__ const char* bbase(const Unit& u) const { return Bt + (size_t)u.pn * BM * K * 2; }
};
struct GatherProv {
    StaticOrder so; const char* Bt; int K; const int* rowidx; const int* tile_e; int t_lo; size_t estride;
    __device__ __forceinline__ bool next(int i, Unit& u) const { return so.next(i, u); }
    __device__ __forceinline__ void aoffs(const Unit& u, const int (&RA)[2], const int (&CA)[2], unsigned (&v)[2][2]) const {
#pragma unroll
        for (int h = 0; h < 2; ++h)
#pragma unroll
            for (int i = 0; i < 2; ++i) { const int row = rowidx ? rowidx[(t_lo + u.pm) * BM + h * HALF + RA[i]] : (u.pm * BM + h * HALF + RA[i]); v[h][i] = (unsigned)(row * K + CA[i]) * 2u; }
    }
    __device__ __forceinline__ const char* bbase(const Unit& u) const { const int e = __builtin_amdgcn_readfirstlane(tile_e[t_lo + u.pm]); return Bt + (size_t)e * estride + (size_t)u.pn * BM * K * 2; }
};

struct EpiBf16 {
    static constexpr bool PERM = true;
    bf16_t* O; int ldc; bf16_t* X = nullptr; int xpn = -1; int frames = 0; int b16 = 0; int q8off = 0; int q8lo = 0;
    __device__ __forceinline__ void operator()(const f32x4 (&acc)[2][2][4][2], const Unit& u, int wr, int wc, int fr, int fq) const {
        const int row0 = (frames ? frame_row0(u.pm) : u.pm * BM) + wr * 64 + fr, col0 = u.pn * BM + wc * 32 + 8 * fq;
        const bool xc = (u.pn == xpn) && (wc < 2);
#pragma unroll
        for (int ai = 0; ai < 2; ++ai)
#pragma unroll
            for (int m = 0; m < 4; ++m) { bf16_t* rowp = O + (size_t)(row0 + ai * HALF + m * 16) * ldc + col0;
#pragma unroll
                for (int bj = 0; bj < 2; ++bj) { const f32x4 v0 = acc[ai][bj][m][0], v1 = acc[ai][bj][m][1];
                    u32x4 w;
                    if (b16) { w.x = pk2_b(v0[0], v0[1]); w.y = pk2_b(v0[2], v0[3]); w.z = pk2_b(v1[0], v1[1]); w.w = pk2_b(v1[2], v1[3]); }
                    else { w.x = pk2(v0[0], v0[1]); w.y = pk2(v0[2], v0[3]); w.z = pk2(v1[0], v1[1]); w.w = pk2(v1[2], v1[3]); }
                    *(u32x4*)(rowp + bj * HALF) = w;
                    if (q8off != 0 && u.pn >= q8lo && u.pn < q8lo + 8)
                        *(u32x2*)((unsigned char*)O + (long)q8off * 524288 + (size_t)(row0 + ai * HALF + m * 16) * 2048 + (u.pn - q8lo) * BM + wc * 32 + 8 * fq + bj * HALF) =
                            (u32x2){pk4_f8(v0[0] * F8S_QK, v0[1] * F8S_QK, v0[2] * F8S_QK, v0[3] * F8S_QK), pk4_f8(v1[0] * F8S_QK, v1[1] * F8S_QK, v1[2] * F8S_QK, v1[3] * F8S_QK)};
                    if (bj == 0 && xc)
                        *(u32x2*)((unsigned char*)X + (size_t)(row0 + ai * HALF + m * 16) * 64 + fq * 16 + wc * 8) =
                            (u32x2){pk4_f8(v0[0] * F8S_QK, v0[1] * F8S_QK, v0[2] * F8S_QK, v0[3] * F8S_QK), pk4_f8(v1[0] * F8S_QK, v1[1] * F8S_QK, v1[2] * F8S_QK, v1[3] * F8S_QK)}; } }
    }
};
struct EpiGated {
    static constexpr bool PERM = true;
    bf16_t* O; int ldc; int nostore;
    __device__ __forceinline__ void operator()(const f32x4 (&acc)[2][2][4][2], const Unit& u, int wr, int wc, int fr, int fq) const {
        if (nostore == 1) return;
        if (nostore == 2) {
            const int wv = wr * 4 + wc; char* slab = (char*)O + ((size_t)(u.pm * 44 + u.pn) * 8 + wv) * 8192 + (fq * 16 + fr) * 16;
#pragma unroll
            for (int ai = 0; ai < 2; ++ai)
#pragma unroll
                for (int m = 0; m < 4; ++m) { float r[8];
#pragma unroll
                    for (int n = 0; n < 2; ++n)
#pragma unroll
                        for (int j = 0; j < 4; ++j) { const float a = acc[ai][0][m][n][j], b = acc[ai][1][m][n][j]; r[n * 4 + j] = a * b * __builtin_amdgcn_rcpf(1.0f + __expf(-a)); }
                    u32x4 w; w.x = pk2(r[0], r[1]); w.y = pk2(r[2], r[3]); w.z = pk2(r[4], r[5]); w.w = pk2(r[6], r[7]);
                    *(u32x4*)(slab + (ai * 4 + m) * 1024) = w; }
            return; }
        const int row0 = u.pm * BM + wr * 64 + fr, col0 = u.pn * HALF + wc * 32 + 8 * fq;
#pragma unroll
        for (int ai = 0; ai < 2; ++ai)
#pragma unroll
            for (int m = 0; m < 4; ++m) { bf16_t* rowp = O + (size_t)(row0 + ai * HALF + m * 16) * ldc + col0;
                float r[8];
#pragma unroll
                for (int n = 0; n < 2; ++n)
#pragma unroll
                    for (int j = 0; j < 4; ++j) { const float a = acc[ai][0][m][n][j], b = acc[ai][1][m][n][j]; r[n * 4 + j] = a * b * __builtin_amdgcn_rcpf(1.0f + __expf(-a)); }
                u32x4 w; w.x = pk2(r[0], r[1]); w.y = pk2(r[2], r[3]); w.z = pk2(r[4], r[5]); w.w = pk2(r[6], r[7]);
                *(u32x4*)rowp = w; }
    }
};
struct EpiF8S {
    static constexpr bool PERM = true;
    unsigned char* O; int ldc; float scale;
    __device__ __forceinline__ void operator()(const f32x4 (&acc)[2][2][4][2], const Unit& u, int wr, int wc, int fr, int fq) const {
        const int row0 = u.pm * BM + wr * 64 + fr, col0 = u.pn * BM + wc * 32 + 8 * fq;
#pragma unroll
        for (int ai = 0; ai < 2; ++ai)
#pragma unroll
            for (int m = 0; m < 4; ++m) { unsigned char* rowp = O + (size_t)(row0 + ai * HALF + m * 16) * ldc + col0;
#pragma unroll
                for (int bj = 0; bj < 2; ++bj) { const f32x4 v0 = acc[ai][bj][m][0] * scale, v1 = acc[ai][bj][m][1] * scale;
                    *(u32x2*)(rowp + bj * HALF) = (u32x2){pk4_f8(v0[0], v0[1], v0[2], v0[3]), pk4_f8(v1[0], v1[1], v1[2], v1[3])}; } }
    }
};
struct EpiResBf16S {
    static constexpr bool PERM = true;
    bf16_t* C; const bf16_t* H; int ldc; float alpha, scale; int frames = 0;
    __device__ __forceinline__ void operator()(const f32x4 (&acc)[2][2][4][2], const Unit& u, int wr, int wc, int fr, int fq) const {
        const int row0 = (frames ? frame_row0(u.pm) : u.pm * BM) + wr * 64 + fr, col0 = u.pn * BM + wc * 32 + 8 * fq;
#pragma unroll
        for (int ai = 0; ai < 2; ++ai)
#pragma unroll
            for (int m = 0; m < 4; ++m) { const size_t off = (size_t)(row0 + ai * HALF + m * 16) * ldc + col0;
#pragma unroll
                for (int bj = 0; bj < 2; ++bj) { const u32x4 hv = *(const u32x4*)(H + off + bj * HALF); const f32x4 v0 = acc[ai][bj][m][0] * scale, v1 = acc[ai][bj][m][1] * scale;
                    u32x4 w; w.x = pk2(alpha * bflo(hv.x) + v0[0], alpha * bfhi(hv.x) + v0[1]); w.y = pk2(alpha * bflo(hv.y) + v0[2], alpha * bfhi(hv.y) + v0[3]);
                    w.z = pk2(alpha * bflo(hv.z) + v1[0], alpha * bfhi(hv.z) + v1[1]); w.w = pk2(alpha * bflo(hv.w) + v1[2], alpha * bfhi(hv.w) + v1[3]);
                    *(u32x4*)(C + off + bj * HALF) = w; } }
    }
};
struct EpiBf16S {
    static constexpr bool PERM = true;
    bf16_t* O; int ldc; float scale; int b16 = 0; int v8off = 0; int v8lo = 0; int q8off = 0, q8n = 0, q8sub = 0; unsigned char* X = nullptr; int xpn = -1;
    __device__ __forceinline__ void operator()(const f32x4 (&acc)[2][2][4][2], const Unit& u, int wr, int wc, int fr, int fq) const {
        const int row0 = u.pm * BM + wr * 64 + fr, col0 = u.pn * BM + wc * 32 + 8 * fq;
#pragma unroll
        for (int ai = 0; ai < 2; ++ai)
#pragma unroll
            for (int m = 0; m < 4; ++m) { bf16_t* rowp = O + (size_t)(row0 + ai * HALF + m * 16) * ldc + col0;
#pragma unroll
                for (int bj = 0; bj < 2; ++bj) { const f32x4 v0 = acc[ai][bj][m][0] * scale, v1 = acc[ai][bj][m][1] * scale;
                    if (u.pn == xpn) {
                        if (bj == 0 && wc < 2) *(u32x2*)(X + (size_t)(row0 + ai * HALF + m * 16) * 64 + fq * 16 + wc * 8) =
                            (u32x2){pk4_f8(v0[0] * F8S_QK, v0[1] * F8S_QK, v0[2] * F8S_QK, v0[3] * F8S_QK), pk4_f8(v1[0] * F8S_QK, v1[1] * F8S_QK, v1[2] * F8S_QK, v1[3] * F8S_QK)};
                        continue; }
                    if (u.pn < q8n) {
                        *(u32x2*)((unsigned char*)O - q8sub + (long)q8off * 524288 + (size_t)(row0 + ai * HALF + m * 16) * T8P + col0 + bj * HALF) =
                            (u32x2){pk4_f8(v0[0] * F8S_QK, v0[1] * F8S_QK, v0[2] * F8S_QK, v0[3] * F8S_QK), pk4_f8(v1[0] * F8S_QK, v1[1] * F8S_QK, v1[2] * F8S_QK, v1[3] * F8S_QK)};
                        continue; }
                    u32x4 w;
                    if (b16) { w.x = pk2_b(v0[0], v0[1]); w.y = pk2_b(v0[2], v0[3]); w.z = pk2_b(v1[0], v1[1]); w.w = pk2_b(v1[2], v1[3]); }
                    else { w.x = pk2(v0[0], v0[1]); w.y = pk2(v0[2], v0[3]); w.z = pk2(v1[0], v1[1]); w.w = pk2(v1[2], v1[3]); }
                    if (v8off != 0 && u.pm >= v8lo)
                        *(u32x2*)((unsigned char*)O + (long)v8off * 524288 + (size_t)(row0 - v8lo * BM + ai * HALF + m * 16) * ldc + col0 + bj * HALF) =
                            (u32x2){pk4_f8(v0[0] * F8S_V, v0[1] * F8S_V, v0[2] * F8S_V, v0[3] * F8S_V), pk4_f8(v1[0] * F8S_V, v1[1] * F8S_V, v1[2] * F8S_V, v1[3] * F8S_V)};
                    else *(u32x4*)(rowp + bj * HALF) = w; } }
    }
};
struct EpiGatedS {
    static constexpr bool PERM = true;
    bf16_t* O; int ldc; float sin; int frames = 0;
    __device__ __forceinline__ void operator()(const f32x4 (&acc)[2][2][4][2], const Unit& u, int wr, int wc, int fr, int fq) const {
        const int row0 = (frames ? frame_row0(u.pm) : u.pm * BM) + wr * 64 + fr, col0 = u.pn * HALF + wc * 32 + 8 * fq;
#pragma unroll
        for (int ai = 0; ai < 2; ++ai)
#pragma unroll
            for (int m = 0; m < 4; ++m) { bf16_t* rowp = O + (size_t)(row0 + ai * HALF + m * 16) * ldc + col0;
                float r[8];
#pragma unroll
                for (int n = 0; n < 2; ++n)
#pragma unroll
                    for (int j = 0; j < 4; ++j) { const float a = acc[ai][0][m][n][j] * sin, b = acc[ai][1][m][n][j] * sin; r[n * 4 + j] = a * b * __builtin_amdgcn_rcpf(1.0f + __expf(-a)); }
                u32x4 w; w.x = pk2(r[0], r[1]); w.y = pk2(r[2], r[3]); w.z = pk2(r[4], r[5]); w.w = pk2(r[6], r[7]);
                *(u32x4*)rowp = w; }
    }
};
struct EpiGatedF8 {
    static constexpr bool PERM = true;
    unsigned char* O; int ldc; float sin, sout; int frames = 0;
    __device__ __forceinline__ void operator()(const f32x4 (&acc)[2][2][4][2], const Unit& u, int wr, int wc, int fr, int fq) const {
        const int row0 = (frames ? frame_row0(u.pm) : u.pm * BM) + wr * 64 + fr, col0 = u.pn * HALF + wc * 32 + 8 * fq;
        const float sb = sin * sout;
#pragma unroll
        for (int ai = 0; ai < 2; ++ai)
#pragma unroll
            for (int m = 0; m < 4; ++m) { unsigned char* rowp = O + (size_t)(row0 + ai * HALF + m * 16) * ldc + col0;
                float r[8];
#pragma unroll
                for (int n = 0; n < 2; ++n)
#pragma unroll
                    for (int j = 0; j < 4; ++j) { const float a = acc[ai][0][m][n][j] * sin, b = acc[ai][1][m][n][j] * sb; r[n * 4 + j] = a * b * __builtin_amdgcn_rcpf(1.0f + __expf(-a)); }
                u32x2 w; w.x = pk4_f8(r[0], r[1], r[2], r[3]); w.y = pk4_f8(r[4], r[5], r[6], r[7]);
                *(u32x2*)rowp = w; }
    }
};
struct EpiResBf16 {
    static constexpr bool PERM = true;
    bf16_t* C; const bf16_t* H; int ldc; float alpha; int frames = 0;
    __device__ __forceinline__ void operator()(const f32x4 (&acc)[2][2][4][2], const Unit& u, int wr, int wc, int fr, int fq) const {
        const int row0 = (frames ? frame_row0(u.pm) : u.pm * BM) + wr * 64 + fr, col0 = u.pn * BM + wc * 32 + 8 * fq;
#pragma unroll
        for (int ai = 0; ai < 2; ++ai)
#pragma unroll
            for (int m = 0; m < 4; ++m) { const size_t off = (size_t)(row0 + ai * HALF + m * 16) * ldc + col0;
#pragma unroll
                for (int bj = 0; bj < 2; ++bj) { const u32x4 hv = *(const u32x4*)(H + off + bj * HALF); const f32x4 v0 = acc[ai][bj][m][0], v1 = acc[ai][bj][m][1];
                    u32x4 w; w.x = pk2(alpha * bflo(hv.x) + v0[0], alpha * bfhi(hv.x) + v0[1]); w.y = pk2(alpha * bflo(hv.y) + v0[2], alpha * bfhi(hv.y) + v0[3]);
                    w.z = pk2(alpha * bflo(hv.z) + v1[0], alpha * bfhi(hv.z) + v1[1]); w.w = pk2(alpha * bflo(hv.w) + v1[2], alpha * bfhi(hv.w) + v1[3]);
                    *(u32x4*)(C + off + bj * HALF) = w; } }
    }
};


template <int MODE> struct SkOp;
template <> struct SkOp<0> { typedef bf16x8 T; static constexpr int OPB = 16, UN = 8; };
template <> struct SkOp<1> { typedef i32x8v T; static constexpr int OPB = 32, UN = 6; };
template <> struct SkOp<2> { typedef i32x4v T; static constexpr int OPB = 16, UN = 4; };
__device__ __forceinline__ void skmma(f32x4& acc, const bf16x8& b, const bf16x8& a) { acc = MFMA16(b, a, acc, 0, 0, 0); }
__device__ __forceinline__ void skmma(f32x4& acc, const i32x8v& b, const i32x8v& a) { acc = __builtin_amdgcn_mfma_scale_f32_16x16x128_f8f6f4(b, a, acc, 0, 0, 0, 0, 0, 0); }
__device__ __forceinline__ void skmma(f32x4& acc, const i32x4v& b, const i32x4v& a) { acc = __builtin_bit_cast(f32x4, __builtin_amdgcn_mfma_i32_16x16x64_i8(b, a, __builtin_bit_cast(i32x4v, acc), 0, 0, 0)); }
template <int MODE, int NF, class BRows, class Fin>
__device__ __forceinline__ void skinny_phase(LAS unsigned char* lds, int bid, int G, int wave, int lane, const unsigned char* A, size_t pitch, int kbytes, int nunits, const BRows& brows, const Fin& fin) {
    typedef typename SkOp<MODE>::T T; constexpr int OPB = SkOp<MODE>::OPB, UN = SkOp<MODE>::UN, STEPB = 4 * OPB;
    const int fr = lane & 15, fq = lane >> 4, steps = kbytes / STEPB;
    const unsigned char* a0 = A + (size_t)fr * pitch + fq * OPB; const unsigned char* a1 = A + (size_t)(LP + fr) * pitch + fq * OPB;
    LAS f32x4* red = (LAS f32x4*)lds;
    for (int u = bid; u < nunits; u += G) {
        const unsigned char* bp[NF];
#pragma unroll
        for (int f = 0; f < NF; ++f) bp[f] = brows(u, f) + (size_t)fr * kbytes + fq * OPB;
        f32x4 acc[NF][2];
#pragma unroll
        for (int f = 0; f < NF; ++f) { acc[f][0] = (f32x4){0.f, 0.f, 0.f, 0.f}; acc[f][1] = (f32x4){0.f, 0.f, 0.f, 0.f}; }
        for (int s0 = wave * UN; s0 < steps; s0 += 8 * UN) {
            T av0[UN], av1[UN], bv[NF][UN];
#pragma unroll
            for (int q = 0; q < UN; ++q) { const int s = (s0 + q < steps) ? s0 + q : s0; const size_t off = (size_t)s * STEPB; av0[q] = *(const T*)(a0 + off); av1[q] = *(const T*)(a1 + off);
#pragma unroll
                for (int f = 0; f < NF; ++f) bv[f][q] = *(const T*)(bp[f] + off); }
            __builtin_amdgcn_sched_barrier(0);
#pragma unroll
            for (int q = 0; q < UN; ++q) if (s0 + q < steps) {
#pragma unroll
                for (int f = 0; f < NF; ++f) { skmma(acc[f][0], bv[f][q], av0[q]); skmma(acc[f][1], bv[f][q], av1[q]); } }
        }
#pragma unroll
        for (int f = 0; f < NF; ++f)
#pragma unroll
            for (int b = 0; b < 2; ++b) { f32x4 v = acc[f][b];
                if (MODE == 2) {
#pragma unroll
                    for (int j = 0; j < 4; ++j) v[j] = (float)__float_as_int(v[j]); }
                red[(wave * (NF * 2) + f * 2 + b) * 64 + lane] = v; }
        __syncthreads();
        if (wave < NF) {
            f32x4 sum[2];
#pragma unroll
            for (int b = 0; b < 2; ++b) { f32x4 v = red[(wave * 2 + b) * 64 + lane];
#pragma unroll
                for (int w = 1; w < 8; ++w) v += red[(w * (NF * 2) + wave * 2 + b) * 64 + lane];
                sum[b] = v; }
            fin(u * NF + wave, sum, red, fr, fq);
        }
        __syncthreads();
    }
}
struct SkRowsLin { const unsigned char* Bt; int kbytes; int nf; __device__ __forceinline__ const unsigned char* operator()(int u, int f) const { return Bt + (size_t)(u * nf + f) * 16 * kbytes; } };
struct SkRowsGated { const unsigned char* Bt; int kbytes;
    __device__ __forceinline__ const unsigned char* operator()(int u, int f) const { const int j0 = 16 * (u * 2 + (f >> 1)); return Bt + (size_t)((j0 >> 7) * 256 + (j0 & 127) + 128 * (f & 1)) * kbytes; } };
struct SkFinBf16 { bf16_t* O; int ldc;
    __device__ __forceinline__ void operator()(int c, const f32x4 (&s)[2], LAS f32x4*, int fr, int fq) const {
#pragma unroll
        for (int b = 0; b < 2; ++b) *(u32x2*)(O + (size_t)(b * LP + fr) * ldc + 16 * c + 4 * fq) = (u32x2){pk2(s[b][0], s[b][1]), pk2(s[b][2], s[b][3])}; } };
struct SkFinRes { bf16_t* C; const bf16_t* H; int ldc; float alpha, scale;
    __device__ __forceinline__ void operator()(int c, const f32x4 (&s)[2], LAS f32x4*, int fr, int fq) const {
#pragma unroll
        for (int b = 0; b < 2; ++b) { const size_t off = (size_t)(b * LP + fr) * ldc + 16 * c + 4 * fq; const u32x2 hv = *(const u32x2*)(H + off);
            *(u32x2*)(C + off) = (u32x2){pk2(alpha * bflo(hv.x) + scale * s[b][0], alpha * bfhi(hv.x) + scale * s[b][1]), pk2(alpha * bflo(hv.y) + scale * s[b][2], alpha * bfhi(hv.y) + scale * s[b][3])}; } } };
template <bool OUTF8> struct SkFinGated { unsigned char* O; int ldc; float sin, sout;
    __device__ __forceinline__ void operator()(int c, const f32x4 (&s)[2], LAS f32x4* red, int fr, int fq) const {
        if (c & 1) return;
        const int lane = fq * 16 + fr, f1 = (c & 3) + 1;
#pragma unroll
        for (int b = 0; b < 2; ++b) { f32x4 g4 = red[(f1 * 2 + b) * 64 + lane];
#pragma unroll
            for (int w = 1; w < 8; ++w) g4 += red[(w * 8 + f1 * 2 + b) * 64 + lane];
            float r[4];
#pragma unroll
            for (int j = 0; j < 4; ++j) { const float a = s[b][j] * sin, g = g4[j] * sin; r[j] = a * g * __builtin_amdgcn_rcpf(1.0f + __expf(-a)); }
            const size_t off = (size_t)(b * LP + fr) * ldc + 16 * (c >> 1) + 4 * fq;
            if (OUTF8) *(unsigned*)(O + off) = pk4_f8(r[0] * sout, r[1] * sout, r[2] * sout, r[3] * sout);
            else *(u32x2*)((bf16_t*)O + off) = (u32x2){pk2(r[0], r[1]), pk2(r[2], r[3])}; } } };

template <int MODE> struct Frag;
template <> struct Frag<0> { bf16x8 v[2]; };
template <> struct Frag<1> { i32x8v v; };
template <> struct Frag<2> { i32x4v v[2]; };
__device__ __forceinline__ void ldfrag(Frag<0>& f, const LAS unsigned char* p) { f.v[0] = *(const LAS bf16x8*)p; f.v[1] = *(const LAS bf16x8*)(p + 1024); }
__device__ __forceinline__ void ldfrag(Frag<1>& f, const LAS unsigned char* p) { const i32x4v a = *(const LAS i32x4v*)p, b = *(const LAS i32x4v*)(p + 1024); f.v = __builtin_shufflevector(a, b, 0, 1, 2, 3, 4, 5, 6, 7); }
__device__ __forceinline__ void ldfrag(Frag<2>& f, const LAS unsigned char* p) { f.v[0] = *(const LAS i32x4v*)p; f.v[1] = *(const LAS i32x4v*)(p + 1024); }
__device__ __forceinline__ void mmafrag(f32x4& acc, const Frag<0>& b, const Frag<0>& a) { acc = MFMA16(b.v[0], a.v[0], acc, 0, 0, 0); acc = MFMA16(b.v[1], a.v[1], acc, 0, 0, 0); }
__device__ __forceinline__ void mmafrag(f32x4& acc, const Frag<1>& b, const Frag<1>& a) { acc = __builtin_amdgcn_mfma_scale_f32_16x16x128_f8f6f4(b.v, a.v, acc, 0, 0, 0, 0, 0, 0); }
__device__ __forceinline__ void mmafrag(f32x4& acc, const Frag<2>& b, const Frag<2>& a) {
    i32x4v c = __builtin_bit_cast(i32x4v, acc); c = __builtin_amdgcn_mfma_i32_16x16x64_i8(b.v[0], a.v[0], c, 0, 0, 0); c = __builtin_amdgcn_mfma_i32_16x16x64_i8(b.v[1], a.v[1], c, 0, 0, 0); acc = __builtin_bit_cast(f32x4, c); }
template <class Epi, class Prov, int MODE = 0>
__device__ __forceinline__ void gemm_phase(LAS unsigned char* lds, const char* Abase, const int K, const Prov& S, const Epi& E) {
    constexpr bool F8 = (MODE == 1);
    const int tid = threadIdx.x, wid = __builtin_amdgcn_readfirstlane(tid >> 6), lane = tid & 63, wr = wid >> 2, wc = wid & 3, fr = lane & 15, fq = lane >> 4;
    const int nt = K / BK;
    int RA[2], CA[2]; unsigned voffB[2];
#pragma unroll
    for (int i = 0; i < 2; ++i) { int R, C; stage_rc(tid * 16 + i * 8192, R, C); const int Rb = Epi::PERM ? ((R & ~31) + perm32(R & 31)) : R;
        RA[i] = R; CA[i] = C; voffB[i] = (unsigned)(Rb * K + C) * 2u; }
    const size_t kstep = (size_t)(BK * 2);
    const size_t hstep = (size_t)HALF * K * 2;
    const unsigned ldsw = (unsigned)wid * 1024u;
    const unsigned ldsb = (unsigned)(size_t)lds + ldsw;
    const int aoff = lds_byte(wr * 64 + fr, fq * 8), boff = lds_byte(wc * 32 + fr, fq * 8);
#define PG8_SA(b, h) (((b) * 2 + (h)) * HTB)
#define PG8_SB(b, h) ((4 + (b) * 2 + (h)) * HTB)
#define PG8_STAGE(bufoff, gbase, voff) do { _Pragma("unroll") for (int _i = 0; _i < 2; ++_i) { \
        if (F8) asm volatile("s_mov_b32 m0, %0\n\ts_nop 0\n\tglobal_load_lds_dwordx4 %1, %2" :: "s"(ldsb + (unsigned)((bufoff) + _i * 8192)), "v"((voff)[_i]), "s"((const char*)(gbase)) : "memory", "m0"); \
        else __builtin_amdgcn_global_load_lds((const unsigned*)((const char*)(gbase) + (voff)[_i]), (LAS unsigned*)(lds + (bufoff) + ldsw + _i * 8192), 16, 0, 0); } } while (0)
#define PG8_LDA(dst, b, h) do { _Pragma("unroll") for (int m = 0; m < 4; ++m) ldfrag(dst[m], lds + PG8_SA(b, h) + aoff + m * 2048); } while (0)
#define PG8_LDB(dst, b, h) do { _Pragma("unroll") for (int n = 0; n < 2; ++n) ldfrag(dst[n], lds + PG8_SB(b, h) + boff + n * 2048); } while (0)
#define PG8_MMA(ai, bj, At, Bt) do { __builtin_amdgcn_s_setprio(1); _Pragma("unroll") for (int m = 0; m < 4; ++m) _Pragma("unroll") for (int n = 0; n < 2; ++n) { \
        if (F8) { f32x4 c_; _Pragma("unroll") for (int j_ = 0; j_ < 4; ++j_) c_[j_] = acc16[ai][bj][m >> 1][8 * (m & 1) + 4 * n + j_]; mmafrag(c_, Bt[n], At[m]); \
                  _Pragma("unroll") for (int j_ = 0; j_ < 4; ++j_) acc16[ai][bj][m >> 1][8 * (m & 1) + 4 * n + j_] = c_[j_]; } \
        else mmafrag(acc[ai][bj][m][n], Bt[n], At[m]); } __builtin_amdgcn_s_setprio(0); } while (0)
#define PG8_WAIT_V(n) asm volatile("s_waitcnt vmcnt(" #n ")" ::: "memory")
#define PG8_WAIT_L(n) asm volatile("s_waitcnt lgkmcnt(" #n ")" ::: "memory")
#define PG8_BAR __builtin_amdgcn_s_barrier()
#define PG8_SCHED __builtin_amdgcn_sched_barrier(0)
    Unit cur, nxt; int ui = 0;
    if (!S.next(0, cur)) return;
    f32x4 acc[2][2][4][2];
    f32x16 acc16[2][2][2];
#pragma unroll
    for (int a = 0; a < 2; ++a)
#pragma unroll
        for (int b = 0; b < 2; ++b)
#pragma unroll
            for (int q = 0; q < 2; ++q)
#pragma unroll
                for (int j = 0; j < 16; ++j) acc16[a][b][q][j] = 0.f;
#pragma unroll
    for (int a = 0; a < 2; ++a)
#pragma unroll
        for (int b = 0; b < 2; ++b)
#pragma unroll
            for (int m = 0; m < 4; ++m)
#pragma unroll
                for (int n = 0; n < 2; ++n) acc[a][b][m][n] = (f32x4){0.f, 0.f, 0.f, 0.f};
    Frag<MODE> At[4], B0[2], B1[2];
    unsigned vAc[2][2], vAn[2][2];
    S.aoffs(cur, RA, CA, vAc);
    const char* cB = S.bbase(cur);
    const char* A0 = Abase;
    PG8_STAGE(PG8_SB(0, 0), cB, voffB); PG8_STAGE(PG8_SA(0, 0), A0, vAc[0]); PG8_STAGE(PG8_SB(0, 1), cB + hstep, voffB); PG8_STAGE(PG8_SA(0, 1), A0, vAc[1]);
    if (wr == 1) PG8_BAR;
    PG8_WAIT_V(4); PG8_BAR;
    PG8_STAGE(PG8_SB(1, 0), cB + kstep, voffB); PG8_STAGE(PG8_SA(1, 0), A0 + kstep, vAc[0]); PG8_STAGE(PG8_SB(1, 1), cB + hstep + kstep, voffB);
    PG8_WAIT_V(6); PG8_BAR;
    for (;;) {
        const bool has_next = S.next(ui + 1, nxt);
        const char* nB = cB;
        if (has_next) { S.aoffs(nxt, RA, CA, vAn); nB = S.bbase(nxt); }
        else {
#pragma unroll
            for (int h = 0; h < 2; ++h)
#pragma unroll
                for (int i = 0; i < 2; ++i) vAn[h][i] = vAc[h][i];
        }
        for (int t = 0; t < nt; t += 2) {
            const bool last = (t == nt - 2);
            const char* a1 = A0 + (size_t)(t + 1) * kstep;
            const char* a2 = last ? A0 : A0 + (size_t)(t + 2) * kstep; const char* b2 = last ? nB : cB + (size_t)(t + 2) * kstep;
            const char* a3 = a2 + kstep; const char* b3 = b2 + kstep;
            unsigned v2[2][2];
#pragma unroll
            for (int h = 0; h < 2; ++h)
#pragma unroll
                for (int i = 0; i < 2; ++i) v2[h][i] = last ? vAn[h][i] : vAc[h][i];
            PG8_LDB(B0, 0, 0); PG8_SCHED; PG8_LDA(At, 0, 0); PG8_STAGE(PG8_SA(1, 1), a1, vAc[1]);
            PG8_WAIT_L(8); PG8_BAR; PG8_WAIT_L(0); PG8_MMA(0, 0, At, B0); PG8_BAR; PG8_SCHED;
            PG8_LDB(B1, 0, 1); PG8_STAGE(PG8_SB(0, 0), b2, voffB);
            PG8_BAR; PG8_WAIT_L(0); PG8_MMA(0, 1, At, B1); PG8_BAR;
            PG8_LDA(At, 0, 1); PG8_STAGE(PG8_SA(0, 0), a2, v2[0]);
            PG8_BAR; PG8_WAIT_L(0); PG8_MMA(1, 0, At, B0); PG8_BAR; PG8_SCHED;
            PG8_STAGE(PG8_SB(0, 1), b2 + hstep, voffB);
            PG8_WAIT_V(6); PG8_BAR; PG8_MMA(1, 1, At, B1); PG8_BAR;
            PG8_LDB(B0, 1, 0); PG8_SCHED; PG8_LDA(At, 1, 0); PG8_STAGE(PG8_SA(0, 1), a2, v2[1]);
            PG8_WAIT_L(8); PG8_BAR; PG8_WAIT_L(0); PG8_MMA(0, 0, At, B0); PG8_BAR; PG8_SCHED;
            PG8_LDB(B1, 1, 1); PG8_STAGE(PG8_SB(1, 0), b3, voffB);
            PG8_BAR; PG8_WAIT_L(0); PG8_MMA(0, 1, At, B1); PG8_BAR;
            PG8_LDA(At, 1, 1); PG8_STAGE(PG8_SA(1, 0), a3, v2[0]);
            PG8_BAR; PG8_WAIT_L(0); PG8_MMA(1, 0, At, B0); PG8_BAR; PG8_SCHED;
            PG8_STAGE(PG8_SB(1, 1), b3 + hstep, voffB);
            PG8_WAIT_V(6); PG8_BAR; PG8_MMA(1, 1, At, B1); PG8_BAR;
        }
        if (F8) {
#pragma unroll
            for (int a = 0; a < 2; ++a)
#pragma unroll
                for (int b = 0; b < 2; ++b)
#pragma unroll
                    for (int m = 0; m < 4; ++m)
#pragma unroll
                        for (int n = 0; n < 2; ++n)
#pragma unroll
                            for (int j = 0; j < 4; ++j) { acc[a][b][m][n][j] = acc16[a][b][m >> 1][8 * (m & 1) + 4 * n + j]; acc16[a][b][m >> 1][8 * (m & 1) + 4 * n + j] = 0.f; }
        }
        if (MODE == 2) {
#pragma unroll
            for (int a = 0; a < 2; ++a)
#pragma unroll
                for (int b = 0; b < 2; ++b)
#pragma unroll
                    for (int m = 0; m < 4; ++m)
#pragma unroll
                        for (int n = 0; n < 2; ++n)
#pragma unroll
                            for (int j = 0; j < 4; ++j) acc[a][b][m][n][j] = (float)__float_as_int(acc[a][b][m][n][j]);
        }
        E(acc, cur, wr, wc, fr, fq);
        if (!has_next) break;
#pragma unroll
        for (int a = 0; a < 2; ++a)
#pragma unroll
            for (int b = 0; b < 2; ++b)
#pragma unroll
                for (int m = 0; m < 4; ++m)
#pragma unroll
                    for (int n = 0; n < 2; ++n) acc[a][b][m][n] = (f32x4){0.f, 0.f, 0.f, 0.f};
        cur = nxt; cB = nB; ++ui;
#pragma unroll
        for (int h = 0; h < 2; ++h)
#pragma unroll
            for (int i = 0; i < 2; ++i) vAc[h][i] = vAn[h][i];
    }
    PG8_WAIT_V(0);
    if (wr == 0) PG8_BAR;
    PG8_BAR;
#undef PG8_SA
#undef PG8_SB
#undef PG8_STAGE
#undef PG8_LDA
#undef PG8_LDB
#undef PG8_MMA
#undef PG8_WAIT_V
#undef PG8_WAIT_L
#undef PG8_BAR
#undef PG8_SCHED
}
}
struct Frame {
    LAS unsigned char* lds;
    unsigned* ctl;
    unsigned char* ws;
    const float* in[35];
    float* out;
    int tid, lane, wave, G, bid;
};
enum { I_X = 0, I_META, I_WINE, I_CONVW, I_ARE, I_AIM, I_LOGDT, I_BRE, I_BIM, I_CRE, I_CIM, I_S5D, I_WGLU, I_WOUTE, I_LN1G, I_LN1B, I_W1, I_W3, I_W2, I_LN2G, I_LN2B,
       I_WINO, I_MBI, I_MBF, I_RELB, I_WOUTO, I_LN3G, I_LN3B, I_RW, I_RB, I_EW1, I_EW3, I_EW2, I_LN4G, I_LN4B };

struct SrcRef { const float* p; int col; float sc; };
template <class F> __device__ __forceinline__ void transpose_item(const F& f, int ldw, bf16_t* dst, int Kd, int k0, int n0, LAS float* scr, int lane) {
    const SrcRef s = f(n0 + (lane & 31));
    float v[32];
#pragma unroll
    for (int i = 0; i < 32; ++i) v[i] = s.p[(size_t)(k0 + 2 * i + (lane >> 5)) * ldw + s.col];
    __builtin_amdgcn_sched_barrier(0);
#pragma unroll
    for (int i = 0; i < 32; ++i) scr[(2 * i + (lane >> 5)) * 33 + (lane & 31)] = v[i] * s.sc;
    LDS_WAIT();
    const int c = lane & 7;
#pragma unroll
    for (int j = 0; j < 4; ++j) { const int n = (lane >> 3) + 8 * j; const LAS float* sp = scr + (8 * c) * 33 + n;
        u32x4 o; o.x = pk2(sp[0 * 33], sp[1 * 33]); o.y = pk2(sp[2 * 33], sp[3 * 33]); o.z = pk2(sp[4 * 33], sp[5 * 33]); o.w = pk2(sp[6 * 33], sp[7 * 33]);
        *(u32x4*)(dst + (size_t)(n0 + n) * Kd + k0 + 8 * c) = o; }
    LDS_WAIT();
}
#define PK4(a, b, c, d) (I8 ? pk4_i8(a, b, c, d) : pk4_f8(a, b, c, d))
template <bool I8, class F> __device__ __forceinline__ void transpose_item_f8(const F& f, int ldw, unsigned char* dst, int Kd, int k0, int n0, float scale, LAS float* scr, int lane) {
    const SrcRef s = f(n0 + (lane & 31));
    float v[32];
#pragma unroll
    for (int i = 0; i < 32; ++i) v[i] = s.p[(size_t)(k0 + 2 * i + (lane >> 5)) * ldw + s.col];
    __builtin_amdgcn_sched_barrier(0);
#pragma unroll
    for (int i = 0; i < 32; ++i) scr[(2 * i + (lane >> 5)) * 33 + (lane & 31)] = v[i] * (s.sc * scale);
    LDS_WAIT();
    const int c = lane & 3;
#pragma unroll
    for (int j = 0; j < 2; ++j) { const int n = (lane >> 2) + 16 * j; const LAS float* sp = scr + (16 * c) * 33 + n;
        u32x4 o; o.x = PK4(sp[0 * 33], sp[1 * 33], sp[2 * 33], sp[3 * 33]); o.y = PK4(sp[4 * 33], sp[5 * 33], sp[6 * 33], sp[7 * 33]);
        o.z = PK4(sp[8 * 33], sp[9 * 33], sp[10 * 33], sp[11 * 33]); o.w = PK4(sp[12 * 33], sp[13 * 33], sp[14 * 33], sp[15 * 33]);
        *(u32x4*)(dst + (size_t)(n0 + n) * Kd + k0 + 16 * c) = o; }
    LDS_WAIT();
}
#undef PK4
struct MapIdent { const float* w; __device__ __forceinline__ SrcRef operator()(int n) const { return SrcRef{w, n, 1.f}; } };
struct MapGated { const float* w1; const float* w3; __device__ __forceinline__ SrcRef operator()(int n) const { const int t = n >> 8, r = n & 255; return r < 128 ? SrcRef{w1, t * 128 + r, 1.f} : SrcRef{w3, t * 128 + r - 128, 1.f}; } };
struct MapOddA { const float* w; __device__ __forceinline__ SrcRef operator()(int n) const {
    int c;
    if (n < 1024) c = n;
    else if (n < 1028) c = 4096 + (n - 1024);
    else if (n < 1032) c = 4100 + (n - 1028);
    else if (n < 1040) c = 7752 + (n - 1032);
    else if (n < 1280) return SrcRef{w, 0, 0.f};
    else if (n < 1792) c = 7176 + (n - 1280);
    else if (n < 2816) c = 4104 + (n - 1792);
    else if (n < 3840) c = 5128 + (n - 2816);
    else if (n < 3904) c = 7688 + (n - 3840);
    else if (n < 4096) return SrcRef{w, 0, 0.f};
    else c = 3072 + (n - 4096);
    return SrcRef{w, c, 1.f}; } };
struct MapOddB { const float* w; __device__ __forceinline__ SrcRef operator()(int n) const {
    int c;
    if (n < 1024) c = 1024 + n;
    else if (n < 2048) c = 2048 + (n - 1024);
    else c = 6152 + (n - 2048);
    return SrcRef{w, c, 1.f}; } };

constexpr int WI_1 = (NIN_E / 32) * (D / 64);
__device__ __forceinline__ int weight_items(Frame& F, const int first, const int last, const int gw, const int NGW) {
    LAS float* scr = (LAS float*)(F.lds + F.wave * 16384);
    bf16_t* WINE = (bf16_t*)(F.ws + WS_WINE); bf16_t* WOUTE = (bf16_t*)(F.ws + WS_WOUTE);
    bf16_t* WINOA = (bf16_t*)(F.ws + WS_WINOA); bf16_t* WINOB = (bf16_t*)(F.ws + WS_WINOB); bf16_t* WOUTO = (bf16_t*)(F.ws + WS_WOUTO);
    constexpr int I1 = (NIN_E / 32) * (D / 64), I2 = (D / 32) * (D / 64), I3 = (N13 / 32) * (D / 64), I4 = (D / 32) * (DFF / 64), I5 = (NIN_OA / 32) * (D / 64), I6 = (NIN_OB / 32) * (D / 64), I7 = I2;
    constexpr int NITEMS = I1 + I2 + I3 + I4 + I5 + I6 + I7; static_assert(I1 == WI_1, "item split");
    const int lim = last < NITEMS ? last : NITEMS;
    for (int it = first + gw; it < lim; it += NGW) {
        int r = it;
        if (r < I1) { const int nb = NIN_E / 32; transpose_item(MapIdent{F.in[I_WINE]}, NIN_E, WINE, D, (r / nb) * 64, (r % nb) * 32, scr, F.lane); continue; } r -= I1;
        if (r < I2) { const int nb = D / 32; transpose_item(MapIdent{F.in[I_WOUTE]}, D, WOUTE, D, (r / nb) * 64, (r % nb) * 32, scr, F.lane); continue; } r -= I2;
        if (r < I3) { const int nb = N13 / 32; transpose_item_f8<true>(MapGated{F.in[I_W1], F.in[I_W3]}, DFF, F.ws + WS_W13, D, (r / nb) * 64, (r % nb) * 32, I8S_W13, scr, F.lane); continue; } r -= I3;
        if (r < I4) { const int nb = D / 32;
#if FFN_DOWN_F8
            transpose_item_f8<false>(MapIdent{F.in[I_W2]}, D, F.ws + WS_W2, DFF, (r / nb) * 64, (r % nb) * 32, F8S_W2, scr, F.lane);
#else
            transpose_item(MapIdent{F.in[I_W2]}, D, (bf16_t*)(F.ws + WS_W2), DFF, (r / nb) * 64, (r % nb) * 32, scr, F.lane);
#endif
            continue; } r -= I4;
        if (r < I5) { const int nb = NIN_OA / 32, k0 = (r / nb) * 64, n0 = (r % nb) * 32;
            if (n0 >= NA_BF) transpose_item_f8<true>(MapOddA{F.in[I_WINO]}, 7760, F.ws + WS_WINOA8 - (size_t)NA_BF * D, D, k0, n0, I8S_W13, scr, F.lane);
            else transpose_item(MapOddA{F.in[I_WINO]}, 7760, WINOA, D, k0, n0, scr, F.lane);
            continue; } r -= I5;
        if (r < I6) { const int nb = NIN_OB / 32, k0 = (r / nb) * 64, n0 = (r % nb) * 32;
            if (n0 >= RB_VM) transpose_item_f8<true>(MapOddB{F.in[I_WINO]}, 7760, F.ws + WS_WINOB8 - (size_t)RB_VM * D, D, k0, n0, I8S_W13, scr, F.lane);
            else transpose_item(MapOddB{F.in[I_WINO]}, 7760, WINOB, D, k0, n0, scr, F.lane);
            continue; } r -= I6;
#if OUT1_F8
        { const int nb = D / 32; transpose_item_f8<false>(MapIdent{F.in[I_WOUTO]}, D, F.ws + WS_WOUTO, D, (r / nb) * 64, (r % nb) * 32, F8S_WOUT, scr, F.lane); }
#else
        { const int nb = D / 32; transpose_item(MapIdent{F.in[I_WOUTO]}, D, WOUTO, D, (r / nb) * 64, (r % nb) * 32, scr, F.lane); }
#endif
    }
    return NITEMS;
}
constexpr int WI_SPLIT = (NIN_E / 32) * (D / 64) + (D / 32) * (D / 64);
__device__ __forceinline__ void p0_prologue(Frame& F) {
    const int gw = F.bid * NWAVES + F.wave, NGW = F.G * NWAVES;
    (void)weight_items(F, 0, WI_SPLIT, gw, NGW);
    bf16_t* HA = (bf16_t*)(F.ws + WS_HA);
    const size_t gt = (size_t)F.bid * NTHREADS + F.tid, NGT = (size_t)F.G * NTHREADS;
#pragma unroll 4
    for (size_t e = gt; e < (size_t)M * (D / 8); e += NGT) {
        const int r = (int)(e / (D / 8)), c = (int)(e % (D / 8)) * 8, b = r / LP, pos = r % LP;
        u32x4 o = (u32x4){0u, 0u, 0u, 0u};
        if (pos < LR) { const float* src = pos < NMETA ? F.in[I_META] + (size_t)pos * D + c : F.in[I_X] + ((size_t)b * SEQ + (pos - NMETA)) * D + c;
            const f32x4 v0 = *(const f32x4*)src, v1 = *(const f32x4*)(src + 4);
            o.x = pk2(v0[0], v0[1]); o.y = pk2(v0[2], v0[3]); o.z = pk2(v1[0], v1[1]); o.w = pk2(v1[2], v1[3]); }
        *(u32x4*)(HA + (size_t)r * D + c) = o;
    }
    if (gt < 2048) {
        const int gp = (int)gt, g = gp >> 6;
        const double are = F.in[I_ARE][gp], aim = F.in[I_AIM][gp], dt = exp((double)F.in[I_LOGDT][g]);
        const double er = exp(dt * are), abr = er * cos(dt * aim), abi = er * sin(dt * aim);
        const double erp = exp(S5CH * dt * are), apr = erp * cos(S5CH * dt * aim), api = erp * sin(S5CH * dt * aim);
        const double nr = abr - 1.0, ni = abi, den = are * are + aim * aim;
        const double qr = (nr * are + ni * aim) / den, qi = (ni * are - nr * aim) / den;
        float* T = (float*)(F.ws + WS_S5T);
        T[gp * 2 + 0] = (float)abr; T[gp * 2 + 1] = (float)abi;
        T[4096 + gp * 2 + 0] = (float)apr; T[4096 + gp * 2 + 1] = (float)api;
        float* BB = T + 8192 + gp * 32;
        for (int c = 0; c < 16; ++c) { const double br = F.in[I_BRE][gp * 16 + c], bi = F.in[I_BIM][gp * 16 + c];
            BB[2 * c + 0] = (float)(qr * br - qi * bi); BB[2 * c + 1] = (float)(qr * bi + qi * br); }
        float* PW = T + 73728 + gp * 18;
        double pr = 1.0, pi = 0.0;
        for (int tau = 0; tau <= 8; ++tau) { PW[2 * tau] = (float)pr; PW[2 * tau + 1] = (float)pi; const double nr2 = pr * abr - pi * abi, ni2 = pr * abi + pi * abr; pr = nr2; pi = ni2; }
    }
}

template <class F> __device__ __forceinline__ void transpose_item32(const F& f, int ldw, bf16_t* dst, int Kd, int k0, int n0, LAS float* scr, int lane) {
    const SrcRef s = f(n0 + (lane & 31));
#pragma unroll 8
    for (int i = 0; i < 16; ++i) { const int kk = 2 * i + (lane >> 5); scr[kk * 33 + (lane & 31)] = s.p[(size_t)(k0 + kk) * ldw + s.col] * s.sc; }
    LDS_WAIT();
    const int c = lane & 3;
#pragma unroll
    for (int j = 0; j < 2; ++j) { const int n = (lane >> 2) + 16 * j; const LAS float* sp = scr + (8 * c) * 33 + n;
        u32x4 o; o.x = pk2(sp[0 * 33], sp[1 * 33]); o.y = pk2(sp[2 * 33], sp[3 * 33]); o.z = pk2(sp[4 * 33], sp[5 * 33]); o.w = pk2(sp[6 * 33], sp[7 * 33]);
        *(u32x4*)(dst + (size_t)(n0 + n) * Kd + k0 + 8 * c) = o; }
    LDS_WAIT();
}
template <class F> __device__ __forceinline__ void transpose_item32_f8(const F& f, int ldw, unsigned char* dst, int Kd, int k0, int n0, float scale, LAS float* scr, int lane) {
    const SrcRef s = f(n0 + (lane & 31));
#pragma unroll 8
    for (int i = 0; i < 16; ++i) { const int kk = 2 * i + (lane >> 5); scr[kk * 33 + (lane & 31)] = s.p[(size_t)(k0 + kk) * ldw + s.col] * (s.sc * scale); }
    LDS_WAIT();
    const int c = lane & 1, n = lane >> 1; const LAS float* sp = scr + (16 * c) * 33 + n;
    u32x4 o; o.x = pk4_f8(sp[0 * 33], sp[1 * 33], sp[2 * 33], sp[3 * 33]); o.y = pk4_f8(sp[4 * 33], sp[5 * 33], sp[6 * 33], sp[7 * 33]);
    o.z = pk4_f8(sp[8 * 33], sp[9 * 33], sp[10 * 33], sp[11 * 33]); o.w = pk4_f8(sp[12 * 33], sp[13 * 33], sp[14 * 33], sp[15 * 33]);
    *(u32x4*)(dst + (size_t)(n0 + n) * Kd + k0 + 16 * c) = o;
    LDS_WAIT();
}
struct CvItem { const float* src; int ldw; unsigned char* dst; int Kd; float scale; };
__device__ __forceinline__ CvItem cv_item(const Frame& F, int it) {
    constexpr int J1 = (N13 / 32) * (D / 32), J2 = (D / 32) * (DFF / 32);
    const int e = it / (J1 + J2); int r = it % (J1 + J2); const int kq = F.lane >> 3, nq = F.lane & 7;
    if (r < J1) { const int nb = N13 / 32, k0 = (r / nb) * 32, n0 = (r % nb) * 32; const SrcRef s = MapGated{F.in[I_EW1] + (size_t)e * D * DFF, F.in[I_EW3] + (size_t)e * D * DFF}(n0 + 4 * nq);
        return CvItem{s.p + (size_t)(k0 + 4 * kq) * DFF + s.col, DFF, F.ws + WS_EW13 + (size_t)e * N13 * D + (size_t)(n0 + 4 * nq) * D + k0 + 4 * kq, D, F8S_W13 * s.sc}; }
    r -= J1; const int nb = D / 32, k0 = (r / nb) * 32, n0 = (r % nb) * 32;
    return CvItem{F.in[I_EW2] + (size_t)e * DFF * D + (size_t)(k0 + 4 * kq) * D + n0 + 4 * nq, D, F.ws + WS_EW2 + (size_t)e * D * DFF + (size_t)(n0 + 4 * nq) * DFF + k0 + 4 * kq, DFF, F8S_W2};
}
__device__ __forceinline__ void convert_experts(Frame& F) {
    const int gw = F.bid * 4 + (F.wave - 4), NGW = F.G * 4;
    constexpr int NIT = NEXP * ((N13 / 32) * (D / 32) + (D / 32) * (DFF / 32));
#define CV_LOAD(buf, d) do { _Pragma("unroll") for (int j = 0; j < 4; ++j) buf[j] = *(const f32x4*)((d).src + (size_t)j * (d).ldw); __builtin_amdgcn_sched_barrier(0); } while (0)
#define CV_FIN(buf, d) do { _Pragma("unroll") for (int i = 0; i < 4; ++i) \
            *(unsigned*)((d).dst + (size_t)i * (d).Kd) = pk4_f8(buf[0][i] * (d).scale, buf[1][i] * (d).scale, buf[2][i] * (d).scale, buf[3][i] * (d).scale); \
        __builtin_amdgcn_sched_barrier(0); } while (0)
    int it = gw; if (it >= NIT) return;
    CvItem dA = cv_item(F, it), dB = dA; f32x4 A[4], B[4];
    CV_LOAD(A, dA);
    for (;;) {
        const int itB = it + NGW; const bool hB = itB < NIT;
        dB = cv_item(F, hB ? itB : it); CV_LOAD(B, dB);
        CV_FIN(A, dA);
        if (!hB) break;
        it = itB + NGW; const bool hA = it < NIT;
        dA = cv_item(F, hA ? it : itB); CV_LOAD(A, dA);
        CV_FIN(B, dB);
        if (!hA) break;
    }
#undef CV_LOAD
#undef CV_FIN
}

__device__ __forceinline__ void cvt8(const u32x4 w, float (&f)[8]) { f[0] = bflo(w.x); f[1] = bfhi(w.x); f[2] = bflo(w.y); f[3] = bfhi(w.y); f[4] = bflo(w.z); f[5] = bfhi(w.z); f[6] = bflo(w.w); f[7] = bfhi(w.w); }
__device__ __forceinline__ void conv_phase(Frame& F, int wg0, int nwg) {
    const bf16_t* P = (const bf16_t*)(F.ws + WS_P); bf16_t* Y = (bf16_t*)(F.ws + WS_Y);
    const float* cw = F.in[I_CONVW];
    constexpr int STRIP = 16, NSTRIP = LP / STRIP, NCG = DCONV / 8;
    const int gt = (F.bid - wg0) * NTHREADS + F.tid, NGT = nwg * NTHREADS;
    for (int it = gt; it < NB * NSTRIP * NCG; it += NGT) {
        const int cg = it % NCG, sp = (it / NCG) % NSTRIP, b = it / (NCG * NSTRIP), c = cg * 8, p0 = sp * STRIP;
        float w0[8], w1[8], w2[8];
#pragma unroll
        for (int j = 0; j < 8; ++j) { w0[j] = cw[c + j]; w1[j] = cw[DCONV + c + j]; w2[j] = cw[2 * DCONV + c + j]; }
        float z1[8], z2[8];
#pragma unroll
        for (int j = 0; j < 8; ++j) { z1[j] = 0.f; z2[j] = 0.f; }
        for (int d = 2; d >= 1; --d) { const int pos = p0 - d; if (pos >= 0) { const bf16_t* row = P + (size_t)(b * LP + pos) * NIN_E;
                float cgv[8], xv[8]; cvt8(*(const u32x4*)(row + DCONV + c), cgv); cvt8(*(const u32x4*)(row + 2 * DCONV + c), xv);
#pragma unroll
                for (int j = 0; j < 8; ++j) { if (d == 2) z2[j] = cgv[j] * xv[j]; else z1[j] = cgv[j] * xv[j]; } } }
        for (int s4 = 0; s4 < STRIP; s4 += 4) {
            u32x4 rb[4], rc[4], rx[4];
#pragma unroll
            for (int q = 0; q < 4; ++q) { const bf16_t* row = P + (size_t)(b * LP + p0 + s4 + q) * NIN_E; rb[q] = *(const u32x4*)(row + c); rc[q] = *(const u32x4*)(row + DCONV + c); rx[q] = *(const u32x4*)(row + 2 * DCONV + c); }
#pragma unroll
            for (int q = 0; q < 4; ++q) { const int pos = p0 + s4 + q;
                float bg[8], cgv[8], xv[8]; cvt8(rb[q], bg); cvt8(rc[q], cgv); cvt8(rx[q], xv);
                float o[8];
#pragma unroll
                for (int j = 0; j < 8; ++j) { const float z0 = cgv[j] * xv[j]; o[j] = bg[j] * (w0[j] * z2[j] + w1[j] * z1[j] + w2[j] * z0); z2[j] = z1[j]; z1[j] = z0; }
                u32x4 w; w.x = pk2(o[0], o[1]); w.y = pk2(o[2], o[3]); w.z = pk2(o[4], o[5]); w.w = pk2(o[6], o[7]);
                *(u32x4*)(Y + (size_t)(b * LP + pos) * D + c) = w; } }
    }
}
constexpr size_t WS_MS5 = WS_XE;
__device__ __forceinline__ void s5_build_matrices(Frame& F) {
    const float* T = (const float*)(F.ws + WS_S5T); bf16_t* MS = (bf16_t*)(F.ws + WS_MS5);
    const int gt = F.bid * NTHREADS + F.tid, NGT = F.G * NTHREADS;
    for (int e = gt; e < 32 * 3 * 16384; e += NGT) {
        const int k = e & 127, r = (e >> 7) & 127, m = (e >> 14) % 3, g = e / (3 * 16384);
        const float* PW = T + 73728 + (size_t)g * 64 * 18; const float* BB = T + 8192 + (size_t)g * 64 * 32;
        float v = 0.f;
        if (m == 0) { const int t = r >> 4, c = r & 15, s = k >> 4, c2 = k & 15;
            if (s <= t) { const int tau = t - s; const float* cre = F.in[I_CRE] + ((size_t)g * 16 + c) * 64; const float* cim = F.in[I_CIM] + ((size_t)g * 16 + c) * 64;
                for (int p = 0; p < 64; ++p) { const float ar = PW[p * 18 + 2 * tau], ai = PW[p * 18 + 2 * tau + 1], br = BB[p * 32 + 2 * c2], bi = BB[p * 32 + 2 * c2 + 1];
                    const float abr_ = ar * br - ai * bi, abi_ = ar * bi + ai * br; v += cre[p] * abr_ - cim[p] * abi_; }
                if (tau == 0 && c == c2) v += F.in[I_S5D][g * 16 + c]; } }
        else if (m == 1) { const int p = r >> 1, ri = r & 1, s = k >> 4, c2 = k & 15; const int tau = 7 - s;
            const float ar = PW[p * 18 + 2 * tau], ai = PW[p * 18 + 2 * tau + 1], br = BB[p * 32 + 2 * c2], bi = BB[p * 32 + 2 * c2 + 1];
            v = ri ? (ar * bi + ai * br) : (ar * br - ai * bi); }
        else { const int t = r >> 4, c = r & 15, p = k >> 1, ri = k & 1; const int tau = t + 1;
            const float ar = PW[p * 18 + 2 * tau], ai = PW[p * 18 + 2 * tau + 1], cr = F.in[I_CRE][((size_t)g * 16 + c) * 64 + p], ci = F.in[I_CIM][((size_t)g * 16 + c) * 64 + p];
            v = ri ? -(cr * ai + ci * ar) : (cr * ar - ci * ai); }
        MS[e] = (bf16_t)f2bf(v);
    }
}
template <int CTRL> __device__ __forceinline__ float dpp_row_f(float old, float src) { return __int_as_float(__builtin_amdgcn_update_dpp(__float_as_int(old), __float_as_int(src), CTRL, 0xf, 0xf, false)); }
constexpr int S5X_ROW = 272, S5X_BUF = 16 * S5X_ROW;
template <bool SPLIT>
__device__ __forceinline__ void s5_ssd_unit(Frame& F, int b, int g, int half) {
    const bf16_t* P = (const bf16_t*)(F.ws + WS_P); bf16_t* Y = (bf16_t*)(F.ws + WS_Y);
    const float* T = (const float*)(F.ws + WS_S5T); const bf16_t* MS = (const bf16_t*)(F.ws + WS_MS5) + (size_t)g * 3 * 16384;
    const int lane = F.lane, w = F.wave, ql = lane & 15, gq = lane >> 4;
    bf16x8 A1[4], A2[4], A3[4];
#pragma unroll
    for (int ks = 0; ks < 4; ++ks) { const int off = (16 * w + ql) * 128 + 32 * ks + 8 * gq;
        A1[ks] = *(const bf16x8*)(MS + off); A2[ks] = *(const bf16x8*)(MS + 16384 + off); A3[ks] = *(const bf16x8*)(MS + 32768 + off); }
    float m1r[2], m1i[2], m2r[2], m2i[2], m4r[2], m4i[2], m8r[2], m8i[2];
#pragma unroll
    for (int j = 0; j < 2; ++j) { const float* PW = T + 73728 + ((size_t)g * 64 + 8 * w + 2 * gq + j) * 18 + 16;
        m1r[j] = PW[0]; m1i[j] = PW[1]; m2r[j] = m1r[j] * m1r[j] - m1i[j] * m1i[j]; m2i[j] = 2.f * m1r[j] * m1i[j];
        m4r[j] = m2r[j] * m2r[j] - m2i[j] * m2i[j]; m4i[j] = 2.f * m2r[j] * m2i[j]; m8r[j] = m4r[j] * m4r[j] - m4i[j] * m4i[j]; m8i[j] = 2.f * m4r[j] * m4i[j]; }
    bf16x8 Awg; { const float* wg = F.in[I_WGLU] + (size_t)g * 256 + ql * 16 + 4 * gq; u32x4 t_; t_.x = pk2(wg[0], wg[1]); t_.y = pk2(wg[2], wg[3]); t_.z = 0u; t_.w = 0u; Awg = __builtin_bit_cast(bf16x8, t_); }
    float cr[2] = {0.f, 0.f}, ci[2] = {0.f, 0.f};
    const size_t rowb = (size_t)b * LP;
    const bf16_t* ubase = P + (rowb + 8 * ql + (gq >> 1)) * NIN_E + 3 * DCONV + g * 16 + 8 * (gq & 1);
    bf16x8 Bu[4], Bn[4];
    constexpr int NCH = LP / 128, CSPLIT = 65;
    if (half) {
#pragma unroll
        for (int ks = 0; ks < 4; ++ks) Bu[ks] = *(const bf16x8*)(ubase + (size_t)(2 * ks) * NIN_E);
        for (int ch = 0; ch < CSPLIT; ++ch) {
            if (ch + 1 < CSPLIT) {
#pragma unroll
                for (int ks = 0; ks < 4; ++ks) Bn[ks] = *(const bf16x8*)(ubase + ((size_t)(ch + 1) * 128 + 2 * ks) * NIN_E); }
            f32x4 IN = (f32x4){0.f, 0.f, 0.f, 0.f};
#pragma unroll
            for (int ks = 0; ks < 4; ++ks) IN = MFMA16(A2[ks], Bu[ks], IN, 0, 0, 0);
            float er[2] = {IN[0], IN[2]}, ei[2] = {IN[1], IN[3]};
#pragma unroll
            for (int j = 0; j < 2; ++j) {
                if (ql == 0) { er[j] += m1r[j] * cr[j] - m1i[j] * ci[j]; ei[j] += m1r[j] * ci[j] + m1i[j] * cr[j]; }
                { const float tr = dpp_row_f<0x111>(0.f, er[j]), ti = dpp_row_f<0x111>(0.f, ei[j]); er[j] += m1r[j] * tr - m1i[j] * ti; ei[j] += m1r[j] * ti + m1i[j] * tr; }
                { const float tr = dpp_row_f<0x112>(0.f, er[j]), ti = dpp_row_f<0x112>(0.f, ei[j]); er[j] += m2r[j] * tr - m2i[j] * ti; ei[j] += m2r[j] * ti + m2i[j] * tr; }
                { const float tr = dpp_row_f<0x114>(0.f, er[j]), ti = dpp_row_f<0x114>(0.f, ei[j]); er[j] += m4r[j] * tr - m4i[j] * ti; ei[j] += m4r[j] * ti + m4i[j] * tr; }
                { const float tr = dpp_row_f<0x118>(0.f, er[j]), ti = dpp_row_f<0x118>(0.f, ei[j]); er[j] += m8r[j] * tr - m8i[j] * ti; ei[j] += m8r[j] * ti + m8i[j] * tr; }
                cr[j] = __shfl(er[j], (lane & 48) | 15); ci[j] = __shfl(ei[j], (lane & 48) | 15);
            }
#pragma unroll
            for (int ks = 0; ks < 4; ++ks) Bu[ks] = Bn[ks];
        }
    }
    const int ch0 = half ? CSPLIT : 0, ch1 = (half || !SPLIT) ? NCH : CSPLIT;
#pragma unroll
    for (int ks = 0; ks < 4; ++ks) Bu[ks] = *(const bf16x8*)(ubase + ((size_t)ch0 * 128 + 2 * ks) * NIN_E);
    for (int ch = ch0; ch < ch1; ++ch) {
        if (ch + 1 < ch1) {
#pragma unroll
            for (int ks = 0; ks < 4; ++ks) Bn[ks] = *(const bf16x8*)(ubase + ((size_t)(ch + 1) * 128 + 2 * ks) * NIN_E); }
        f32x4 IN = (f32x4){0.f, 0.f, 0.f, 0.f};
#pragma unroll
        for (int ks = 0; ks < 4; ++ks) IN = MFMA16(A2[ks], Bu[ks], IN, 0, 0, 0);
        float er[2] = {IN[0], IN[2]}, ei[2] = {IN[1], IN[3]}, xr[2], xi[2];
#pragma unroll
        for (int j = 0; j < 2; ++j) {
            if (ql == 0) { er[j] += m1r[j] * cr[j] - m1i[j] * ci[j]; ei[j] += m1r[j] * ci[j] + m1i[j] * cr[j]; }
            { const float tr = dpp_row_f<0x111>(0.f, er[j]), ti = dpp_row_f<0x111>(0.f, ei[j]); er[j] += m1r[j] * tr - m1i[j] * ti; ei[j] += m1r[j] * ti + m1i[j] * tr; }
            { const float tr = dpp_row_f<0x112>(0.f, er[j]), ti = dpp_row_f<0x112>(0.f, ei[j]); er[j] += m2r[j] * tr - m2i[j] * ti; ei[j] += m2r[j] * ti + m2i[j] * tr; }
            { const float tr = dpp_row_f<0x114>(0.f, er[j]), ti = dpp_row_f<0x114>(0.f, ei[j]); er[j] += m4r[j] * tr - m4i[j] * ti; ei[j] += m4r[j] * ti + m4i[j] * tr; }
            { const float tr = dpp_row_f<0x118>(0.f, er[j]), ti = dpp_row_f<0x118>(0.f, ei[j]); er[j] += m8r[j] * tr - m8i[j] * ti; ei[j] += m8r[j] * ti + m8i[j] * tr; }
            xr[j] = dpp_row_f<0x111>(cr[j], er[j]); xi[j] = dpp_row_f<0x111>(ci[j], ei[j]);
            cr[j] = __shfl(er[j], (lane & 48) | 15); ci[j] = __shfl(ei[j], (lane & 48) | 15);
        }
        LAS unsigned char* xb = F.lds + (ch & 1) * S5X_BUF;
        *(LAS u32x2*)(xb + ql * S5X_ROW + (16 * w + 4 * gq) * 2) = (u32x2){pk2(xr[0], xi[0]), pk2(xr[1], xi[1])};
        RAW_BAR();
        f32x4 Yt = (f32x4){0.f, 0.f, 0.f, 0.f};
#pragma unroll
        for (int ks = 0; ks < 4; ++ks) Yt = MFMA16(A1[ks], Bu[ks], Yt, 0, 0, 0);
#pragma unroll
        for (int ks = 0; ks < 4; ++ks) { const bf16x8 Bx = *(const LAS bf16x8*)(xb + ql * S5X_ROW + (32 * ks + 8 * gq) * 2); Yt = MFMA16(A3[ks], Bx, Yt, 0, 0, 0); }
        float y[4];
#pragma unroll
        for (int i = 0; i < 4; ++i) { const float v = Yt[i]; y[i] = v * fast_sigmoid(1.5957691216f * (v + 0.044715f * v * v * v)); }
        u32x4 by; by.x = pk2(y[0], y[1]); by.y = pk2(y[2], y[3]); by.z = 0u; by.w = 0u;
        const f32x4 Z = MFMA16(Awg, __builtin_bit_cast(bf16x8, by), (f32x4){0.f, 0.f, 0.f, 0.f}, 0, 0, 0);
        u32x2 o; o.x = pk2(y[0] * fast_sigmoid(Z[0]), y[1] * fast_sigmoid(Z[1])); o.y = pk2(y[2] * fast_sigmoid(Z[2]), y[3] * fast_sigmoid(Z[3]));
        *(u32x2*)(Y + (rowb + (size_t)ch * 128 + 8 * ql + w) * D + DCONV + g * 16 + 4 * gq) = o;
#pragma unroll
        for (int ks = 0; ks < 4; ++ks) Bu[ks] = Bn[ks];
    }
}

template <bool ROUTER, int QOUT = (ROUTER ? 1 : 0)>
__device__ __forceinline__ void ln_phase(Frame& F, const bf16_t* PRE, bf16_t* H, const float* gam, const float* bet, unsigned char* H8 = nullptr) {
    const int gw = F.bid * NWAVES + F.wave, NGW = F.G * NWAVES;
    LAS unsigned* lcnt = (LAS unsigned*)(F.lds + LDS_MISC + 64);
    if (ROUTER) { if (F.tid < 16) lcnt[F.tid] = 0u; __syncthreads(); }
    f32x4 gv[8], bv[8];
#pragma unroll
    for (int j = 0; j < 8; ++j) { gv[j] = *(const f32x4*)(gam + 4 * F.lane + 256 * j); bv[j] = *(const f32x4*)(bet + 4 * F.lane + 256 * j); }
    for (int r = gw; r < M; r += NGW) {
        if (ROUTER && !(r % LP >= NMETA && r % LP < LR)) continue;
        if (!ROUTER && r % LP >= LR) {
            u32x2* o8 = (u32x2*)(H + (size_t)r * D) + F.lane;
#pragma unroll
            for (int j = 0; j < 8; ++j) o8[64 * j] = (u32x2){0u, 0u};
            if (QOUT) { unsigned* o4 = (unsigned*)(H8 + (size_t)r * D) + F.lane;
#pragma unroll
                for (int j = 0; j < 8; ++j) o4[64 * j] = 0u; }
            continue; }
        const u32x2* xr = (const u32x2*)(PRE + (size_t)r * D) + F.lane;
        f32x4 v[8]; float s = 0.f;
#pragma unroll
        for (int j = 0; j < 8; ++j) { const u32x2 x = xr[64 * j]; v[j] = (f32x4){bflo(x.x), bfhi(x.x), bflo(x.y), bfhi(x.y)}; s += (v[j][0] + v[j][1]) + (v[j][2] + v[j][3]); }
        const float mean = wave_sum(s) * (1.f / D); float s2 = 0.f;
#pragma unroll
        for (int j = 0; j < 8; ++j) { v[j] = v[j] - mean; s2 += (v[j][0] * v[j][0] + v[j][1] * v[j][1]) + (v[j][2] * v[j][2] + v[j][3] * v[j][3]); }
        const float rstd = 1.f / sqrtf(wave_sum(s2) * (1.f / D) + LN_EPS);
        u32x2* o8 = (u32x2*)(H + (size_t)r * D) + F.lane;
#pragma unroll
        for (int j = 0; j < 8; ++j) { v[j] = v[j] * rstd * gv[j] + bv[j]; u32x2 w; w.x = pk2(v[j][0], v[j][1]); w.y = pk2(v[j][2], v[j][3]); o8[64 * j] = w; }
        if (QOUT) { unsigned* o4 = (unsigned*)(H8 + (size_t)r * D) + F.lane;
#pragma unroll
            for (int j = 0; j < 8; ++j) o4[64 * j] = (QOUT == 2) ? pk4_i8(v[j][0] * I8S_H, v[j][1] * I8S_H, v[j][2] * I8S_H, v[j][3] * I8S_H) : pk4_f8(v[j][0] * F8S_H3, v[j][1] * F8S_H3, v[j][2] * F8S_H3, v[j][3] * F8S_H3); }
        if (ROUTER) {
            {
                const float* rw = F.in[I_RW];
                float lg[8];
#pragma unroll
                for (int e = 0; e < 8; ++e) lg[e] = 0.f;
#pragma unroll
                for (int j = 0; j < 8; ++j)
#pragma unroll
                    for (int q = 0; q < 4; ++q) { const int c = 4 * F.lane + 256 * j + q; const f32x4 w0 = *(const f32x4*)(rw + (size_t)c * 8), w1 = *(const f32x4*)(rw + (size_t)c * 8 + 4); const float x = v[j][q];
                        lg[0] += x * w0[0]; lg[1] += x * w0[1]; lg[2] += x * w0[2]; lg[3] += x * w0[3]; lg[4] += x * w1[0]; lg[5] += x * w1[1]; lg[6] += x * w1[2]; lg[7] += x * w1[3]; }
#pragma unroll
                for (int e = 0; e < 8; ++e) lg[e] = wave_sum(lg[e]) + F.in[I_RB][e];
                int e0 = 0; float v0 = lg[0];
#pragma unroll
                for (int e = 1; e < 8; ++e) if (lg[e] > v0) { v0 = lg[e]; e0 = e; }
                int e1 = -1; float v1 = -3.0e38f;
#pragma unroll
                for (int e = 0; e < 8; ++e) if (e != e0 && lg[e] > v1) { v1 = lg[e]; e1 = e; }
                const float p1 = __expf(v1 - v0), g0 = 1.f / (1.f + p1), g1 = p1 * g0;
                if (F.lane == 0) {
                    int* TE = (int*)(F.ws + WS_MOE + MO_TOKE); float* TG = (float*)(F.ws + WS_MOE + MO_TOKG); int* TP = (int*)(F.ws + WS_MOE + MO_TOKPOS);
                    const unsigned q0 = __hip_atomic_fetch_add(lcnt + e0, 1u, __ATOMIC_RELAXED, __HIP_MEMORY_SCOPE_WORKGROUP);
                    const unsigned q1 = __hip_atomic_fetch_add(lcnt + e1, 1u, __ATOMIC_RELAXED, __HIP_MEMORY_SCOPE_WORKGROUP);
                    TE[2 * r] = e0; TE[2 * r + 1] = e1; TG[2 * r] = g0; TG[2 * r + 1] = g1; TP[2 * r] = (int)q0; TP[2 * r + 1] = (int)q1;
                }
            }
        }
    }
    if (ROUTER) {
        __syncthreads();
        if (F.tid < 8) lcnt[8 + F.tid] = __hip_atomic_fetch_add(F.ctl + CW_CNT + 64 * F.tid, lcnt[F.tid], __ATOMIC_RELAXED, __HIP_MEMORY_SCOPE_AGENT);
        __syncthreads();
        const int* TE = (const int*)(F.ws + WS_MOE + MO_TOKE); int* TP = (int*)(F.ws + WS_MOE + MO_TOKPOS);
        for (int r = gw; r < M; r += NGW) if (r % LP >= NMETA && r % LP < LR && F.lane < 2) TP[2 * r + F.lane] += (int)lcnt[8 + TE[2 * r + F.lane]];
    }
}
__device__ __forceinline__ void route_phase(Frame& F) {
    int cnt[8], ps[8]; int tot = 0;
#pragma unroll
    for (int e = 0; e < 8; ++e) { cnt[e] = (int)__hip_atomic_load(F.ctl + CW_CNT + 64 * e, __ATOMIC_RELAXED, __HIP_MEMORY_SCOPE_AGENT); ps[e] = tot; tot += (cnt[e] + 255) / 256 * 256; }
    const int* TE = (const int*)(F.ws + WS_MOE + MO_TOKE); const int* TP = (const int*)(F.ws + WS_MOE + MO_TOKPOS);
    int* TS = (int*)(F.ws + WS_MOE + MO_TOKSLOT); int* ST = (int*)(F.ws + WS_MOE + MO_SLOTTOK); int* TL = (int*)(F.ws + WS_MOE + MO_TILEE);
    int tid_ = F.tid; asm volatile("" : "+v"(tid_));
    const int gt = F.bid * NTHREADS + tid_, NGT = F.G * NTHREADS;
    for (int a = gt; a < 2 * M; a += NGT) { const int r = a >> 1; if (r % LP >= NMETA && r % LP < LR) { const int e = TE[a]; int base = 0;
#pragma unroll
            for (int j = 0; j < 8; ++j) base = (j == e) ? ps[j] : base;
            const int slot = base + TP[a]; TS[a] = slot; ST[slot] = r; } }
    for (int s = gt; s < tot; s += NGT) { int e = 0;
#pragma unroll
        for (int j = 1; j < 8; ++j) e = (s >= ps[j]) ? j : e;
        int pe = 0, ce = 0;
#pragma unroll
        for (int j = 0; j < 8; ++j) { pe = (j == e) ? ps[j] : pe; ce = (j == e) ? cnt[j] : ce; }
        if (s - pe >= ce) ST[s] = NMETA;
        if ((s & 255) == 0) TL[s >> 8] = e; }
    if (gt == 0) TL[300] = tot >> 8;
}
__device__ __forceinline__ void final_phase(Frame& F) {
    const bf16_t* H = (const bf16_t*)(F.ws + WS_H3); const unsigned char* YB = F.ws + WS_YB;
    const int* TS = (const int*)(F.ws + WS_MOE + MO_TOKSLOT); const float* TG = (const float*)(F.ws + WS_MOE + MO_TOKG);
    const float* gam = F.in[I_LN4G]; const float* bet = F.in[I_LN4B];
    const int gw = F.bid * NWAVES + F.wave, NGW = F.G * NWAVES;
    f32x4 gv[8], bv[8];
#pragma unroll
    for (int j = 0; j < 8; ++j) { gv[j] = *(const f32x4*)(gam + 4 * F.lane + 256 * j); bv[j] = *(const f32x4*)(bet + 4 * F.lane + 256 * j); }
    for (int o = gw; o < NB * SEQ; o += NGW) {
        const int b = o / SEQ, s = o % SEQ, r = b * LP + NMETA + s;
        const int s0 = TS[2 * r], s1 = TS[2 * r + 1]; const float g0 = TG[2 * r], g1 = TG[2 * r + 1];
        const u32x2* hr = (const u32x2*)(H + (size_t)r * D) + F.lane; const unsigned* y0 = (const unsigned*)(YB + (size_t)s0 * D) + F.lane; const unsigned* y1 = (const unsigned*)(YB + (size_t)s1 * D) + F.lane;
        const float h0 = g0 * (1.f / F8S_YB), h1 = g1 * (1.f / F8S_YB);
        f32x4 v[8]; float sm = 0.f;
#pragma unroll
        for (int j = 0; j < 8; ++j) { const u32x2 hw = hr[64 * j]; const unsigned a = y0[64 * j], c = y1[64 * j];
            const auto a01 = __builtin_amdgcn_cvt_pk_f32_fp8((int)a, false), a23 = __builtin_amdgcn_cvt_pk_f32_fp8((int)a, true), c01 = __builtin_amdgcn_cvt_pk_f32_fp8((int)c, false), c23 = __builtin_amdgcn_cvt_pk_f32_fp8((int)c, true);
            v[j][0] = ALPHA * bflo(hw.x) + h0 * a01[0] + h1 * c01[0]; v[j][1] = ALPHA * bfhi(hw.x) + h0 * a01[1] + h1 * c01[1];
            v[j][2] = ALPHA * bflo(hw.y) + h0 * a23[0] + h1 * c23[0]; v[j][3] = ALPHA * bfhi(hw.y) + h0 * a23[1] + h1 * c23[1];
            sm += (v[j][0] + v[j][1]) + (v[j][2] + v[j][3]); }
        const float mean = wave_sum(sm) * (1.f / D); float s2 = 0.f;
#pragma unroll
        for (int j = 0; j < 8; ++j) { v[j] = v[j] - mean; s2 += (v[j][0] * v[j][0] + v[j][1] * v[j][1]) + (v[j][2] * v[j][2] + v[j][3] * v[j][3]); }
        const float rstd = 1.f / sqrtf(wave_sum(s2) * (1.f / D) + LN_EPS);
        f32x4* op = (f32x4*)(F.out + (size_t)o * D) + F.lane;
#pragma unroll
        for (int j = 0; j < 8; ++j) op[64 * j] = v[j] * rstd * gv[j] + bv[j];
    }
}
#define pk2 pk2_b
#define bflo bflo_b
#define bfhi bfhi_b
#define bf2f bf2f_b
#define MFMA16 MFMA16_b
#define ONE16X2 0x3F803F80u
__device__ __forceinline__ int dsa_kend(int q) { return q < NMETA ? NMETA : NMETA + 64 * (1 + (q - NMETA) / 64); }
constexpr int D1_CAP = 512, D1_BUF = 0, D1_HIST = 16 * D1_CAP * 4, D1_BMP = D1_HIST + 1024, D1_CNT = D1_BMP + BMP_PITCH * 4, D1_WAVE = D1_CNT + 64; static_assert(D1_WAVE == D1_WAVE_BYTES && 4 * D1_WAVE + 4 * 4352 <= LDS_MISC, "top-k LDS map");
__device__ __forceinline__ unsigned d1_mono(float f) { const unsigned u = __float_as_uint(f); return (u & 0x80000000u) ? ~u : (u | 0x80000000u); }
template <int CTRL, int ROWMASK> __device__ __forceinline__ int dpp_int(int old, int src) { return __builtin_amdgcn_update_dpp(old, src, CTRL, ROWMASK, 0xf, false); }
__device__ __forceinline__ int wave_scan_add_i(int v) {
    v += dpp_int<0x111, 0xf>(0, v); v += dpp_int<0x112, 0xf>(0, v); v += dpp_int<0x114, 0xf>(0, v); v += dpp_int<0x118, 0xf>(0, v);
    v += dpp_int<0x142, 0xa>(0, v); v += dpp_int<0x143, 0xc>(0, v); return v;
}
__device__ __forceinline__ unsigned d1_refresh(LAS unsigned* buf, LAS unsigned* hist, LAS unsigned* cnt, int qq, int lane) {
    const int n = (int)cnt[qq];
    LAS unsigned* bq = buf + qq * D1_CAP;
    unsigned e[8];
#pragma unroll
    for (int i = 0; i < 8; ++i) e[i] = (lane + 64 * i < n) ? bq[lane + 64 * i] : 0u;
    unsigned prefix = 0u; int need = 256;
#pragma unroll 1
    for (int r = 3; r >= 0; --r) {
        const int shift = 8 * r;
        bool m[8]; unsigned dg[8]; unsigned any_d = 0u; bool uni = true;
#pragma unroll
        for (int i = 0; i < 8; ++i) { m[i] = (e[i] != 0u) && (r == 3 || (e[i] >> (shift + 8)) == (prefix >> (shift + 8))); dg[i] = (e[i] >> shift) & 255u; }
        { unsigned long long bm = 0ull; unsigned first = 0u;
#pragma unroll
          for (int i = 0; i < 8; ++i) { const unsigned long long b_ = __ballot(m[i]); if (bm == 0ull && b_ != 0ull) first = (unsigned)__builtin_amdgcn_readlane((int)dg[i], (int)__builtin_ctzll(b_)); bm |= b_; }
          any_d = first;
#pragma unroll
          for (int i = 0; i < 8; ++i) uni = uni && !__any(m[i] && dg[i] != first); }
        if (uni) { prefix |= any_d << shift; continue; }
        *(LAS u32x4*)(hist + 4 * lane) = (u32x4){0u, 0u, 0u, 0u};
        LDS_WAIT();
#pragma unroll
        for (int i = 0; i < 8; ++i) if (m[i]) __hip_atomic_fetch_add(hist + (255u - dg[i]), 1u, __ATOMIC_RELAXED, __HIP_MEMORY_SCOPE_WORKGROUP);
        LDS_WAIT();
        const u32x4 h4 = *(const LAS u32x4*)(hist + 4 * lane);
        const int s = (int)(h4.x + h4.y + h4.z + h4.w);
        const int S = wave_scan_add_i(s);
        const int above = S - s;
        const bool found = (above < need) && (need <= S);
        int digit = 0, nneed = 0;
        if (found) { int a = above;
            if (a + (int)h4.x >= need) { digit = 255 - 4 * lane; nneed = need - a; }
            else { a += (int)h4.x;
                if (a + (int)h4.y >= need) { digit = 254 - 4 * lane; nneed = need - a; }
                else { a += (int)h4.y;
                    if (a + (int)h4.z >= need) { digit = 253 - 4 * lane; nneed = need - a; }
                    else { a += (int)h4.z; digit = 252 - 4 * lane; nneed = need - a; } } } }
        const unsigned long long fm = __ballot(found);
        const int src = fm ? (int)__builtin_ctzll(fm) : 0;
        digit = __builtin_amdgcn_readlane(digit, src); nneed = __builtin_amdgcn_readlane(nneed, src);
        prefix |= (unsigned)digit << shift; need = nneed;
    }
    const unsigned T = prefix;
    int base = 0;
#pragma unroll
    for (int i = 0; i < 8; ++i) { const bool keep = e[i] >= T && e[i] != 0u; const unsigned long long mk = __ballot(keep);
        const int pos = base + (int)__builtin_popcountll(mk & ((1ull << lane) - 1ull));
        if (keep) bq[pos] = e[i];
        base += (int)__builtin_popcountll(mk); }
    if (lane == 0) cnt[qq] = (unsigned)base;
    LDS_WAIT();
    return T;
}
__device__ __forceinline__ unsigned wave_min_u(unsigned v) {
    const int ni = -1;
    v = min(v, (unsigned)dpp_int<0x111, 0xf>(ni, (int)v)); v = min(v, (unsigned)dpp_int<0x112, 0xf>(ni, (int)v)); v = min(v, (unsigned)dpp_int<0x114, 0xf>(ni, (int)v)); v = min(v, (unsigned)dpp_int<0x118, 0xf>(ni, (int)v));
    v = min(v, (unsigned)dpp_int<0x142, 0xa>(ni, (int)v)); v = min(v, (unsigned)dpp_int<0x143, 0xc>(ni, (int)v));
    return (unsigned)__builtin_amdgcn_readlane((int)v, 63);
}
__device__ __forceinline__ unsigned wave_max_u(unsigned v) {
    v = max(v, (unsigned)dpp_int<0x111, 0xf>(0, (int)v)); v = max(v, (unsigned)dpp_int<0x112, 0xf>(0, (int)v)); v = max(v, (unsigned)dpp_int<0x114, 0xf>(0, (int)v)); v = max(v, (unsigned)dpp_int<0x118, 0xf>(0, (int)v));
    v = max(v, (unsigned)dpp_int<0x142, 0xa>(0, (int)v)); v = max(v, (unsigned)dpp_int<0x143, 0xc>(0, (int)v));
    return (unsigned)__builtin_amdgcn_readlane((int)v, 63);
}
template <bool EXACT>
__device__ __forceinline__ unsigned d1_select(LAS unsigned* buf, LAS unsigned* hist, LAS unsigned* cnt, int qq, int lane) {
    const int n = (int)cnt[qq];
    LAS unsigned* bq = buf + qq * D1_CAP;
    unsigned e[8];
#pragma unroll
    for (int i = 0; i < 8; ++i) e[i] = (lane + 64 * i < n) ? bq[lane + 64 * i] : 0u;
    unsigned lmin = 0xFFFFFFFFu, lmax = 0u;
#pragma unroll
    for (int i = 0; i < 8; ++i) { const unsigned k = e[i] >> 17; lmin = (e[i] != 0u) ? min(lmin, k) : lmin; lmax = (e[i] != 0u) ? max(lmax, k) : lmax; }
    const unsigned kmin = wave_min_u(lmin), kmax = wave_max_u(lmax);
    const float inv = 256.0f / (float)(kmax - kmin + 1u);
    int bin[8];
#pragma unroll
    for (int i = 0; i < 8; ++i) { const int b_ = (int)((float)((e[i] >> 17) - kmin) * inv); bin[i] = b_ > 255 ? 255 : b_; }
    *(LAS u32x4*)(hist + 4 * lane) = (u32x4){0u, 0u, 0u, 0u};
    LDS_WAIT();
#pragma unroll
    for (int i = 0; i < 8; ++i) if (e[i] != 0u) __hip_atomic_fetch_add(hist + (255 - bin[i]), 1u, __ATOMIC_RELAXED, __HIP_MEMORY_SCOPE_WORKGROUP);
    LDS_WAIT();
    const u32x4 h4 = *(const LAS u32x4*)(hist + 4 * lane);
    const int s_ = (int)(h4.x + h4.y + h4.z + h4.w);
    const int S = wave_scan_add_i(s_);
    const int above_l = S - s_;
    const bool found = (above_l < 256) && (256 <= S);
    int bstar = 0, above = 0, cb = 0;
    if (found) { int a = above_l;
        if (a + (int)h4.x >= 256) { bstar = 255 - 4 * lane; above = a; cb = (int)h4.x; }
        else { a += (int)h4.x;
            if (a + (int)h4.y >= 256) { bstar = 254 - 4 * lane; above = a; cb = (int)h4.y; }
            else { a += (int)h4.y;
                if (a + (int)h4.z >= 256) { bstar = 253 - 4 * lane; above = a; cb = (int)h4.z; }
                else { a += (int)h4.z; bstar = 252 - 4 * lane; above = a; cb = (int)h4.w; } } } }
    const unsigned long long fm = __ballot(found);
    const int src = fm ? (int)__builtin_ctzll(fm) : 0;
    bstar = __builtin_amdgcn_readlane(bstar, src); above = __builtin_amdgcn_readlane(above, src); cb = __builtin_amdgcn_readlane(cb, src);
    unsigned T;
    if (!EXACT) {
        if (above + cb > D1_CAP - 128) return d1_refresh(buf, hist, cnt, qq, lane);
        unsigned lk = 0xFFFFFFFFu;
#pragma unroll
        for (int i = 0; i < 8; ++i) lk = (e[i] != 0u && bin[i] >= bstar) ? min(lk, e[i]) : lk;
        T = wave_min_u(lk);
    } else {
        if (cb > 48) return d1_refresh(buf, hist, cnt, qq, lane);
        unsigned cur = 0xFFFFFFFFu;
        for (int it = above; it < 256; ++it) {
            unsigned lm = 0u;
#pragma unroll
            for (int i = 0; i < 8; ++i) lm = (bin[i] == bstar && e[i] < cur) ? max(lm, e[i]) : lm;
            cur = wave_max_u(lm);
        }
        T = cur;
    }
    int base = 0;
#pragma unroll
    for (int i = 0; i < 8; ++i) { const bool keep = e[i] >= T && e[i] != 0u; const unsigned long long mk = __ballot(keep);
        const int pos = base + (int)__builtin_popcountll(mk & ((1ull << lane) - 1ull));
        if (keep) bq[pos] = e[i];
        base += (int)__builtin_popcountll(mk); }
    if (lane == 0) cnt[qq] = (unsigned)base;
    LDS_WAIT();
    return EXACT ? T : T - 1u;
}
#ifndef PROBE_D1
#define PROBE_D1 0
#endif
__device__ __forceinline__ void d1_qprefix(unsigned c, int g, unsigned& pre, unsigned& tot) {
    const auto s16 = __builtin_amdgcn_permlane16_swap(c, c, false, false);
    const unsigned ce = s16[0], co = s16[1], ps = ce + co;
    const auto s32 = __builtin_amdgcn_permlane32_swap(ps, ps, false, false);
    const unsigned lo = s32[0], hi = s32[1];
    pre = ((g & 2) ? lo : 0u) + ((g & 1) ? ce : 0u); tot = lo + hi;
}
__device__ __forceinline__ void d1_append(LAS unsigned* buf, LAS unsigned* hist, LAS unsigned* cnt, const unsigned (&pk)[8], unsigned& thr, unsigned& qcnt, const int ql, const int g, const int lane) {
    unsigned c = 0u;
#pragma unroll
    for (int i = 0; i < 8; ++i) c += (pk[i] > thr) ? 1u : 0u;
    unsigned pre, tot; d1_qprefix(c, g, pre, tot);
    unsigned wp = ql * D1_CAP + qcnt + pre;
#pragma unroll
    for (int i = 0; i < 8; ++i) { const bool t = pk[i] > thr; buf[t ? wp : (unsigned)(16 * D1_CAP) + (unsigned)lane] = pk[i]; wp += t ? 1u : 0u; }
    qcnt += tot;
    unsigned long long fm = __ballot(qcnt > (unsigned)(D1_CAP - 32)) & 0xFFFFull;
    if (fm) {
        if (g == 0) cnt[ql] = qcnt;
        LDS_WAIT();
        while (fm) { const int qq = (int)__builtin_ctzll(fm); fm &= fm - 1ull;
            const unsigned T = d1_select<false>(buf, hist, cnt, qq, lane);
            if (ql == qq) thr = T; }
        qcnt = cnt[ql];
    }
}
__device__ __forceinline__ void d1_unit(Frame& F, LAS unsigned char* wl, int b, int qg, int rep) {
    const bf16_t* PA = (const bf16_t*)(F.ws + WS_P); unsigned* BMP = (unsigned*)(F.ws + WS_BMP);
    LAS unsigned* buf = (LAS unsigned*)(wl + D1_BUF); LAS unsigned* hist = (LAS unsigned*)(wl + D1_HIST); LAS unsigned* bmp = (LAS unsigned*)(wl + D1_BMP); LAS unsigned* cnt = (LAS unsigned*)(wl + D1_CNT);
    const int lane = F.lane, ql = lane & 15, g = lane >> 4, q0 = qg * 16, kend = dsa_kend(q0);
    const size_t rowq = (size_t)b * LP + q0 + ql;
    long Bq[8][2]; float wq[8];
#pragma unroll
    for (int h = 0; h < 8; ++h) {
#pragma unroll
        for (int ks = 0; ks < 2; ++ks) Bq[h][ks] = *(const long*)(F.ws + WS_QK8 + rowq * T8P + T8_QI + h * 64 + ks * 32 + 8 * g);
        wq[h] = bf2f(PA[rowq * NIN_OA + CA_WI + h]) * (0.35355339059f * 0.125f / (F8S_QK * F8S_QK));
    }
    if (lane < 16) cnt[lane] = 0u;
    LDS_WAIT();
    unsigned thr = 0u;
    const unsigned char* kp = F.ws + WS_KIC + ((size_t)b * LP + ql) * 64 + 16 * g;
    const int ngrp = kend / 16, nit = (ngrp + 1) / 2;
    u32x4 S0[2], S1[2], S2[2];
#define D1_LOADG(dst, it_) do { _Pragma("unroll") for (int j_ = 0; j_ < 2; ++j_) { int gi_ = 2 * (it_) + j_; gi_ = gi_ < ngrp ? gi_ : ngrp - 1; dst[j_] = *(const u32x4*)(kp + (size_t)gi_ * 16 * 64); } } while (0)
#define D1_SCORE(CUR, LD, itv, PK) do { const int it_b = (itv); \
        D1_LOADG(LD, it_b + 2); \
        _Pragma("unroll") for (int j = 0; j < 2; ++j) { \
            float sc[4] = {0.f, 0.f, 0.f, 0.f}; \
            _Pragma("unroll") for (int h = 0; h < 8; ++h) { f32x4 acc = (f32x4){0.f, 0.f, 0.f, 0.f}; \
                acc = __builtin_amdgcn_mfma_f32_16x16x32_fp8_fp8(__builtin_bit_cast(long, (u32x2){CUR[j].x, CUR[j].y}), Bq[h][0], acc, 0, 0, 0); \
                acc = __builtin_amdgcn_mfma_f32_16x16x32_fp8_fp8(__builtin_bit_cast(long, (u32x2){CUR[j].z, CUR[j].w}), Bq[h][1], acc, 0, 0, 0); \
                _Pragma("unroll") for (int i = 0; i < 4; ++i) sc[i] = __builtin_fmaf(wq[h], __int_as_float(max(__float_as_int(acc[i]), 0)), sc[i]); }   \
            const bool gv = (2 * it_b + j) < ngrp; \
            _Pragma("unroll") for (int i = 0; i < 4; ++i) { const unsigned p = (d1_mono(sc[i]) & 0xFFFF8000u) | (unsigned)((2 * it_b + j) * 16 + 4 * g + i); PK[4 * j + i] = gv ? p : 0u; } \
        } \
    } while (0)
#pragma unroll
    for (int h = 0; h < 8; ++h) asm volatile("" :: "v"(Bq[h][0]), "v"(Bq[h][1]), "v"(wq[h]));
    unsigned pkA[8], pkB[8], pkC[8]; unsigned qcnt = 0u;
    D1_LOADG(S0, 0); D1_LOADG(S1, 1);
    D1_SCORE(S0, S2, 0, pkA);
    for (int it = 0; it < nit; it += 3) {
        D1_SCORE(S1, S0, it + 1, pkB); d1_append(buf, hist, cnt, pkA, thr, qcnt, ql, g, lane);
        D1_SCORE(S2, S1, it + 2, pkC); d1_append(buf, hist, cnt, pkB, thr, qcnt, ql, g, lane);
        D1_SCORE(S0, S2, it + 3, pkA); d1_append(buf, hist, cnt, pkC, thr, qcnt, ql, g, lane);
    }
    if (g == 0) cnt[ql] = qcnt;
#undef D1_SCORE
#undef D1_LOADG
    LDS_WAIT();
#pragma unroll 1
    for (int qq = 0; qq < 16; ++qq) {
        if ((int)cnt[qq] > 256) (void)d1_select<true>(buf, hist, cnt, qq, lane);
        const int n = (int)cnt[qq];
#pragma unroll
        for (int j = 0; j < 9; ++j) if (lane + 64 * j < BMP_PITCH) bmp[lane + 64 * j] = 0u;
        LDS_WAIT();
#pragma unroll
        for (int i = 0; i < 4; ++i) if (lane + 64 * i < n) { const unsigned idx = buf[qq * D1_CAP + lane + 64 * i] & 0x7FFFu; __hip_atomic_fetch_or(bmp + (idx >> 5), 1u << (idx & 31u), __ATOMIC_RELAXED, __HIP_MEMORY_SCOPE_WORKGROUP); }
        LDS_WAIT();
        unsigned* orow = BMP + ((size_t)b * LP + q0 + qq) * BMP_PITCH;
#pragma unroll
        for (int j = 0; j < 9; ++j) if (lane + 64 * j < BMP_PITCH) orow[lane + 64 * j] = bmp[lane + 64 * j];
        LDS_WAIT();
    }
}
__device__ __forceinline__ void d1_phase(Frame& F, int rep) {
    if (F.wave >= 4) return;
    LAS unsigned char* wl = F.lds + F.wave * D1_WAVE;
    constexpr int NQG = LR / 16;
    const int b = F.bid & 1;
    for (;;) {
        int u = 0;
        if (F.lane == 0) u = (int)__hip_atomic_fetch_add(F.ctl + CW_Q1 + 64 * (b + 2 * rep), 1u, __ATOMIC_RELAXED, __HIP_MEMORY_SCOPE_AGENT);
        u = __builtin_amdgcn_readfirstlane(u);
        if (u >= NQG) break;
        d1_unit(F, wl, b, NQG - 1 - u, rep);
    }
}

constexpr int D2_KROW8 = 144, D2_VROW8 = 72;
constexpr int D2_KS = 0, D2_KROW = 272, D2_VS = 64 * D2_KROW, D2_VROW = 144, D2_BUF = D2_VS + 128 * D2_VROW, D2_LUT = 2 * D2_BUF, D2_LDS = D2_LUT + 260 * 4;
constexpr float D2_SL2 = 0.08838834764831845f * 1.4426950408889634f / (F8S_QK * F8S_QK),        D2_L2E = 1.4426950408889634f, D2_NEG = -3.0e38f, D2_THR = 11.5f;
__device__ __forceinline__ int t5_bucket_dev(int rel) {
    const int n = rel < 0 ? -rel : rel; int v;
    if (n < 8) v = n; else { int l = 8 + (int)(log((double)n / 8.0) / log(16.0) * 8.0); v = l < 15 ? l : 15; }
    return (rel > 0 ? 16 : 0) + v;
}
typedef float f32x2_t __attribute__((ext_vector_type(2)));
template <bool FAR>
__device__ __forceinline__ void d2_softmax(const f32x4 (&St)[2][4], unsigned (&bw)[2][2], const unsigned (&bwn)[2][2], float (&mrun)[2], float (&lrun)[2], f32x4 (&O)[2][8], long (&Pb)[2][2],
                                           const LAS float* lut, const int g, const int key0, const int (&qpos)[2]) {
    const float bfar = lut[128];
#pragma unroll
    for (int s = 0; s < 2; ++s) {
        const int wsh0 = (int)(bw[s][0] >> (4 * g)), wsh1 = (int)(bw[s][1] >> (4 * g));
        const float mr = mrun[s], cb = bfar - mr;
        float pv[4][4]; float tmax = D2_NEG;
#pragma unroll
        for (int sub = 0; sub < 4; ++sub) {
            const f32x4 xv = St[s][sub] * D2_SL2 + cb;
#pragma unroll
            for (int i = 0; i < 4; ++i) {
                float x = xv[i];
                if (!FAR) { const int rel = key0 + 16 * sub + 4 * g + i - qpos[s]; const int n = rel < 0 ? -rel : rel; const int nn = n < 128 ? n : 128; x = __builtin_fmaf(St[s][sub][i], D2_SL2, lut[rel > 0 ? 129 + nn : nn] - mr); }
                const int t = __builtin_amdgcn_sbfe((sub >> 1) ? wsh1 : wsh0, 16 * (sub & 1) + i, 1);
                const float xm = __int_as_float(__builtin_amdgcn_bitop3_b32(t, __float_as_int(x), __float_as_int(D2_NEG), 0xCA));
                pv[sub][i] = xm; tmax = fmaxf(tmax, xm); } }
        if (__any(tmax > D2_THR)) {
            float tm = fmaxf(tmax, __shfl_xor(tmax, 16)); tm = fmaxf(tm, __shfl_xor(tm, 32));
            const float d = fmaxf(tm, 0.f), alpha = __builtin_amdgcn_exp2f(-d);
            mrun[s] = mr + d; lrun[s] *= alpha;
#pragma unroll
            for (int dt = 0; dt < 8; ++dt) O[s][dt] = O[s][dt] * alpha;
#pragma unroll
            for (int sub = 0; sub < 4; ++sub)
#pragma unroll
                for (int i = 0; i < 4; ++i) pv[sub][i] -= d;
        }
        f32x2_t ps2 = (f32x2_t){0.f, 0.f};
#pragma unroll
        for (int sub = 0; sub < 4; ++sub)
#pragma unroll
            for (int i = 0; i < 4; i += 2) { const float p0 = __builtin_amdgcn_exp2f(pv[sub][i]), p1 = __builtin_amdgcn_exp2f(pv[sub][i + 1]); pv[sub][i] = p0; pv[sub][i + 1] = p1; ps2 += (f32x2_t){p0, p1}; }
        lrun[s] += ps2[0] + ps2[1];
#pragma unroll
        for (int kk = 0; kk < 2; ++kk) { const u32x2 pw = (u32x2){pk4_bf8(pv[2 * kk][0], pv[2 * kk][1], pv[2 * kk][2], pv[2 * kk][3]), pk4_bf8(pv[2 * kk + 1][0], pv[2 * kk + 1][1], pv[2 * kk + 1][2], pv[2 * kk + 1][3])};
            Pb[s][kk] = __builtin_bit_cast(long, pw); }
        bw[s][0] = bwn[s][0]; bw[s][1] = bwn[s][1];
    }
}
#ifndef PROBE_D2
#define PROBE_D2 0
#endif
__device__ __forceinline__ void d2_unit(Frame& F, LAS unsigned char* lds, int b, int jb, int h, int rep) {
    const bf16_t* PA = (const bf16_t*)(F.ws + WS_P); const bf16_t* KVT = (const bf16_t*)(F.ws + WS_KVT); const unsigned* BMP = (const unsigned*)(F.ws + WS_BMP);
    bf16_t* Y = (bf16_t*)(F.ws + WS_Y);
    LAS float* lut = (LAS float*)(lds + D2_LUT);
    const int lane = F.lane, ql = lane & 15, g = lane >> 4, w = F.wave, tid = F.tid;
    const int qbase = jb * 256 + w * 32;
    const int qlast = (jb * 256 + 255 < LR - 1) ? jb * 256 + 255 : LR - 1;
    const int ntile = (dsa_kend(qlast) + 63) / 64;
    const int kr = tid >> 3, ksg = tid & 7, vd = tid >> 2, vst = tid & 3;
    const unsigned char* ksrc = F.ws + WS_QK8 + ((size_t)b * LP + kr) * T8P + T8_KD + h * 128 + ksg * 16;
    const unsigned char* vsrc = F.ws + WS_VT8 + (size_t)(h * 128 + vd) * M + (size_t)b * LP + vst * 16;
    const int kdst = D2_KS + kr * D2_KROW8 + ksg * 16, vdst = D2_VS + vd * D2_VROW8 + (vst >> 1) * 32 + (vst & 1) * 4;
    u32x4 rk0, rva;
#define D2_LOAD(kt_) do { const unsigned char* ks_ = ksrc + (size_t)(kt_) * 64 * T8P; rk0 = *(const u32x4*)ks_; rva = *(const u32x4*)(vsrc + (kt_) * 64); } while (0)
#define D2_STORE(p_) do { LAS unsigned char* kb_ = lds + (p_) * D2_BUF; *(LAS u32x4*)(kb_ + kdst) = rk0; \
        *(LAS unsigned*)(kb_ + vdst) = rva.x; *(LAS unsigned*)(kb_ + vdst + 8) = rva.y; *(LAS unsigned*)(kb_ + vdst + 16) = rva.z; *(LAS unsigned*)(kb_ + vdst + 24) = rva.w; } while (0)
    RAW_BAR();
    D2_LOAD(0);
    if (tid < 258) { const int n = tid < 129 ? tid : tid - 129; const int rel = tid < 129 ? -n : n; lut[tid] = F.in[I_RELB][t5_bucket_dev(rel) * 8 + h] * D2_L2E; }
    int qpos[2]; size_t qrow[2]; bool qok[2];
    pg8::i32x8v Bq[2];
#pragma unroll
    for (int s = 0; s < 2; ++s) { qpos[s] = qbase + 16 * s + ql; qok[s] = qpos[s] < LR; qrow[s] = (size_t)b * LP + (qok[s] ? qpos[s] : 0);
        const unsigned char* qp_ = F.ws + WS_QK8 + qrow[s] * T8P + T8_QD + h * 128 + 32 * g;
        Bq[s] = __builtin_shufflevector(*(const pg8::i32x4v*)qp_, *(const pg8::i32x4v*)(qp_ + 16), 0, 1, 2, 3, 4, 5, 6, 7); }
    f32x4 O[2][8]; float mrun[2], lrun[2];
#pragma unroll
    for (int s = 0; s < 2; ++s) { mrun[s] = 0.f; lrun[s] = 0.f;
#pragma unroll
        for (int dt = 0; dt < 8; ++dt) O[s][dt] = (f32x4){0.f, 0.f, 0.f, 0.f}; }
    unsigned bw[2][2], bwn[2][2];
    u32x4 bq[2], bqn[2];
#pragma unroll
    for (int s = 0; s < 2; ++s) { bq[s] = qok[s] ? *(const u32x4*)(BMP + qrow[s] * BMP_PITCH) : (u32x4){0u, 0u, 0u, 0u}; bqn[s] = (u32x4){0u, 0u, 0u, 0u};
        bw[s][0] = bq[s].x; bw[s][1] = bq[s].y; bwn[s][0] = 0u; bwn[s][1] = 0u; }
    D2_STORE(0);
#pragma unroll
    for (int s = 0; s < 2; ++s) {
        asm volatile("" :: "v"(Bq[s]));
        asm volatile("" :: "v"(bw[s][0]), "v"(bw[s][1])); }
    if (ntile > 1) D2_LOAD(1);
    RAW_BAR();
    for (int kt = 0; kt < ntile; ++kt) {
        const int key0 = kt * 64;
        LAS unsigned char* tb = lds + (kt & 1) * D2_BUF;
        if (kt + 1 < ntile) { D2_STORE((kt + 1) & 1); if (kt + 2 < ntile) D2_LOAD(kt + 2); }
        if (!(kt & 1)) {
            if (kt + 2 < ntile) {
#pragma unroll
                for (int s = 0; s < 2; ++s) bqn[s] = qok[s] ? *(const u32x4*)(BMP + qrow[s] * BMP_PITCH + 2 * kt + 4) : (u32x4){0u, 0u, 0u, 0u}; }
#pragma unroll
            for (int s = 0; s < 2; ++s) { bwn[s][0] = bq[s].z; bwn[s][1] = bq[s].w; }
        } else {
#pragma unroll
            for (int s = 0; s < 2; ++s) { bwn[s][0] = bqn[s].x; bwn[s][1] = bqn[s].y; bq[s] = bqn[s]; }
        }
        f32x4 St[2][4];
#pragma unroll
        for (int s = 0; s < 2; ++s)
#pragma unroll
            for (int sub = 0; sub < 4; ++sub) St[s][sub] = (f32x4){0.f, 0.f, 0.f, 0.f};
#pragma unroll
        for (int sub = 0; sub < 4; ++sub) { const LAS unsigned char* kp_ = tb + D2_KS + (16 * sub + ql) * D2_KROW8 + 32 * g;
            const pg8::i32x8v Ak = __builtin_shufflevector(*(const LAS pg8::i32x4v*)kp_, *(const LAS pg8::i32x4v*)(kp_ + 16), 0, 1, 2, 3, 4, 5, 6, 7);
#pragma unroll
            for (int s = 0; s < 2; ++s) St[s][sub] = __builtin_amdgcn_mfma_scale_f32_16x16x128_f8f6f4(Ak, Bq[s], St[s][sub], 0, 0, 0, 0, 0, 0); }
        const bool far = (key0 + 63 + 129 <= qbase);
        long Pb[2][2];
        if (!far) {
            const float bf_ = lut[128];
#pragma unroll
            for (int s = 0; s < 2; ++s)
#pragma unroll
                for (int sub = 0; sub < 4; ++sub)
#pragma unroll
                    for (int i = 0; i < 4; ++i) { const int rel = key0 + 16 * sub + 4 * g + i - qpos[s]; const int n = rel < 0 ? -rel : rel; const int nn = n < 128 ? n : 128;
                        St[s][sub][i] += (lut[rel > 0 ? 129 + nn : nn] - bf_) * (1.0f / D2_SL2); }
        }
        d2_softmax<true>(St, bw, bwn, mrun, lrun, O, Pb, lut, g, key0, qpos);
#pragma unroll
        for (int kk = 0; kk < 2; ++kk)
#pragma unroll
            for (int dt = 0; dt < 8; ++dt) { const long Av = *(const LAS long*)(tb + D2_VS + (16 * dt + ql) * D2_VROW8 + kk * 32 + g * 8);
#pragma unroll
                for (int s = 0; s < 2; ++s) O[s][dt] = __builtin_amdgcn_mfma_f32_16x16x32_fp8_bf8(Av, Pb[s][kk], O[s][dt], 0, 0, 0); }
        RAW_BAR();
    }
#undef D2_LOAD
#undef D2_STORE
#pragma unroll
    for (int s = 0; s < 2; ++s) {
        float l = lrun[s]; l += __shfl_xor(l, 16); l += __shfl_xor(l, 32);
        const float inv = (qok[s] && l > 0.f) ? (1.0f / F8S_V) / l : 0.f;
#if OUT1_F8
        if (qpos[s] < LP) { unsigned char* yr = (unsigned char*)Y + ((size_t)b * LP + qpos[s]) * D + 1024 + h * 128 + 4 * g; const float i8 = inv * F8S_Y;
#pragma unroll
            for (int dt = 0; dt < 8; ++dt) *(unsigned*)(yr + 16 * dt) = pk4_f8(O[s][dt][0] * i8, O[s][dt][1] * i8, O[s][dt][2] * i8, O[s][dt][3] * i8); }
#else
        if (qpos[s] < LP) { bf16_t* yr = Y + ((size_t)b * LP + qpos[s]) * D + 1024 + h * 128 + 4 * g;
#pragma unroll
            for (int dt = 0; dt < 8; ++dt) { u32x2 o; o.x = pk2(O[s][dt][0] * inv, O[s][dt][1] * inv); o.y = pk2(O[s][dt][2] * inv, O[s][dt][3] * inv); *(u32x2*)(yr + 16 * dt) = o; } }
#endif
    }
}
constexpr int D2_NJB = (LP + 255) / 256, D2_NU = NB * D2_NJB * 8;
__device__ __forceinline__ void d2_worker(Frame& F, LAS unsigned char* lds, int rep) {
    LAS int* slot = (LAS int*)(F.lds + LDS_MISC);
    for (;;) {
        __syncthreads();
        if (F.tid == 0) slot[0] = (int)__hip_atomic_fetch_add(F.ctl + CW_Q2 + 64 * rep, 1u, __ATOMIC_RELAXED, __HIP_MEMORY_SCOPE_AGENT);
        __syncthreads();
        const int u = slot[0];
        if (u >= D2_NU) break;
        const int h = u & 7, b = (u >> 3) & 1, jb = D2_NJB - 1 - (u >> 4);
        d2_unit(F, lds, b, jb, h, rep);
    }
}

#undef pk2
#undef bflo
#undef bfhi
#undef bf2f
#undef MFMA16
#undef ONE16X2
#define pk2 pk2_b
#define bflo bflo_b
#define bfhi bfhi_b
#define bf2f bf2f_b
#define MFMA16 MFMA16_b
#define ONE16X2 0x3F803F80u
constexpr int ML_QS = 0, ML_ROW = 528, ML_KS = ML_QS + 64 * ML_ROW, ML_KT = ML_KS + 64 * ML_ROW, ML_TROW = 144, ML_VT = ML_KT + 256 * ML_TROW, ML_VW = ML_VT + 48 * ML_TROW, ML_CB = ML_VW + 48 * ML_TROW,
              ML_SD = ML_CB + 48 * ML_ROW, ML_SC = ML_SD + 64 * ML_TROW, ML_LDS = ML_SC + 2048;
typedef short s16x4 __attribute__((ext_vector_type(4)));
template <int CTRL, int ROWMASK> __device__ __forceinline__ float dpp_f(float old, float src) { return __int_as_float(__builtin_amdgcn_update_dpp(__float_as_int(old), __float_as_int(src), CTRL, ROWMASK, 0xf, false)); }
__device__ __forceinline__ float wave_scan_add(float v) {
    v += dpp_f<0x111, 0xf>(0.f, v); v += dpp_f<0x112, 0xf>(0.f, v); v += dpp_f<0x114, 0xf>(0.f, v); v += dpp_f<0x118, 0xf>(0.f, v);
    v += dpp_f<0x142, 0xa>(0.f, v); v += dpp_f<0x143, 0xc>(0.f, v); return v;
}
__device__ __forceinline__ float wave_scan_max(float v) {
    const float ni = -3.0e38f;
    v = fmaxf(v, dpp_f<0x111, 0xf>(ni, v)); v = fmaxf(v, dpp_f<0x112, 0xf>(ni, v)); v = fmaxf(v, dpp_f<0x114, 0xf>(ni, v)); v = fmaxf(v, dpp_f<0x118, 0xf>(ni, v));
    v = fmaxf(v, dpp_f<0x142, 0xa>(ni, v)); v = fmaxf(v, dpp_f<0x143, 0xc>(ni, v)); return v;
}
__device__ __forceinline__ float readlane_f(float v, int l) { return __int_as_float(__builtin_amdgcn_readlane(__float_as_int(v), l)); }
__device__ __forceinline__ void mlstm_worker(Frame& F, LAS unsigned char* lds, int wg, int noload) {
    const bf16_t* PA = (const bf16_t*)(F.ws + WS_P); const bf16_t* KVT = (const bf16_t*)(F.ws + WS_KVT); bf16_t* Y = (bf16_t*)(F.ws + WS_Y);
    const int b = wg >> 5, h = (wg >> 3) & 3, sl = wg & 7, v0 = sl * 32;
    const int tid = F.tid, lane = F.lane, w = F.wave, ql = lane & 15, g = lane >> 4;
    LAS float* sc = (LAS float*)(lds + ML_SC);
    const float b_i = F.in[I_MBI][h], b_f = F.in[I_MBF][h];
    for (int i = tid; i < (48 * ML_ROW) / 4; i += NTHREADS) ((LAS unsigned*)(lds + ML_CB))[i] = 0u;
    for (int i = tid; i < (48 * ML_TROW) / 4; i += NTHREADS) ((LAS unsigned*)(lds + ML_VT))[i] = 0u;
    __syncthreads();
    if (tid < 32) ((LAS unsigned*)(lds + ML_VT + 32 * ML_TROW))[tid] = ONE16X2;
    if (tid == 0) sc[320] = 0.f;
    f32x4 Cacc[2][3];
#pragma unroll
    for (int a = 0; a < 2; ++a)
#pragma unroll
        for (int c = 0; c < 3; ++c) Cacc[a][c] = (f32x4){0.f, 0.f, 0.f, 0.f};
    u32x4 rq[4], rkt[4], rv; unsigned rli = 0, rlf = 0; u32x2 rog = (u32x2){0u, 0u};
    const int srow = tid >> 3, sseg = tid & 7;
    const int krow = tid >> 1, khalf = tid & 1;
    const int vrow = tid >> 3, vseg = tid & 7;
    const int tt = w & 3, vtA = (w < 4) ? 0 : 1;
    constexpr int NCHUNK = LP / 64;
#define ML_ISSUE(cc) do { \
        const size_t r0_ = (size_t)b * LP + (size_t)(cc) * 64; \
        const bf16_t* qs_ = PA + (r0_ + srow) * NIN_OA + CA_QM + h * 256 + sseg * 32; \
        _Pragma("unroll") for (int j = 0; j < 4; ++j) rq[j] = *(const u32x4*)(qs_ + 8 * j); \
        const bf16_t* kt_ = KVT + (size_t)(RB_KM + h * 256 + krow) * M + r0_ + khalf * 32; \
        _Pragma("unroll") for (int j = 0; j < 4; ++j) rkt[j] = *(const u32x4*)(kt_ + 8 * j); \
        if (tid < 256) rv = *(const u32x4*)(KVT + (size_t)(RB_VM + h * 256 + v0 + vrow) * M + r0_ + vseg * 8); \
        rog = *(const u32x2*)(PA + (r0_ + 16 * tt + ql) * NIN_OA + CA_OM + h * 256 + v0 + 16 * vtA + 4 * g); \
        if (tid < 64) { rli = PA[(r0_ + tid) * NIN_OA + CA_IM + h]; rlf = PA[(r0_ + tid) * NIN_OA + CA_FM + h]; } \
    } while (0)
    ML_ISSUE(0);
    for (int c = 0; c < NCHUNK; ++c) {
        const size_t r0 = (size_t)b * LP + (size_t)c * 64;
#pragma unroll
        for (int j = 0; j < 4; ++j) { *(LAS u32x4*)(lds + ML_QS + srow * ML_ROW + sseg * 64 + 16 * j) = rq[j];
            *(LAS u32x4*)(lds + ML_KT + krow * ML_TROW + khalf * 64 + 16 * j) = rkt[j]; }
        if (tid < 256) *(LAS u32x4*)(lds + ML_VT + vrow * ML_TROW + vseg * 16) = rv;
        const u32x2 ogc = rog;
        if (w == 0) {
            const float mprev = sc[320];
            const float li_ = bf2f(rli) + b_i, f_ = bf2f(rlf) + b_f, lf_ = fminf(f_, 0.f) - __logf(1.0f + __expf(-fabsf(f_)));
            const float bc = wave_scan_add(lf_);
            const float gg = li_ - bc, pm = wave_scan_max(gg);
            const float Mt = fmaxf(mprev, pm);
            const float M63 = readlane_f(Mt, 63), b63 = readlane_f(bc, 63);
            sc[lane] = gg; sc[64 + lane] = Mt; sc[128 + lane] = bc; sc[256 + lane] = __expf(gg - M63) * 0.0625f;
            if (lane == 0) { sc[321] = __expf(mprev - M63); sc[322] = b63 + M63; sc[323] = mprev; }
        }
        if (c + 1 < NCHUNK && !noload) ML_ISSUE(c + 1);
        RAW_BAR();
        {
            const int ss = w >> 1;
            f32x4 S2[2] = {(f32x4){0.f, 0.f, 0.f, 0.f}, (f32x4){0.f, 0.f, 0.f, 0.f}};
            {
                bf16x8 Ak[8], Bq0[8], Bq1[8];
#pragma unroll
                for (int ks = 0; ks < 8; ++ks) {
                    const LAS unsigned char* ta = lds + ML_KT + (32 * ks + 8 * g + (ql >> 2)) * ML_TROW + (16 * ss + 4 * (ql & 3)) * 2;
                    const s16x4 lo = __builtin_amdgcn_ds_read_tr16_b64_v4i16((LAS s16x4*)ta), hi = __builtin_amdgcn_ds_read_tr16_b64_v4i16((LAS s16x4*)(ta + 4 * ML_TROW));
                    Ak[ks] = (bf16x8){lo[0], lo[1], lo[2], lo[3], hi[0], hi[1], hi[2], hi[3]};
                    Bq0[ks] = *(const LAS bf16x8*)(lds + ML_QS + (16 * (2 * (w & 1)) + ql) * ML_ROW + (32 * ks + 8 * g) * 2);
                    Bq1[ks] = *(const LAS bf16x8*)(lds + ML_QS + (16 * (2 * (w & 1) + 1) + ql) * ML_ROW + (32 * ks + 8 * g) * 2); }
#pragma unroll
                for (int ks = 0; ks < 8; ++ks) { S2[0] = MFMA16(Ak[ks], Bq0[ks], S2[0], 0, 0, 0); S2[1] = MFMA16(Ak[ks], Bq1[ks], S2[1], 0, 0, 0); }
            }
            const f32x4 gg4 = *(const LAS f32x4*)(sc + 16 * ss + 4 * g);
#pragma unroll
            for (int j = 0; j < 2; ++j) { const int t = 16 * (2 * (w & 1) + j) + ql; const float Mt = sc[64 + t]; float v[4];
#pragma unroll
                for (int i = 0; i < 4; ++i) { const int s_ = 16 * ss + 4 * g + i; const float e = __expf(fminf(gg4[i] - Mt, 0.f)) * 0.0625f; v[i] = (s_ <= t) ? S2[j][i] * e : 0.f; }
                *(LAS u32x2*)(lds + ML_SD + t * ML_TROW + (16 * ss + 4 * g) * 2) = (u32x2){pk2(v[0], v[1]), pk2(v[2], v[3])}; }
            if (tid < 384) { const int v_ = tid >> 3, sg = tid & 7; const u32x4 vv = *(const LAS u32x4*)(lds + ML_VT + v_ * ML_TROW + sg * 16);
                const f32x4 wa = *(const LAS f32x4*)(sc + 256 + 8 * sg), wb = *(const LAS f32x4*)(sc + 256 + 8 * sg + 4);
                u32x4 o; o.x = pk2(bflo(vv.x) * wa[0], bfhi(vv.x) * wa[1]); o.y = pk2(bflo(vv.y) * wa[2], bfhi(vv.y) * wa[3]); o.z = pk2(bflo(vv.z) * wb[0], bfhi(vv.z) * wb[1]); o.w = pk2(bflo(vv.w) * wb[2], bfhi(vv.w) * wb[3]);
                *(LAS u32x4*)(lds + ML_VW + v_ * ML_TROW + sg * 16) = o; }
        }
        RAW_BAR();
        f32x4 N0 = (f32x4){0.f, 0.f, 0.f, 0.f}, N1 = (f32x4){0.f, 0.f, 0.f, 0.f};
        const int t_ = 16 * tt + ql;
        {
#pragma unroll
            for (int hf = 0; hf < 2; ++hf) {
                bf16x8 Bq[4], Ac[4], Ac2[4];
#pragma unroll
                for (int k4 = 0; k4 < 4; ++k4) { const int ks = 4 * hf + k4; Bq[k4] = *(const LAS bf16x8*)(lds + ML_QS + t_ * ML_ROW + (32 * ks + 8 * g) * 2);
                    Ac[k4] = *(const LAS bf16x8*)(lds + ML_CB + (16 * vtA + ql) * ML_ROW + (32 * ks + 8 * g) * 2);
                    if (w < 4) Ac2[k4] = *(const LAS bf16x8*)(lds + ML_CB + (32 + ql) * ML_ROW + (32 * ks + 8 * g) * 2); }
#pragma unroll
                for (int k4 = 0; k4 < 4; ++k4) { N0 = MFMA16(Ac[k4], Bq[k4], N0, 0, 0, 0);
                    if (w < 4) N1 = MFMA16(Ac2[k4], Bq[k4], N1, 0, 0, 0); }
            }
            const float wi = __expf(sc[323] - sc[64 + t_]);
            N0 = N0 * wi; N1 = N1 * wi;
#pragma unroll
            for (int ks = 0; ks < 2; ++ks) { const bf16x8 Bs = *(const LAS bf16x8*)(lds + ML_SD + t_ * ML_TROW + (32 * ks + 8 * g) * 2);
                const bf16x8 Av = *(const LAS bf16x8*)(lds + ML_VT + (16 * vtA + ql) * ML_TROW + (32 * ks + 8 * g) * 2);
                N0 = MFMA16(Av, Bs, N0, 0, 0, 0);
                if (w < 4) { const bf16x8 Av2 = *(const LAS bf16x8*)(lds + ML_VT + (32 + ql) * ML_TROW + (32 * ks + 8 * g) * 2); N1 = MFMA16(Av2, Bs, N1, 0, 0, 0); } }
            if (w < 4 && g == 0) sc[192 + t_] = N1[0];
        }
        RAW_BAR();
        {
            const float den = sc[192 + t_], mt = sc[128 + t_] + sc[64 + t_];
            const float inv = 1.0f / fmaxf(fabsf(den), __expf(-mt));
            const float o0 = N0[0] * inv * fast_sigmoid(bflo(ogc.x)), o1 = N0[1] * inv * fast_sigmoid(bfhi(ogc.x)), o2 = N0[2] * inv * fast_sigmoid(bflo(ogc.y)), o3 = N0[3] * inv * fast_sigmoid(bfhi(ogc.y));
#if OUT1_F8
            *(unsigned*)((unsigned char*)Y + (r0 + t_) * D + h * 256 + v0 + 16 * vtA + 4 * g) = pk4_f8(o0 * F8S_Y, o1 * F8S_Y, o2 * F8S_Y, o3 * F8S_Y);
#else
            *(u32x2*)(Y + (r0 + t_) * D + h * 256 + v0 + 16 * vtA + 4 * g) = (u32x2){pk2(o0, o1), pk2(o2, o3)};
#endif
        }
        {
            const float decay = sc[321];
            bf16x8 Bv[3][2];
#pragma unroll
            for (int ks = 0; ks < 2; ++ks)
#pragma unroll
                for (int vt = 0; vt < 3; ++vt) Bv[vt][ks] = *(const LAS bf16x8*)(lds + ML_VW + (16 * vt + ql) * ML_TROW + (32 * ks + 8 * g) * 2);
#pragma unroll
            for (int a = 0; a < 2; ++a) { const int kt = 2 * w + a;
#pragma unroll
                for (int vt = 0; vt < 3; ++vt) Cacc[a][vt] = Cacc[a][vt] * decay;
#pragma unroll
                for (int ks = 0; ks < 2; ++ks) { const bf16x8 Ak = *(const LAS bf16x8*)(lds + ML_KT + (16 * kt + ql) * ML_TROW + (32 * ks + 8 * g) * 2);
#pragma unroll
                    for (int vt = 0; vt < 3; ++vt) Cacc[a][vt] = MFMA16(Ak, Bv[vt][ks], Cacc[a][vt], 0, 0, 0); }
#pragma unroll
                for (int vt = 0; vt < 3; ++vt) *(LAS u32x2*)(lds + ML_CB + (16 * vt + ql) * ML_ROW + (16 * kt + 4 * g) * 2) = (u32x2){pk2(Cacc[a][vt][0], Cacc[a][vt][1]), pk2(Cacc[a][vt][2], Cacc[a][vt][3])}; }
            if (tid == 0) sc[320] = sc[322];
        }
        RAW_BAR();
    }
#undef ML_ISSUE
}

#undef pk2
#undef bflo
#undef bfhi
#undef bf2f
#undef MFMA16
#undef ONE16X2
constexpr int NPHASE = 18;
struct Args { const float* in[35]; float* out; unsigned char* ws; int ph_lo, ph_hi, rep, pad; };
__global__ void __launch_bounds__(NTHREADS, 2) fwd_kernel(Args args) {
    extern __shared__ __attribute__((aligned(16))) unsigned char lds_raw[];
    Frame F;
    F.lds = (LAS unsigned char*)lds_raw;
    F.ws = args.ws; F.ctl = (unsigned*)(args.ws + WS_CTL); F.out = args.out;
#pragma unroll
    for (int i = 0; i < 35; ++i) F.in[i] = args.in[i];
    F.tid = threadIdx.x; F.lane = F.tid & 63; F.wave = __builtin_amdgcn_readfirstlane(F.tid >> 6); F.G = gridDim.x; F.bid = blockIdx.x;
    if (F.tid < 64) ((LAS unsigned*)(F.lds + LDS_MISC))[F.tid] = 0u;
    __syncthreads();
    const int lo = args.ph_lo, hi = args.ph_hi;
    XcdBarrier bar; bar.bar = F.ctl + CW_BAR; bar.x = 0; bar.st = (volatile LAS unsigned*)(F.lds + LDS_MISC + 32);
    if (hi - lo > 1) bar = xcd_barrier_post(F.ctl + CW_BAR, (volatile LAS unsigned*)(F.lds + LDS_MISC + 32));
#define IN(k) (lo <= (k) && (k) < hi)
#define SEAM(k) do { if (IN(k) && IN((k) + 1)) xcd_barrier(bar); } while (0)
    unsigned char* ws = args.ws;
    const int nM = M / 256, nF = 2 * SEQ / 256;

    if (IN(0)) { p0_prologue(F); } SEAM(0);
    if (IN(1)) {
        s5_build_matrices(F);
        pg8::skinny_phase<0, 2>(F.lds, F.bid, F.G, F.wave, F.lane, ws + WS_HA, (size_t)D * 2, D * 2, NIN_E / 32, pg8::SkRowsLin{ws + WS_WINE, D * 2, 2}, pg8::SkFinBf16{(bf16_t*)(ws + WS_P), NIN_E});
        pg8::LinProv S; S.so.init(nF, NIN_E / 256, F.G, F.bid); S.Bt = (const char*)(ws + WS_WINE); S.K = D; S.frames = 1;
        pg8::EpiBf16 E{(bf16_t*)(ws + WS_P), NIN_E}; E.frames = 1;
        pg8::gemm_phase(F.lds, (const char*)(ws + WS_HA), D, S, E); } SEAM(1);
    if (IN(2)) { if (F.bid < 64) { if (!(args.rep && PROBE_ML == 2)) s5_ssd_unit<false>(F, F.bid >> 5, F.bid & 31, 0); } else { if (!(args.rep && PROBE_ML == 1)) conv_phase(F, 64, F.G - 64); if (!args.rep) (void)weight_items(F, WI_SPLIT, 1 << 30, (F.bid - 64) * NWAVES + F.wave, (F.G - 64) * NWAVES); } } do { if (IN(2) && IN(4)) xcd_barrier(bar); } while (0);
    if (IN(4)) {
        pg8::skinny_phase<0, 1>(F.lds, F.bid, F.G, F.wave, F.lane, ws + WS_Y, (size_t)D * 2, D * 2, D / 16, pg8::SkRowsLin{ws + WS_WOUTE, D * 2, 1}, pg8::SkFinRes{(bf16_t*)(ws + WS_PRE), (const bf16_t*)(ws + WS_HA), D, ALPHA, 1.f});
        pg8::LinProv S; S.so.init(nF, D / 256, F.G, F.bid); S.Bt = (const char*)(ws + WS_WOUTE); S.K = D; S.frames = 1;
        pg8::EpiResBf16 E{(bf16_t*)(ws + WS_PRE), (const bf16_t*)(ws + WS_HA), D, ALPHA, 1};
        pg8::gemm_phase(F.lds, (const char*)(ws + WS_Y), D, S, E); } SEAM(4);
    if (IN(5)) { ln_phase<false, 2>(F, (const bf16_t*)(ws + WS_PRE), (bf16_t*)(ws + WS_HB), F.in[I_LN1G], F.in[I_LN1B], ws + WS_HBF8); } SEAM(5);
    if (IN(6)) {
        pg8::skinny_phase<2, 4>(F.lds, F.bid, F.G, F.wave, F.lane, ws + WS_HBF8, (size_t)D, D, DFF / 32, pg8::SkRowsGated{ws + WS_W13, D}, pg8::SkFinGated<FFN_DOWN_F8 != 0>{ws + WS_P, DFF, 1.f / (I8S_H * I8S_W13), F8S_GH});
        pg8::LinProv S; S.so.init(nF, N13 / 256, F.G, F.bid); S.Bt = (const char*)(ws + WS_W13); S.K = D / 2; S.frames = 1;
#if FFN_DOWN_F8
        pg8::EpiGatedF8 E{ws + WS_P, DFF, 1.f / (I8S_H * I8S_W13), F8S_GH, 1};
        pg8::gemm_phase<pg8::EpiGatedF8, pg8::LinProv, 2>(F.lds, (const char*)(ws + WS_HBF8), D / 2, S, E); } SEAM(6);
#else
        pg8::EpiGatedS E{(bf16_t*)(ws + WS_P), DFF, 1.f / (I8S_H * I8S_W13), 1};
        pg8::gemm_phase<pg8::EpiGatedS, pg8::LinProv, 2>(F.lds, (const char*)(ws + WS_HBF8), D / 2, S, E); } SEAM(6);
#endif
    if (IN(7)) {
#if FFN_DOWN_F8
        pg8::skinny_phase<1, 1>(F.lds, F.bid, F.G, F.wave, F.lane, ws + WS_P, (size_t)DFF, DFF, D / 16, pg8::SkRowsLin{ws + WS_W2, DFF, 1}, pg8::SkFinRes{(bf16_t*)(ws + WS_PRE), (const bf16_t*)(ws + WS_HB), D, ALPHA, 1.f / (F8S_GH * F8S_W2)});
        pg8::LinProv S; S.so.init(nF, D / 256, F.G, F.bid); S.Bt = (const char*)(ws + WS_W2); S.K = DFF / 2; S.frames = 1;
        pg8::EpiResBf16S E{(bf16_t*)(ws + WS_PRE), (const bf16_t*)(ws + WS_HB), D, ALPHA, 1.f / (F8S_GH * F8S_W2), 1};
        pg8::gemm_phase<pg8::EpiResBf16S, pg8::LinProv, 1>(F.lds, (const char*)(ws + WS_P), DFF / 2, S, E); } SEAM(7);
#else
        pg8::skinny_phase<0, 1>(F.lds, F.bid, F.G, F.wave, F.lane, ws + WS_P, (size_t)DFF * 2, DFF * 2, D / 16, pg8::SkRowsLin{ws + WS_W2, DFF * 2, 1}, pg8::SkFinRes{(bf16_t*)(ws + WS_PRE), (const bf16_t*)(ws + WS_HB), D, ALPHA, 1.f});
        pg8::LinProv S; S.so.init(nF, D / 256, F.G, F.bid); S.Bt = (const char*)(ws + WS_W2); S.K = DFF; S.frames = 1;
        pg8::EpiResBf16 E{(bf16_t*)(ws + WS_PRE), (const bf16_t*)(ws + WS_HB), D, ALPHA, 1};
        pg8::gemm_phase(F.lds, (const char*)(ws + WS_P), DFF, S, E); } SEAM(7);
#endif
    if (IN(8)) { ln_phase<false, 2>(F, (const bf16_t*)(ws + WS_PRE), (bf16_t*)(ws + WS_H2), F.in[I_LN2G], F.in[I_LN2B], ws + WS_H2I8); } SEAM(8);
    if (IN(9)) {
        const int G = F.G, al = (G & 7) ? 0 : 1;
        const int n1 = nM * (NA_BF / 256), n2 = (RB_VM / 256) * nM, n3 = nM * ((NIN_OA - NA_BF) / 256);
        const int o2 = al * (((n1 % G) + 7) & ~7), o3 = al * ((o2 + (n2 % G) + 7) & ~7), o4 = al * ((o3 + (n3 % G) + 7) & ~7);
        const float si = 1.f / (I8S_H * I8S_W13);
        { pg8::LinProv S; S.so.init(nM, NA_BF / 256, G, F.bid); S.Bt = (const char*)(ws + WS_WINOA); S.K = D;
          pg8::EpiBf16 E{(bf16_t*)(ws + WS_P), NIN_OA}; E.b16 = 1;
          pg8::gemm_phase(F.lds, (const char*)(ws + WS_H2), D, S, E); }
        { pg8::LinProv S; S.so.init(RB_VM / 256, nM, G, (F.bid + 2 * G - o2) % G); S.Bt = (const char*)(ws + WS_H2); S.K = D;
          pg8::EpiBf16 E{(bf16_t*)(ws + WS_KVT), M}; E.b16 = 1;
          pg8::gemm_phase(F.lds, (const char*)(ws + WS_WINOB), D, S, E); }
        { pg8::LinProv S; S.so.init(nM, (NIN_OA - NA_BF) / 256, G, (F.bid + 2 * G - o3) % G); S.Bt = (const char*)(ws + WS_WINOA8); S.K = D / 2;
          pg8::EpiBf16S E{(bf16_t*)(ws + WS_P) + NA_BF, NIN_OA, si, 1}; E.q8off = (int)(((long)WS_QK8 - (long)WS_P) / 524288); E.q8n = 10; E.q8sub = NA_BF * 2; E.X = ws + WS_KIC; E.xpn = 10;
          pg8::gemm_phase<pg8::EpiBf16S, pg8::LinProv, 2>(F.lds, (const char*)(ws + WS_H2I8), D / 2, S, E); }
        { pg8::LinProv S; S.so.init((NIN_OB - RB_VM) / 256, nM, G, (F.bid + 2 * G - o4) % G); S.Bt = (const char*)(ws + WS_H2I8); S.K = D / 2;
          pg8::EpiBf16S E{(bf16_t*)(ws + WS_KVT) + (size_t)RB_VM * M, M, si, 1, (int)(((long)WS_VT8 - (long)(WS_KVT + (size_t)RB_VM * M * 2)) / 524288), (RB_VD - RB_VM) / 256};
          static_assert(((long)WS_VT8 - (long)(WS_KVT + (size_t)RB_VM * M * 2)) % 524288 == 0 && ((long)WS_QK8 - (long)WS_P) % 524288 == 0, "fp8 side outputs: offsets in 512 KiB units");
          pg8::gemm_phase<pg8::EpiBf16S, pg8::LinProv, 2>(F.lds, (const char*)(ws + WS_WINOB8), D / 2, S, E); } } SEAM(9);
    if (IN(10)) { d1_phase(F, args.rep); if (F.wave >= 4 && !args.rep) convert_experts(F); } SEAM(10);
    #ifndef PROBE_G3
#define PROBE_G3 1
#endif
#ifndef PROBE_ML
#define PROBE_ML 0
#endif
    if (IN(11)) { if (F.bid < 64) { if (!(args.rep && PROBE_ML == 2)) mlstm_worker(F, F.lds, F.bid, args.rep && PROBE_ML == 3); }
        if (!(args.rep && (PROBE_ML == 1 || PROBE_ML == 3))) d2_worker(F, F.lds, args.rep); } SEAM(11);
    if (IN(12)) {
#if OUT1_F8
        pg8::LinProv S; S.so.init(nF, D / 256, F.G, F.bid); S.Bt = (const char*)(ws + WS_WOUTO); S.K = D / 2; S.frames = 1;
        pg8::EpiResBf16S E{(bf16_t*)(ws + WS_PRE1), (const bf16_t*)(ws + WS_H2), D, ALPHA, 1.f / (F8S_Y * F8S_WOUT), 1};
        pg8::gemm_phase<pg8::EpiResBf16S, pg8::LinProv, 1>(F.lds, (const char*)(ws + WS_Y), D / 2, S, E); } SEAM(12);
#else
        pg8::LinProv S; S.so.init(nF, D / 256, F.G, F.bid); S.Bt = (const char*)(ws + WS_WOUTO); S.K = D; S.frames = 1;
        pg8::EpiResBf16 E{(bf16_t*)(ws + WS_PRE1), (const bf16_t*)(ws + WS_H2), D, ALPHA, 1};
        pg8::gemm_phase(F.lds, (const char*)(ws + WS_Y), D, S, E); } SEAM(12);
#endif
    if (IN(13)) { if (!args.rep) ln_phase<true>(F, (const bf16_t*)(ws + WS_PRE1), (bf16_t*)(ws + WS_H3), F.in[I_LN3G], F.in[I_LN3B], ws + WS_H3F8); } SEAM(13);
    if (IN(14)) { route_phase(F); } SEAM(14);
    const int* TL = (const int*)(ws + WS_MOE + MO_TILEE);
#define MOE_UP(tlo, cnt) do { pg8::GatherProv S; S.so.init((cnt), N13 / 256, F.G, F.bid); S.Bt = (const char*)(ws + WS_EW13); S.K = D / 2; S.rowidx = (const int*)(ws + WS_MOE + MO_SLOTTOK); S.tile_e = TL; S.t_lo = (tlo); S.estride = (size_t)N13 * D; \
        pg8::EpiGatedF8 E{ws + WS_GH, DFF, 1.f / (F8S_H3 * F8S_W13), F8S_GH}; pg8::gemm_phase<pg8::EpiGatedF8, pg8::GatherProv, 1>(F.lds, (const char*)(ws + WS_H3F8), D / 2, S, E); } while (0)
#define MOE_DOWN(tlo, cnt) do { pg8::GatherProv S; S.so.init((cnt), D / 256, F.G, F.bid); S.Bt = (const char*)(ws + WS_EW2); S.K = DFF / 2; S.rowidx = nullptr; S.tile_e = TL; S.t_lo = (tlo); S.estride = (size_t)D * DFF; \
        pg8::EpiF8S E{ws + WS_YB + (size_t)(tlo) * 256 * D, D, F8S_YB / (F8S_GH * F8S_W2)}; pg8::gemm_phase<pg8::EpiF8S, pg8::GatherProv, 1>(F.lds, (const char*)(ws + WS_GH), DFF / 2, S, E); } while (0)
    if (IN(15)) { const int nt = __builtin_amdgcn_readfirstlane(TL[300]); MOE_UP(0, nt); } SEAM(15);
    if (IN(16)) { const int nt = __builtin_amdgcn_readfirstlane(TL[300]); MOE_DOWN(0, nt); } SEAM(16);
    if (IN(17)) { final_phase(F); }
#undef IN
#undef SEAM
}

extern "C" void kernel_launch(void* const* d_in, const int* in_sizes, int n_in, void* d_out, int out_size, void* d_ws, size_t ws_size, hipStream_t stream) {
    static int grid = 0;
    if (grid == 0) {
        int dev = 0, cus = 0;
        if (n_in != 35 || ws_size < WS_END) { fprintf(stderr, "kernel_launch: expected 35 inputs and >= %zu bytes of workspace (got %d, %zu)\n", (size_t)WS_END, n_in, ws_size); grid = -1; return; }
        if (hipGetDevice(&dev) != hipSuccess || hipDeviceGetAttribute(&cus, hipDeviceAttributeMultiprocessorCount, dev) != hipSuccess) { grid = -1; return; }
        if (hipFuncSetAttribute((const void*)fwd_kernel, hipFuncAttributeMaxDynamicSharedMemorySize, LDS_BYTES) != hipSuccess) { fprintf(stderr, "kernel_launch: hipFuncSetAttribute failed\n"); grid = -1; return; }
        int per_cu = 0;
        (void)hipOccupancyMaxActiveBlocksPerMultiprocessor(&per_cu, (const void*)fwd_kernel, NTHREADS, LDS_BYTES);
        (void)hipGetLastError();
        grid = cus;
        if (per_cu < 1) fprintf(stderr, "kernel_launch: occupancy query reports %d\n", per_cu);
    }
    if (grid < 0) return;
    (void)in_sizes; (void)out_size;
    hipMemsetAsync((char*)d_ws + WS_CTL, 0, 65536, stream);
    Args a; memset(&a, 0, sizeof(a));
    for (int i = 0; i < 35; ++i) a.in[i] = (const float*)d_in[i];
    a.out = (float*)d_out; a.ws = (unsigned char*)d_ws;
#if MK_N_LAUNCHES == 1
    a.ph_lo = 0; a.ph_hi = NPHASE;
    hipLaunchKernelGGL(fwd_kernel, dim3(grid), dim3(NTHREADS), LDS_BYTES, stream, a);
#else
#ifndef PROBE_REP
#define PROBE_REP 0
#endif
    for (int p = 0; p < NPHASE; ++p) { a.ph_lo = p; a.ph_hi = p + 1;
        if ((PROBE_REP >> p) & 1) { a.rep = 1; hipLaunchKernelGGL(fwd_kernel, dim3(grid), dim3(NTHREADS), LDS_BYTES, stream, a); }
        a.rep = 0; hipLaunchKernelGGL(fwd_kernel, dim3(grid), dim3(NTHREADS), LDS_BYTES, stream, a); }
#endif
}
```
